# Optimizing an MI355X kernel written in HIP

```python
import math
import jax, jax.numpy as jnp
from jax import lax
import numpy as np

D_MODEL = 1024
BATCH = 2
SEQ = 16384
DEPTH = 2

N_MIXERS = 2
N_HEADS = 8
HEAD_DIM = D_MODEL // N_HEADS
Q_BLOCK = 128
K_SUB = 128
N_EXPERTS = 64
TOP_K = 8
EXPERT_DIM = D_MODEL // 4
SHARED_DIM = EXPERT_DIM
ROUTED_SCALE = 2.5
DISPATCH_BLOCK = 128
LN_EPS = 1e-5
DEEPNORM_ALPHA = (2 * DEPTH) ** 0.25
DEEPNORM_BETA = (8 * DEPTH) ** -0.25
N_FOX = (DEPTH + 1) // 2
N_SB = DEPTH // 2
ATTN_SCALE = 1.0 / math.sqrt(HEAD_DIM)

kernel_name = "hybrid_fox_stickbreaking_moe_deepnorm_adaln"


def layer_norm(x, g, b):
    xf = x.astype(jnp.float32)
    mu = jnp.mean(xf, axis=-1, keepdims=True)
    var = jnp.mean(jnp.square(xf - mu), axis=-1, keepdims=True)
    y = (xf - mu) * lax.rsqrt(var + LN_EPS) * g.astype(jnp.float32) + b.astype(jnp.float32)
    return y.astype(x.dtype)


def modulate(x, shift, scale):
    return x * (1.0 + scale[:, None, :]) + shift[:, None, :]


def split_heads(t):
    b, s, _ = t.shape
    return t.reshape(b, s, N_HEADS, HEAD_DIM).transpose(0, 2, 1, 3)


def merge_heads(o):
    b, h, s, d = o.shape
    return o.transpose(0, 2, 1, 3).reshape(b, s, h * d)


def causal_masks(i, L):
    t = i * Q_BLOCK + jnp.arange(Q_BLOCK)
    s = jnp.arange(L)
    return s[None, :] <= t[:, None], s[None, :] < t[:, None]


def fox_attention(h, w_in, b_f, w_o):
    B, S, D = h.shape
    proj = h @ w_in
    q, k, v, fl = jnp.split(proj, [D, 2 * D, 3 * D], axis=-1)
    q, k, v = split_heads(q), split_heads(k), split_heads(v)
    log_f = jax.nn.log_sigmoid((fl + b_f).astype(jnp.float32))
    F = jnp.cumsum(log_f, axis=1).transpose(0, 2, 1)
    outs = []
    for i in range(S // Q_BLOCK):
        L = (i + 1) * Q_BLOCK
        qi, Fi = q[:, :, i * Q_BLOCK:L], F[:, :, i * Q_BLOCK:L]
        causal, _ = causal_masks(i, L)
        logits = (jnp.einsum('bhqd,bhkd->bhqk', qi, k[:, :, :L], preferred_element_type=jnp.float32) * ATTN_SCALE
                  + Fi[..., None] - F[:, :, None, :L])
        p = jax.nn.softmax(jnp.where(causal, logits, -jnp.inf), axis=-1).astype(v.dtype)
        outs.append(jnp.einsum('bhqk,bhkd->bhqd', p, v[:, :, :L]))
    o = jnp.concatenate(outs, axis=2)
    return merge_heads(o) @ w_o


def exclusive_suffix_sum(u):
    shp = u.shape
    nk = shp[-1] // K_SUB
    ub = u.reshape(shp[:-1] + (nk, K_SUB))
    within = lax.cumsum(ub, axis=ub.ndim - 1, reverse=True)
    totals = within[..., 0]
    later = lax.cumsum(totals, axis=totals.ndim - 1, reverse=True) - totals
    return (within + later[..., None] - ub).reshape(shp)


def stick_breaking_attention(h, w_in, w_o):
    B, S, D = h.shape
    proj = h @ w_in
    q, k, v = jnp.split(proj, [D, 2 * D], axis=-1)
    q, k, v = split_heads(q), split_heads(k), split_heads(v)
    outs = []
    for i in range(S // Q_BLOCK):
        L = (i + 1) * Q_BLOCK
        qi = q[:, :, i * Q_BLOCK:L]
        _, strict = causal_masks(i, L)
        z = jnp.einsum('bhqd,bhkd->bhqk', qi, k[:, :, :L], preferred_element_type=jnp.float32) * ATTN_SCALE
        log1m = jnp.where(strict, jax.nn.log_sigmoid(-z), 0.0)
        suffix = exclusive_suffix_sum(log1m)
        a = jnp.exp(jnp.where(strict, jax.nn.log_sigmoid(z) + suffix, -jnp.inf)).astype(v.dtype)
        outs.append(jnp.einsum('bhqk,bhkd->bhqd', a, v[:, :, :L]))
    o = jnp.concatenate(outs, axis=2)
    return merge_heads(o) @ w_o


def swiglu(x, w_gate, w_up, w_down):
    return (jax.nn.silu(x @ w_gate) * (x @ w_up)) @ w_down


def moe(h, router_w, router_bias, w_gate, w_up, w_down, s_gate, s_up, s_down):
    B, S, D = h.shape
    T = B * S
    xt = h.reshape(T, D)
    scores = jax.nn.sigmoid(jnp.matmul(xt, router_w, preferred_element_type=jnp.float32))
    _, idx = lax.top_k(scores + router_bias.astype(jnp.float32), TOP_K)
    wts = jnp.take_along_axis(scores, idx, axis=-1)
    wts = wts / jnp.sum(wts, axis=-1, keepdims=True) * ROUTED_SCALE

    n_assign = T * TOP_K
    e_flat = idx.reshape(-1).astype(jnp.int32)
    tok_flat = jnp.repeat(jnp.arange(T, dtype=jnp.int32), TOP_K)
    w_flat = wts.reshape(-1).astype(xt.dtype)
    order = jnp.argsort(e_flat)
    e_s, tok_s, w_s = e_flat[order], tok_flat[order], w_flat[order]
    counts = jax.ops.segment_sum(jnp.ones((n_assign,), jnp.int32), e_flat, num_segments=N_EXPERTS)
    start = jnp.cumsum(counts) - counts
    padded = (counts + DISPATCH_BLOCK - 1) // DISPATCH_BLOCK * DISPATCH_BLOCK
    pend = jnp.cumsum(padded)
    pstart = pend - padded
    dest = pstart[e_s] + (jnp.arange(n_assign, dtype=jnp.int32) - start[e_s])
    n_blocks = -(-n_assign // DISPATCH_BLOCK) + N_EXPERTS
    rows = n_blocks * DISPATCH_BLOCK
    row_tok = jnp.zeros((rows,), jnp.int32).at[dest].set(tok_s)
    row_w = jnp.zeros((rows,), xt.dtype).at[dest].set(w_s)
    block_exp = jnp.minimum(
        jnp.searchsorted(pend, jnp.arange(n_blocks, dtype=jnp.int32) * DISPATCH_BLOCK, side='right'),
        N_EXPERTS - 1)
    x_rows = xt[row_tok].reshape(n_blocks, DISPATCH_BLOCK, D)

    def step(carry, inp):
        e, xb = inp
        return carry, swiglu(xb, w_gate[e], w_up[e], w_down[e])

    _, out = lax.scan(step, None, (block_exp, x_rows))
    y = jnp.zeros_like(xt).at[row_tok].add(out.reshape(rows, D) * row_w[:, None])
    y = y + swiglu(xt, s_gate, s_up, s_down)
    return y.reshape(B, S, D)


def setup_inputs(seed: int = 0) -> dict:
    key = jax.random.key(seed)
    ks = jax.random.split(key, 24)
    D, H, E, F, FS = D_MODEL, N_HEADS, N_EXPERTS, EXPERT_DIM, SHARED_DIM

    def nrm(k, shape, scale):
        return jax.random.normal(k, shape, jnp.float32) * scale

    fox_col_scale = jnp.concatenate([jnp.ones((2 * D,)), jnp.full((D,), DEEPNORM_BETA), jnp.ones((H,))])
    sb_col_scale = jnp.concatenate([jnp.ones((2 * D,)), jnp.full((D,), DEEPNORM_BETA)])
    return {
        "x": nrm(ks[0], (BATCH, SEQ, D), 1.0),
        "c": nrm(ks[1], (BATCH, D), 1.0),
        "fox_w_in": nrm(ks[2], (N_FOX, D, 3 * D + H), D ** -0.5) * fox_col_scale,
        "fox_b_f": 3.0 + nrm(ks[3], (N_FOX, H), 0.5),
        "fox_w_o": nrm(ks[4], (N_FOX, D, D), D ** -0.5 * DEEPNORM_BETA),
        "sb_w_in": nrm(ks[5], (N_SB, D, 3 * D), D ** -0.5) * sb_col_scale,
        "sb_w_o": nrm(ks[6], (N_SB, D, D), D ** -0.5 * DEEPNORM_BETA),
        "ada_w": nrm(ks[7], (DEPTH, D, 6 * D), 0.1 * D ** -0.5),
        "ada_b": nrm(ks[8], (DEPTH, 6 * D), 0.01),
        "ln_attn_g": 1.0 + nrm(ks[9], (DEPTH, D), 0.02),
        "ln_attn_b": nrm(ks[10], (DEPTH, D), 0.02),
        "router_w": nrm(ks[11], (DEPTH, D, E), D ** -0.5),
        "router_bias": nrm(ks[12], (DEPTH, E), 0.01),
        "exp_w_gate": nrm(ks[13], (DEPTH, E, D, F), D ** -0.5),
        "exp_w_up": nrm(ks[14], (DEPTH, E, D, F), D ** -0.5),
        "exp_w_down": nrm(ks[15], (DEPTH, E, F, D), F ** -0.5 * DEEPNORM_BETA),
        "shared_w_gate": nrm(ks[16], (DEPTH, D, FS), D ** -0.5),
        "shared_w_up": nrm(ks[17], (DEPTH, D, FS), D ** -0.5),
        "shared_w_down": nrm(ks[18], (DEPTH, FS, D), FS ** -0.5 * DEEPNORM_BETA),
        "ln_ffn_g": 1.0 + nrm(ks[19], (DEPTH, D), 0.02),
        "ln_ffn_b": nrm(ks[20], (DEPTH, D), 0.02),
    }


def reference(x, c, fox_w_in, fox_b_f, fox_w_o, sb_w_in, sb_w_o, ada_w, ada_b,
              ln_attn_g, ln_attn_b, router_w, router_bias, exp_w_gate, exp_w_up, exp_w_down,
              shared_w_gate, shared_w_up, shared_w_down, ln_ffn_g, ln_ffn_b):
    c_act = jax.nn.silu(c)
    for i in range(DEPTH):
        mod = c_act @ ada_w[i] + ada_b[i]
        sh_a, sc_a, g_a, sh_m, sc_m, g_m = jnp.split(mod, 6, axis=-1)

        h = modulate(x, sh_a, sc_a)
        j = i // N_MIXERS
        if i % N_MIXERS == 0:
            y = fox_attention(h, fox_w_in[j], fox_b_f[j], fox_w_o[j])
        else:
            y = stick_breaking_attention(h, sb_w_in[j], sb_w_o[j])
        x = layer_norm(DEEPNORM_ALPHA * x + (1.0 + g_a)[:, None, :] * y, ln_attn_g[i], ln_attn_b[i])

        h = modulate(x, sh_m, sc_m)
        y = moe(h, router_w[i], router_bias[i], exp_w_gate[i], exp_w_up[i], exp_w_down[i],
                shared_w_gate[i], shared_w_up[i], shared_w_down[i])
        x = layer_norm(DEEPNORM_ALPHA * x + (1.0 + g_m)[:, None, :] * y, ln_ffn_g[i], ln_ffn_b[i])
    return x
```

```cpp
#include <hip/hip_runtime.h>
#include <cstdio>
#include <cstdint>
#include <cmath>
__device__ __forceinline__ int lane_now() { int l; asm volatile("v_mbcnt_lo_u32_b32 %0, -1, 0\n\tv_mbcnt_hi_u32_b32 %0, -1, %0" : "=v"(l)); return l; }
namespace pg8 {
#define PG8_LAS __attribute__((address_space(3)))
typedef unsigned short bf16_t;
typedef short bf16x8 __attribute__((ext_vector_type(8)));
typedef float f32x4 __attribute__((ext_vector_type(4)));
typedef unsigned u32x4 __attribute__((ext_vector_type(4)));
constexpr int RTL_OFF = 131072 + 8192;
constexpr int BM = 256, BK = 64, HALF = 128, HTB = HALF * BK * 2  , STAGE_BYTES = 8 * HTB, NXCD = 8, WGM = 8;

__host__ __device__ __forceinline__ int lds_byte(int r, int c) { const int st = (r >> 4) * 2 + (c >> 5), rr = r & 15, cc = c & 31, ob = rr * 64 + cc * 2; return st * 1024 + (ob ^ (((ob >> 9) & 1) << 5)); }
__host__ __device__ __forceinline__ void stage_rc(int b, int& R, int& C) { const int st = b / 1024, sb = b % 1024, swz = sb ^ (((sb >> 9) & 1) << 5); R = (st >> 1) * 16 + swz / 64; C = (st & 1) * 32 + (swz % 64) / 2; }
__host__ __device__ __forceinline__ int perm32(int rho) { const int n = rho >> 4, i = rho & 15; return 8 * (i >> 2) + 4 * n + (i & 3); }

struct Unit { int pm, pn, aux; };
struct Gemm { const bf16_t* A; const bf16_t* Bt; int M, N, K; };

template <int NM, int NN> struct StaticOrder {
    int G, c;
    __host__ __device__ void init(int G_, int c_) { G = G_; c = c_; }
    __host__ __device__ bool next(int i, Unit& u) const {
        constexpr int nwg = NM * NN;
        const int L = i * G + c; if (L >= nwg) return false;
        int wgid = L; { constexpr int q = nwg / NXCD, r = nwg % NXCD; const int xcd = wgid % NXCD, off = wgid / NXCD; wgid = (xcd < r ? xcd * (q + 1) : r * (q + 1) + (xcd - r) * q) + off; }
        constexpr int nig = WGM * NN; const int gid = wgid / nig, fm = gid * WGM, gsz = (NM - fm) < WGM ? (NM - fm) : WGM;
        u.pm = fm + ((wgid % nig) % gsz); u.pn = (wgid % nig) / gsz; u.aux = 0; return true;
    }
};
struct MoeOrder {
    int nunits, sh, G, c; const PG8_LAS int* bt;
    __device__ __forceinline__ bool next(int i, Unit& u) const {
        const long L = (long)i * G + c; if (L >= nunits) return false;
        const int blk = (int)(L >> sh), pnl = (int)L & ((1 << sh) - 1);
        const int v = __builtin_amdgcn_readfirstlane(bt[blk]);
        u.pm = blk; u.pn = ((v & 255) << sh) + pnl; u.aux = v; return true;
    }
};

__device__ __forceinline__ unsigned cvt_pk_bf16(float lo, float hi) { unsigned r; asm volatile("v_cvt_pk_bf16_f32 %0, %1, %2" : "=v"(r) : "v"(lo), "v"(hi)); return r; }


struct EpiBf16 {
    static constexpr int PERMW = 1; static constexpr bool AFTER_DRAIN = false;
    bf16_t* O; int ldc; int pn_mask;
    __device__ __forceinline__ void operator()(const f32x4 (&acc)[2][2][4][2], const Unit& u, int wr, int wc, int fr, int fq) const {
        { const int tz = lane_now(); fr = tz & 15; fq = (tz >> 4) & 3; }
        char* base = (char*)(O + (size_t)(u.pm * BM + wr * 64) * ldc + (u.pn & pn_mask) * BM + wc * 32);
        const unsigned lo = (unsigned)(fr * ldc + 8 * fq) * 2u;
#pragma unroll
        for (int ai = 0; ai < 2; ++ai)
#pragma unroll
            for (int m = 0; m < 4; ++m)
#pragma unroll
                for (int bj = 0; bj < 2; ++bj) { const f32x4 v0 = acc[ai][bj][m][0], v1 = acc[ai][bj][m][1];
                    u32x4 w; w.x = cvt_pk_bf16(v0[0], v0[1]); w.y = cvt_pk_bf16(v0[2], v0[3]); w.z = cvt_pk_bf16(v1[0], v1[1]); w.w = cvt_pk_bf16(v1[2], v1[3]);
                    *(u32x4*)(base + (size_t)(lo + (unsigned)(((ai * HALF + m * 16) * ldc + bj * HALF) * 2))) = w; }
    }
};
struct EpiQKV {
    static constexpr int PERMW = 1; static constexpr bool AFTER_DRAIN = false;
    bf16_t* Q; size_t qkv_stride;
    unsigned* nrm; PG8_LAS float* rs;
    __device__ __forceinline__ void operator()(const f32x4 (&acc)[2][2][4][2], const Unit& u, int wr, int wc, int fr, int fq) const {
        const int lz = lane_now(); fr = lz & 15; fq = (lz >> 4) & 3;
        const int which = u.pn >> 2; bf16_t* base = Q + (size_t)which * qkv_stride;
        const int r0 = u.pm * BM + wr * 64 + fr, b = r0 >> 14, s0 = r0 & 16383;
        const bool norms = nrm != nullptr && which == 1;
        if (norms) { rs[wr * 256 + wc * 64 + lz] = 0.f; asm volatile("s_waitcnt lgkmcnt(0)" ::: "memory"); __builtin_amdgcn_s_barrier(); }
#pragma unroll
        for (int ai = 0; ai < 2; ++ai)
#pragma unroll
            for (int m = 0; m < 4; ++m) { const int s = s0 + ai * HALF + m * 16;
#pragma unroll
                for (int bj = 0; bj < 2; ++bj) { const int head = 2 * (u.pn & 3) + bj;
                    bf16_t* p = base + ((size_t)(b * 8 + head) * 16384 + s) * 128 + wc * 32 + 8 * fq;
                    const f32x4 v0 = acc[ai][bj][m][0], v1 = acc[ai][bj][m][1];
                    u32x4 w; w.x = cvt_pk_bf16(v0[0], v0[1]); w.y = cvt_pk_bf16(v0[2], v0[3]); w.z = cvt_pk_bf16(v1[0], v1[1]); w.w = cvt_pk_bf16(v1[2], v1[3]);
                    *(u32x4*)p = w;
                    if (norms) { float ss = 0.f;
#pragma unroll
                        for (int q = 0; q < 4; ++q) { const unsigned d = q == 0 ? w.x : q == 1 ? w.y : q == 2 ? w.z : w.w; const float lo = __builtin_bit_cast(float, d << 16), hi = __builtin_bit_cast(float, d & 0xffff0000u); ss += lo * lo + hi * hi; }
                        ss += __builtin_bit_cast(float, __builtin_amdgcn_ds_bpermute((lz ^ 16) << 2, __builtin_bit_cast(int, ss)));
                        ss += __builtin_bit_cast(float, __builtin_amdgcn_ds_bpermute((lz ^ 32) << 2, __builtin_bit_cast(int, ss)));
                        if (fq == 0) (void)__hip_atomic_fetch_add(rs + (ai * HALF + wr * 64 + m * 16 + fr) * 2 + bj, ss, __ATOMIC_RELAXED, __HIP_MEMORY_SCOPE_WORKGROUP); } } }
        if (norms) { asm volatile("s_waitcnt lgkmcnt(0)" ::: "memory"); __builtin_amdgcn_s_barrier();
            float mx = rs[wr * 256 + wc * 64 + lz];
#pragma unroll
            for (int o = 2; o < 64; o <<= 1) mx = fmaxf(mx, __builtin_bit_cast(float, __builtin_amdgcn_ds_bpermute((lz ^ o) << 2, __builtin_bit_cast(int, mx))));
            if (lz < 2) { const int bh = b * 8 + 2 * (u.pn & 3) + lz;
                atomicMax(nrm + bh, __builtin_bit_cast(unsigned, mx * 1.001f)); }
            asm volatile("s_waitcnt lgkmcnt(0)" ::: "memory"); __builtin_amdgcn_s_barrier(); }
    }
};
__device__ __forceinline__ float silu_f(float g) { return g * __builtin_amdgcn_rcpf(1.0f + __builtin_amdgcn_exp2f(-1.4426950408889634f * g)); }
struct EpiSwiglu {
    static constexpr int PERMW = 1; static constexpr bool AFTER_DRAIN = false;
    bf16_t* ACT;
    __device__ __forceinline__ void operator()(const f32x4 (&acc)[2][2][4][2], const Unit& u, int wr, int wc, int fr, int fq) const {
        { const int tz = lane_now(); fr = tz & 15; fq = (tz >> 4) & 3; }
        const int row0 = u.pm * BM + wr * 64 + fr; const int col0 = (u.pn & 1) * 128 + wc * 32 + 8 * fq;
#pragma unroll
        for (int ai = 0; ai < 2; ++ai)
#pragma unroll
            for (int m = 0; m < 4; ++m) { bf16_t* rowp = ACT + (size_t)(row0 + ai * HALF + m * 16) * 256 + col0;
                const f32x4 g0 = acc[ai][0][m][0], g1 = acc[ai][0][m][1], u0 = acc[ai][1][m][0], u1 = acc[ai][1][m][1];
                float a[8];
#pragma unroll
                for (int j = 0; j < 4; ++j) { a[j] = silu_f(g0[j]) * u0[j]; a[4 + j] = silu_f(g1[j]) * u1[j]; }
                u32x4 w; w.x = cvt_pk_bf16(a[0], a[1]); w.y = cvt_pk_bf16(a[2], a[3]); w.z = cvt_pk_bf16(a[4], a[5]); w.w = cvt_pk_bf16(a[6], a[7]);
                *(u32x4*)rowp = w; }
    }
};
struct EpiF8 {
    static constexpr int PERMW = 2; static constexpr bool AFTER_DRAIN = false;
    unsigned char* O; int ldc; int pn_mask;
    __device__ __forceinline__ void operator()(const f32x4 (&acc)[2][2][4][2], const Unit& u, int wr, int wc, int fr, int fq) const {
        { const int tz = lane_now(); fr = tz & 15; fq = (tz >> 4) & 3; }
        char* base = (char*)(O + (size_t)(u.pm * BM + wr * 64) * ldc + (u.pn & pn_mask) * BM + wc * 64);
        const unsigned lo = (unsigned)(fr * ldc + 16 * fq);
#pragma unroll
        for (int ai = 0; ai < 2; ++ai)
#pragma unroll
            for (int m = 0; m < 4; ++m) { u32x4 w;
                { const f32x4 a = acc[ai][0][m][0] * 16.f, b = acc[ai][0][m][1] * 16.f; int t = 0; t = __builtin_amdgcn_cvt_pk_fp8_f32(a[0], a[1], t, false); t = __builtin_amdgcn_cvt_pk_fp8_f32(a[2], a[3], t, true); w.x = (unsigned)t;
                  int t2 = 0; t2 = __builtin_amdgcn_cvt_pk_fp8_f32(b[0], b[1], t2, false); t2 = __builtin_amdgcn_cvt_pk_fp8_f32(b[2], b[3], t2, true); w.y = (unsigned)t2; }
                { const f32x4 a = acc[ai][1][m][0] * 16.f, b = acc[ai][1][m][1] * 16.f; int t = 0; t = __builtin_amdgcn_cvt_pk_fp8_f32(a[0], a[1], t, false); t = __builtin_amdgcn_cvt_pk_fp8_f32(a[2], a[3], t, true); w.z = (unsigned)t;
                  int t2 = 0; t2 = __builtin_amdgcn_cvt_pk_fp8_f32(b[0], b[1], t2, false); t2 = __builtin_amdgcn_cvt_pk_fp8_f32(b[2], b[3], t2, true); w.w = (unsigned)t2; }
                __builtin_nontemporal_store(w, (u32x4*)(base + (size_t)(lo + (unsigned)((ai * HALF + m * 16) * ldc)))); }
    }
};
struct EpiRouter {
    static constexpr int PERMW = 0; static constexpr bool AFTER_DRAIN = true;
    const float* rbias; float* gate; unsigned* cnt; int* slotof; unsigned short* rowtok2;
    __device__ __forceinline__ void fused(const f32x4 (&acc)[2][2][4][2], const Unit& u, int wr, int wc, int fr, int fq, PG8_LAS unsigned char* lds, int wid, int lane) const {
        PG8_LAS float* L = (PG8_LAS float*)lds;
        PG8_LAS float* Bs = (PG8_LAS float*)(lds + 256 * 65 * 4);
        PG8_LAS unsigned* H = (PG8_LAS unsigned*)(lds + 256 * 65 * 4 + 256);
        PG8_LAS unsigned* GB = H + 64;
        { const int tz = lane_now(); lane = tz; fr = tz & 15; fq = (tz >> 4) & 3; }
        const int tid = wid * 64 + lane;
        if (tid < 64) { Bs[tid] = rbias[tid]; H[tid] = 0u; }
        if (wc < 2) {
#pragma unroll
            for (int ai = 0; ai < 2; ++ai)
#pragma unroll
                for (int m = 0; m < 4; ++m)
#pragma unroll
                    for (int n = 0; n < 2; ++n) { const int row = 128 * ai + 64 * wr + 16 * m + fr, col = 32 * wc + 16 * n + 4 * fq;
                        const f32x4 v = acc[ai][0][m][n] + acc[ai][1][m][n];
                        L[row * 65 + col + 0] = v[0]; L[row * 65 + col + 1] = v[1]; L[row * 65 + col + 2] = v[2]; L[row * 65 + col + 3] = v[3]; }
        }
        __syncthreads();
        const int half = (u.pm * BM) >> 14;
        int si[8]; unsigned lr[8];
        if (tid < 256) {
            const int t = u.pm * BM + tid; PG8_LAS float* Lr = L + tid * 65;
            for (int e = 0; e < 64; ++e) { const float x = Lr[e]; Lr[e] = 1.0f / (1.0f + expf(-x)) + Bs[e]; }
            float sv[8]; float sum = 0.f;
#pragma unroll
            for (int p = 0; p < 8; ++p) { float bv = -3.0e38f; int bi = 0;
                for (int e = 0; e < 64; ++e) { const float x = Lr[e]; if (x > bv) { bv = x; bi = e; } }
                si[p] = bi; sv[p] = bv - Bs[bi]; sum += sv[p]; Lr[bi] = -3.0e38f; }
            const float inv = 2.5f / sum;
#pragma unroll
            for (int p = 0; p < 8; ++p) { gate[(size_t)t * 8 + p] = sv[p] * inv; lr[p] = atomicAdd((unsigned*)&H[si[p]], 1u); }
        }
        __syncthreads();
        if (tid < 64) { const unsigned h = H[tid]; GB[tid] = h ? atomicAdd(cnt + half * 64 + tid, h) : 0u; }
        __syncthreads();
        if (tid < 256) {
            const int t = u.pm * BM + tid, tl = t - half * 16384;
#pragma unroll
            for (int p = 0; p < 8; ++p) { const unsigned pos = GB[si[p]] + lr[p];
                slotof[(size_t)t * 8 + p] = (int)(((unsigned)si[p] << 16) | pos);
                rowtok2[((size_t)(half * 65 + si[p]) << 14) + pos] = (unsigned short)tl; }
            rowtok2[((size_t)(half * 65 + 64) << 14) + tl] = (unsigned short)tl;
        }
    }
};

template <class Epi, class Sched, bool ALIGN_EPI, bool GATHER>
__device__ __forceinline__ void gemm_phase(PG8_LAS unsigned char* lds, const Gemm g, const Sched& S, const Epi& E, const unsigned short* __restrict__ rowtok, int wave) {
    const int wid = wave, lane = lane_now(), tid = wid * 64 + lane;
    const int wr = wid >> 2, wc = wid & 3, fr = lane & 15, fq = lane >> 4;
    const int K = g.K, nt = K / BK;
    unsigned voffB[2];
#pragma unroll
    for (int i = 0; i < 2; ++i) { int R, C; stage_rc(tid * 16 + i * 8192, R, C); const int Rb = Epi::PERMW == 1 ? ((R & ~31) + perm32(R & 31)) : Epi::PERMW == 2 ? (64 * (R >> 5) + 16 * ((R & 15) >> 2) + 4 * ((R >> 4) & 1) + (R & 3)) : R;
        voffB[i] = (unsigned)(Rb * K + C) * 2u; }
    const size_t kstep = (size_t)(BK * 2);
    const size_t hstep = (size_t)HALF * K * 2;
    const size_t tstep = 2 * hstep;
    const size_t bstep = Epi::PERMW == 2 ? (size_t)8 * K * 2 : hstep;
    const unsigned ldsw = (unsigned)wid * 1024u;
    const int aoff = lds_byte(wr * 64 + fr, fq * 8), boff = lds_byte(wc * 32 + fr, fq * 8);
#define PG8_SA(b, h) (((b) * 2 + (h)) * HTB)
#define PG8_SB(b, h) ((4 + (b) * 2 + (h)) * HTB)
#define PG8_STAGE_B(bufoff, gbase) do { _Pragma("unroll") for (int _i = 0; _i < 2; ++_i) \
        __builtin_amdgcn_global_load_lds((const unsigned*)((const char*)(gbase) + voffB[_i]), (PG8_LAS unsigned*)(lds + (bufoff) + ldsw + _i * 8192), 16, 0, 0); } while (0)
#define PG8_STAGE_A(bufoff, gbase, h, OFFS) do { const char* _gb = (const char*)(gbase) + (GATHER ? (size_t)0 : (size_t)(h) * hstep); \
        __builtin_amdgcn_global_load_lds((const unsigned*)(_gb + (GATHER ? OFFS[h][0] : OFFS[0][0])), (PG8_LAS unsigned*)(lds + (bufoff) + ldsw), 16, 0, 0); \
        __builtin_amdgcn_global_load_lds((const unsigned*)(_gb + (GATHER ? OFFS[h][1] : OFFS[0][1])), (PG8_LAS unsigned*)(lds + (bufoff) + ldsw + 8192), 16, 0, 0); } while (0)
#define PG8_LDA(dst, b, h) do { _Pragma("unroll") for (int m = 0; m < 4; ++m) _Pragma("unroll") for (int k = 0; k < 2; ++k) dst[m][k] = *(const PG8_LAS bf16x8*)(lds + PG8_SA(b, h) + aoff + m * 2048 + k * 1024); } while (0)
#define PG8_LDB(dst, b, h) do { _Pragma("unroll") for (int n = 0; n < 2; ++n) _Pragma("unroll") for (int k = 0; k < 2; ++k) dst[n][k] = *(const PG8_LAS bf16x8*)(lds + PG8_SB(b, h) + boff + n * 2048 + k * 1024); } while (0)
#define PG8_MMA(ai, bj, At, Bt) do { __builtin_amdgcn_s_setprio(1); _Pragma("unroll") for (int m = 0; m < 4; ++m) _Pragma("unroll") for (int n = 0; n < 2; ++n) _Pragma("unroll") for (int k = 0; k < 2; ++k) \
        acc[ai][bj][m][n] = __builtin_amdgcn_mfma_f32_16x16x32_bf16(Bt[n][k], At[m][k], acc[ai][bj][m][n], 0, 0, 0); __builtin_amdgcn_s_setprio(0); } while (0)
#define PG8_WAIT_V(n) asm volatile("s_waitcnt vmcnt(" #n ")" ::: "memory")
#define PG8_WAIT_L(n) asm volatile("s_waitcnt lgkmcnt(" #n ")" ::: "memory")
#define PG8_BAR __builtin_amdgcn_s_barrier()
#define PG8_SCHED __builtin_amdgcn_sched_barrier(0)
#define PG8_VA(dst, U) do { const int _tz = wid * 64 + lane_now(); _Pragma("unroll") for (int _i = 0; _i < 2; ++_i) { int _R, _C; stage_rc(_tz * 16 + _i * 8192, _R, _C); \
        _Pragma("unroll") for (int _h = 0; _h < 2; ++_h) { \
        if constexpr (GATHER) dst[_h][_i] = (unsigned)rowtok[(((U).aux & 255) << 14) + ((U).aux >> 8) * BM + _h * HALF + _R] * (unsigned)(K * 2) + (unsigned)(_C * 2); \
        else dst[_h][_i] = (unsigned)(_R * K + _C) * 2u; } } } while (0)
#define PG8_VA_LDS(dst) do { int _R, _C; stage_rc((wid * 64 + lane_now()) * 16, _R, _C); const PG8_LAS unsigned short* _rp = (const PG8_LAS unsigned short*)(lds + RTL_OFF) + _R;     \
        const unsigned _cb = (unsigned)(_C * 2), _ks = (unsigned)(K * 2); dst[0][0] = _rp[0] * _ks + _cb; dst[0][1] = _rp[64] * _ks + _cb; dst[1][0] = _rp[128] * _ks + _cb; dst[1][1] = _rp[192] * _ks + _cb; } while (0)
    Unit cur, nxt; int ui = 0;
    if (!S.next(0, cur)) return;
    f32x4 acc[2][2][4][2];
#pragma unroll
    for (int a = 0; a < 2; ++a)
#pragma unroll
        for (int b = 0; b < 2; ++b)
#pragma unroll
            for (int m = 0; m < 4; ++m)
#pragma unroll
                for (int n = 0; n < 2; ++n) acc[a][b][m][n] = (f32x4){0.f, 0.f, 0.f, 0.f};
    bf16x8 At[4][2], B0[2][2], B1[2][2];
    unsigned vaC[2][2], vaN[2][2];
    PG8_VA(vaC, cur);
    const char* cA = GATHER ? (const char*)g.A : (const char*)g.A + (size_t)cur.pm * tstep; const char* cB = (const char*)g.Bt + (size_t)cur.pn * tstep;
    PG8_STAGE_B(PG8_SB(0, 0), cB); PG8_STAGE_B(PG8_SB(0, 1), cB + bstep); PG8_STAGE_A(PG8_SA(0, 0), cA, 0, vaC); PG8_STAGE_A(PG8_SA(0, 1), cA, 1, vaC);
    if (wr == 1) PG8_BAR;
    PG8_WAIT_V(2); PG8_BAR;
    PG8_STAGE_B(PG8_SB(1, 0), cB + kstep); PG8_STAGE_A(PG8_SA(1, 0), cA + kstep, 0, vaC); PG8_STAGE_B(PG8_SB(1, 1), cB + bstep + kstep);
    PG8_WAIT_V(6); PG8_BAR;
    for (;;) {
        const bool has_next = S.next(ui + 1, nxt);
        const char* nA = GATHER ? (const char*)g.A : (has_next ? (const char*)g.A + (size_t)nxt.pm * tstep : cA); const char* nB = has_next ? (const char*)g.Bt + (size_t)nxt.pn * tstep : cB;
        if constexpr (GATHER) {
            if (has_next && wid < 2) __builtin_amdgcn_global_load_lds((const unsigned*)(rowtok + ((nxt.aux & 255) << 14) + (nxt.aux >> 8) * BM) + wid * 64 + lane_now(), (PG8_LAS unsigned*)(lds + RTL_OFF + wid * 256), 4, 0, 0); }
#pragma unroll
        for (int h = 0; h < 2; ++h)
#pragma unroll
            for (int i = 0; i < 2; ++i) vaN[h][i] = vaC[h][i];
#pragma nounroll
        for (int t = 0; t < nt; t += 2) {
            const bool last = (t == nt - 2);
            const char* a1 = cA + (size_t)(t + 1) * kstep;
            const char* a2 = last ? nA : cA + (size_t)(t + 2) * kstep; const char* b2 = last ? nB : cB + (size_t)(t + 2) * kstep;
            const char* a3 = a2 + kstep; const char* b3 = b2 + kstep;
            if constexpr (GATHER) { if (last && has_next) { PG8_VA_LDS(vaN); } }
            unsigned o2[2][2];
#pragma unroll
            for (int h = 0; h < 2; ++h)
#pragma unroll
                for (int i = 0; i < 2; ++i) o2[h][i] = (GATHER && last) ? vaN[h][i] : vaC[h][i];
            PG8_LDB(B0, 0, 0); PG8_LDB(B1, 0, 1); PG8_SCHED; PG8_LDA(At, 0, 0); PG8_STAGE_A(PG8_SA(1, 1), a1, 1, vaC);
            PG8_WAIT_V(8); PG8_WAIT_L(0); PG8_BAR; PG8_MMA(0, 0, At, B0); PG8_MMA(0, 1, At, B1); PG8_BAR; PG8_SCHED;
            PG8_LDA(At, 0, 1); PG8_STAGE_B(PG8_SB(0, 0), b2); PG8_STAGE_B(PG8_SB(0, 1), b2 + bstep); PG8_STAGE_A(PG8_SA(0, 0), a2, 0, o2);
            PG8_WAIT_V(8); PG8_WAIT_L(0); PG8_BAR; PG8_MMA(1, 0, At, B0); PG8_MMA(1, 1, At, B1); PG8_BAR; PG8_SCHED;
            PG8_LDB(B0, 1, 0); PG8_LDB(B1, 1, 1); PG8_SCHED; PG8_LDA(At, 1, 0); PG8_STAGE_A(PG8_SA(0, 1), a2, 1, o2);
            PG8_WAIT_V(8); PG8_WAIT_L(0); PG8_BAR; PG8_MMA(0, 0, At, B0); PG8_MMA(0, 1, At, B1); PG8_BAR; PG8_SCHED;
            PG8_LDA(At, 1, 1); PG8_STAGE_B(PG8_SB(1, 0), b3); PG8_STAGE_B(PG8_SB(1, 1), b3 + bstep); PG8_STAGE_A(PG8_SA(1, 0), a3, 0, o2);
            PG8_WAIT_V(8); PG8_WAIT_L(0); PG8_BAR; PG8_MMA(1, 0, At, B0); PG8_MMA(1, 1, At, B1); PG8_BAR; PG8_SCHED;
        }
        if constexpr (ALIGN_EPI) { if (wr == 0) PG8_BAR; }
        if constexpr (!Epi::AFTER_DRAIN) { E(acc, cur, wr, wc, fr, fq); }
        if (!has_next) break;
#pragma unroll
        for (int a = 0; a < 2; ++a)
#pragma unroll
            for (int b = 0; b < 2; ++b)
#pragma unroll
                for (int m = 0; m < 4; ++m)
#pragma unroll
                    for (int n = 0; n < 2; ++n) acc[a][b][m][n] = (f32x4){0.f, 0.f, 0.f, 0.f};
        cur = nxt; cA = nA; cB = nB; ++ui;
#pragma unroll
        for (int h = 0; h < 2; ++h)
#pragma unroll
            for (int i = 0; i < 2; ++i) vaC[h][i] = vaN[h][i];
        if constexpr (ALIGN_EPI) { if (wr == 1) PG8_BAR; }
    }
    PG8_WAIT_V(0);
    if constexpr (!ALIGN_EPI) { if (wr == 0) PG8_BAR; }
    PG8_BAR;
    if constexpr (Epi::AFTER_DRAIN) { E.fused(acc, cur, wr, wc, fr, fq, lds, wid, lane); }
#undef PG8_SA
#undef PG8_SB
#undef PG8_STAGE_A
#undef PG8_STAGE_B
#undef PG8_LDA
#undef PG8_LDB
#undef PG8_MMA
#undef PG8_WAIT_V
#undef PG8_WAIT_L
#undef PG8_BAR
#undef PG8_SCHED
#undef PG8_VA
#undef PG8_VA_LDS
}
}
constexpr int NWAVES = 8;
constexpr int NB = 2, SEQ = 16384, DM = 1024, NH = 8, HD = 128, NE = 64, TOPK = 8, FE = 256, DEPTH = 2;
constexpr int NTOK = NB * SEQ;
constexpr int HTOK = NTOK / 2;
constexpr int NSLOT = 9;
constexpr float LN_EPS = 1e-5f, ALPHA = 1.4142135623730951f, ATTN_SCALE = 0.08838834764831845f;
constexpr int MAXBLK = 640;

constexpr size_t MiB = 1u << 20;
constexpr size_t WS_CTL = 0, CTL_ZERO_BYTES = 1 * MiB;
constexpr size_t WS_MOD = 1 * MiB;
constexpr size_t WS_BSUM = WS_MOD + 128 * 1024;
constexpr size_t WS_ROUTE = 3 * MiB;
constexpr size_t WS_IDX = WS_ROUTE, WS_GATE = WS_ROUTE + 1 * MiB;
constexpr size_t ROWS_HALF = (size_t)MAXBLK * 256;
constexpr size_t WS_ROWTOK = WS_ROUTE + 2 * MiB, WS_SLOTOF = WS_ROWTOK + 2 * ROWS_HALF * 4  , WS_BLKEXP = WS_SLOTOF + 1 * MiB + 512 * 1024;
constexpr size_t WS_ROWTOK2 = 10 * MiB;
constexpr size_t WS_AUX = 10 * MiB;
constexpr size_t WS_LOGF = WS_AUX, WS_F = WS_AUX + 1 * MiB, WS_KAUG = WS_AUX + 2 * MiB;
constexpr size_t WS_WATT = 16 * MiB, WATT_STRIDE = 9 * MiB;
constexpr size_t WATT_O = 6 * MiB, WATT_R = 8 * MiB;
constexpr size_t WS_WMOE0 = 34 * MiB, WS_WMOE1 = 500 * MiB, WMOE_D = 65 * MiB;
constexpr size_t WS_H = 132 * MiB;
constexpr size_t WS_BIG = 196 * MiB;
constexpr size_t WS_Q = WS_BIG, WS_K = WS_BIG + 64 * MiB, WS_V = WS_BIG + 128 * MiB, WS_O = WS_H, WS_Y = WS_Q;
constexpr size_t WS_ACT = WS_BIG, WS_YR = WS_BIG + 80 * MiB;
constexpr size_t WS_XB = 436 * MiB;
static_assert(WS_YR + (size_t)MAXBLK * 256 * 1024 <= WS_XB && WS_V + 64 * MiB <= WS_XB && WS_XB + 64 * MiB <= WS_WMOE1 && WS_WMOE0 + 98 * MiB <= WS_H && WS_WATT + 2 * WATT_STRIDE <= WS_WMOE0, "d_ws map (1)");
constexpr size_t WS_END = WS_WMOE1 + WMOE_D + (size_t)65 * 1024 * 256 * 2;
static_assert(WS_ROWTOK2 + (size_t)2 * 65 * 16384 * 2 <= WS_WATT && WS_V - WS_K == WS_K - WS_Q && WS_BLKEXP + 4 * MAXBLK * 4 + 64 <= WS_AUX && WS_SLOTOF + (size_t)NTOK * 8 * 4 <= WS_BLKEXP && WS_END <= (size_t)598 * MiB, "d_ws map");
constexpr int CW_BAR = 4096;
constexpr int CW_CNT = 8192;
constexpr int CW_CUR = 8192 + 256;
constexpr int CW_CONVQ = 12288;
constexpr int CW_FOXQ = 16384;

constexpr int RING_OFF = 0, RING_BYTES = 131072;
constexpr int LDSCTL_OFF = RING_BYTES, MISC_OFF = LDSCTL_OFF + 320;
static_assert(pg8::RTL_OFF == LDSCTL_OFF + 8192, "LDS map");
constexpr int BT_OFF = LDSCTL_OFF + 9216;
constexpr int BBL_OFF = BT_OFF + 2 * MAXBLK * 4;
static_assert(BBL_OFF + 2 * 68 * 4 <= 147456, "LDS map (2)");
constexpr int LDS_BYTES = 147456;

#define GAS __attribute__((address_space(1)))
#define LAS __attribute__((address_space(3)))
typedef unsigned short bf16;
typedef unsigned v4u __attribute__((ext_vector_type(4)));
typedef float f32x4 __attribute__((ext_vector_type(4)));
#define LDS_WAIT() asm volatile("s_waitcnt lgkmcnt(0)" ::: "memory")
#define VM_WAIT() asm volatile("s_waitcnt vmcnt(0)" ::: "memory")
__device__ __forceinline__ unsigned f2bf(float f) { unsigned u = __builtin_bit_cast(unsigned, f); return (u + 0x7fffu + ((u >> 16) & 1u)) >> 16; }
__device__ __forceinline__ unsigned pk2(float lo, float hi) { return f2bf(lo) | (f2bf(hi) << 16); }
__device__ __forceinline__ float bflo(unsigned w) { return __builtin_bit_cast(float, w << 16); }
__device__ __forceinline__ float bfhi(unsigned w) { return __builtin_bit_cast(float, w & 0xffff0000u); }

#define XB_TMO      128
#define XB_XCNT(j)  (256  + 64 * (j))
#define XB_XSUB(j)  (1280 + 64 * (j))
#define XB_XGEN(j)  (2304 + 64 * (j))
#define XB_TOP      3328
#define XB_TOPGEN   3392
#define XCD_BAR_WORDS 3456
#define XB_SPIN_CAP (1u << 26)

__device__ __forceinline__ unsigned xb_ld(unsigned* p)              { return __hip_atomic_load(p, __ATOMIC_RELAXED, __HIP_MEMORY_SCOPE_AGENT); }
__device__ __forceinline__ unsigned xb_add(unsigned* p, unsigned v) { return __hip_atomic_fetch_add(p, v, __ATOMIC_RELAXED, __HIP_MEMORY_SCOPE_AGENT); }
__device__ __forceinline__ unsigned xb_xcc_id() { return (unsigned)__builtin_amdgcn_s_getreg((3 << 11) | 20) & 0xFu; }
#define XB_SPIN(cond, bar) do { unsigned _sp = 0; while (cond) { __builtin_amdgcn_s_sleep(1); \
    if ((++_sp & 255u) == 0u) { if (xb_ld(&(bar)[XB_TMO])) break; if (_sp > XB_SPIN_CAP) { atomicAdd(&(bar)[XB_TMO], 1u); break; } } } } while (0)

struct XcdBarrier {
    unsigned* bar; unsigned x; int wave;
    volatile LAS unsigned* st;
};
__device__ __forceinline__ XcdBarrier xcd_barrier_post(unsigned* bar, volatile LAS unsigned* st, int wave) {
    XcdBarrier b; b.bar = bar; b.x = xb_xcc_id(); b.st = st; b.wave = wave;
    if (wave == 0 && lane_now() == 0) (void)xb_add(&bar[XB_XCNT(b.x)], 1u);
    return b;
}
__device__ __forceinline__ void xcd_barrier_complete(unsigned* bar, unsigned x, unsigned& nloc, unsigned& nx) {
    const unsigned G = gridDim.x * gridDim.y * gridDim.z;
    unsigned sum, cnt, mine, sp = 0u;
    for (;;) {
        sum = 0u; cnt = 0u; mine = 0u;
#pragma unroll
        for (unsigned j = 0; j < 16; ++j) { const unsigned c = xb_ld(&bar[XB_XCNT(j)]); sum += c; cnt += (c > 0u) ? 1u : 0u; mine = (j == x) ? c : mine; }
        if (sum == G) break;
        __builtin_amdgcn_s_sleep(1);
        if ((++sp & 255u) == 0u) { if (xb_ld(&bar[XB_TMO])) break; if (sp > XB_SPIN_CAP) { atomicAdd(&bar[XB_TMO], 1u); break; } }
    }
    nloc = mine > 0u ? mine : 1u; nx = cnt > 0u ? cnt : 1u;
}
__device__ __forceinline__ void xcd_barrier(const XcdBarrier& b) {
    asm volatile("s_waitcnt vmcnt(0)" ::: "memory");
    __syncthreads();
    if (b.wave == 0 && lane_now() == 0) {
        unsigned* bar = b.bar;
        __builtin_amdgcn_s_waitcnt(0);
        unsigned nloc = b.st[0], nx = b.st[1];
        if (nloc == 0u) { xcd_barrier_complete(bar, b.x, nloc, nx); b.st[0] = nloc; b.st[1] = nx; }
        const unsigned old = xb_add(&bar[XB_XSUB(b.x)], 1u);
        const unsigned gen = old / nloc;
        if (old == gen * nloc) asm volatile("buffer_wbl2 sc1" ::: "memory");
        if (old + 1u == (gen + 1u) * nloc) {
            __builtin_amdgcn_fence(__ATOMIC_RELEASE, "agent");
            asm volatile("s_waitcnt vmcnt(0)" ::: "memory");
            const unsigned og = xb_add(&bar[XB_TOP], 1u);
            const unsigned tg = og / nx;
            if (og + 1u == (tg + 1u) * nx) xb_add(&bar[XB_TOPGEN], 1u);
            else XB_SPIN(xb_ld(&bar[XB_TOPGEN]) == tg, bar);
            __builtin_amdgcn_fence(__ATOMIC_ACQUIRE, "agent");
            xb_add(&bar[XB_XGEN(b.x)], 1u);
            asm volatile("s_waitcnt vmcnt(0)" ::: "memory");
        } else {
            XB_SPIN(xb_ld(&bar[XB_XGEN(b.x)]) == gen, bar);
            __builtin_amdgcn_fence(__ATOMIC_ACQUIRE, "agent");
            asm volatile("s_waitcnt vmcnt(0)" ::: "memory");
        }
    }
    __syncthreads();
}

__device__ __forceinline__ float wave_sum(float v, int lane) {
#pragma unroll
    for (int o = 1; o < 64; o <<= 1) v += __builtin_bit_cast(float, __builtin_amdgcn_ds_bpermute((lane ^ o) << 2, __builtin_bit_cast(int, v)));
    return v;
}
__device__ __forceinline__ float logsig(float z) { return fminf(z, 0.f) - log1pf(__expf(-fabsf(z))); }
__device__ __forceinline__ void ld8f_nt(const float* p, float (&v)[8]) { const f32x4 a = __builtin_nontemporal_load((const f32x4*)p), b = __builtin_nontemporal_load((const f32x4*)(p + 4)); v[0] = a.x; v[1] = a.y; v[2] = a.z; v[3] = a.w; v[4] = b.x; v[5] = b.y; v[6] = b.z; v[7] = b.w; }
__device__ __forceinline__ void ld8f(const float* p, float (&v)[8]) { const f32x4 a = *(const f32x4*)p, b = *(const f32x4*)(p + 4); v[0] = a.x; v[1] = a.y; v[2] = a.z; v[3] = a.w; v[4] = b.x; v[5] = b.y; v[6] = b.z; v[7] = b.w; }
__device__ __forceinline__ void st8f(float* p, const float (&v)[8]) { *(f32x4*)p = (f32x4){v[0], v[1], v[2], v[3]}; *(f32x4*)(p + 4) = (f32x4){v[4], v[5], v[6], v[7]}; }
__device__ __forceinline__ void ld8bf(const bf16* p, float (&v)[8]) { const v4u w = *(const v4u*)p; v[0] = bflo(w.x); v[1] = bfhi(w.x); v[2] = bflo(w.y); v[3] = bfhi(w.y); v[4] = bflo(w.z); v[5] = bfhi(w.z); v[6] = bflo(w.w); v[7] = bfhi(w.w); }
__device__ __forceinline__ void st8bf(bf16* p, const float (&v)[8]) { v4u w; w.x = pk2(v[0], v[1]); w.y = pk2(v[2], v[3]); w.z = pk2(v[4], v[5]); w.w = pk2(v[6], v[7]); *(v4u*)p = w; }

__device__ __forceinline__ void transpose_item(const float* W, int ldw, int k0, int n0, bf16* WT, int Kd, int drow, int lo, LAS unsigned short* scr, int lane) {
    constexpr int KP = 72;
    const int nq = (lane & 15) * 4, kr = lane >> 4;
    f32x4 vv[16];
#pragma unroll
    for (int i = 0; i < 16; ++i) vv[i] = __builtin_nontemporal_load((const f32x4*)(W + (size_t)(k0 + 4 * i + kr) * ldw + n0 + nq));
#pragma unroll
    for (int i = 0; i < 16; ++i) { const int k = 4 * i + kr; f32x4 v = vv[i];
        if (lo) { v.x -= __builtin_bit_cast(float, f2bf(v.x) << 16); v.y -= __builtin_bit_cast(float, f2bf(v.y) << 16); v.z -= __builtin_bit_cast(float, f2bf(v.z) << 16); v.w -= __builtin_bit_cast(float, f2bf(v.w) << 16); }
        scr[(nq + 0) * KP + k] = (unsigned short)f2bf(v.x); scr[(nq + 1) * KP + k] = (unsigned short)f2bf(v.y); scr[(nq + 2) * KP + k] = (unsigned short)f2bf(v.z); scr[(nq + 3) * KP + k] = (unsigned short)f2bf(v.w); }
    LDS_WAIT(); asm volatile("" ::: "memory");
    const int c = lane & 7;
#pragma unroll
    for (int j = 0; j < 8; ++j) { const int n = (lane >> 3) + 8 * j; const v4u o = *(const LAS v4u*)(scr + n * KP + 8 * c);
        __builtin_nontemporal_store(o, (v4u*)(WT + (size_t)(drow + n) * Kd + k0 + 8 * c)); }
    LDS_WAIT(); asm volatile("" ::: "memory");
}
namespace fox {
constexpr int D = 128;
constexpr float THR = 8.f;
constexpr bool WSKIP = false;
constexpr float SCALE = 0.08838834764831845f;
constexpr int NW = 8, QBLK = 32, KVBLK = 64, QB = NW * QBLK;
constexpr int SHM_V = KVBLK * D * 2, SHM_K = KVBLK * D * 2;
constexpr int SHM_KA = KVBLK * 16;
constexpr int KA_OFF = 2 * SHM_V + 2 * SHM_K + NW * 64 * 4;
constexpr int LDS_BYTES = KA_OFF + 2 * SHM_KA;
constexpr int OSTR = 1024;
typedef unsigned short bf16;
typedef short bf16x8 __attribute__((ext_vector_type(8)));
typedef short s16x4 __attribute__((ext_vector_type(4)));
typedef float f32x16 __attribute__((ext_vector_type(16)));
typedef float f32x4 __attribute__((ext_vector_type(4)));
typedef unsigned u32x4 __attribute__((ext_vector_type(4)));
template <class A, class Bt> struct same_t { static constexpr bool v = false; };
template <class A> struct same_t<A, A> { static constexpr bool v = true; };
#define KSWZ(row, colB) ((row) * 256 + ((colB) ^ (((row) & 7) << 4)))
#define SBAR() __builtin_amdgcn_sched_barrier(0)
__device__ __forceinline__ int v_st(int k, int c) { const int kk = (k & ~0xC) | ((k & 4) << 1) | ((k & 8) >> 1); return ((kk >> 3) * 4 + (c >> 5)) * 512 + ((kk & 7) * 32 + (c & 31)) * 2; }
__device__ __forceinline__ int v_rd_base(int lane) { return ((lane & 3) << 3) | (((lane >> 2) & 3) << 6) | (((lane >> 4) & 1) << 5) | (((lane >> 5) & 1) << 8); }
constexpr int v_rd_off(int d0, int ks, int half) { return d0 * 512 + ks * 4096 + half * 2048; }
__device__ __forceinline__ int crow(int r, int hi) { return (r & 3) + 8 * (r >> 2) + 4 * hi; }
__device__ __forceinline__ unsigned cvtpk(float lo, float hi) {
    unsigned r; asm volatile("v_cvt_pk_bf16_f32 %0, %1, %2" : "=v"(r) : "v"(lo), "v"(hi)); return r;
}
__device__ __forceinline__ bf16x8 pack8(f32x4 a, f32x4 b) {
    u32x4 w = {cvtpk(a[0], a[1]), cvtpk(a[2], a[3]), cvtpk(b[0], b[1]), cvtpk(b[2], b[3])};
    return *reinterpret_cast<bf16x8*>(&w);
}
template <class T> __device__ __forceinline__ bf16x8 load8(const T* p) {
    if constexpr (same_t<T, float>::v) { return pack8(*(const f32x4*)p, *(const f32x4*)(p + 4)); }
    else { return *reinterpret_cast<const bf16x8*>(p); }
}
__device__ __forceinline__ void mask_tile(f32x16& p0, f32x16& p1, int dq, unsigned W) {
    const float NEG = -__builtin_inff();
#pragma unroll
    for (int r = 0; r < 16; ++r) {
        const int c = (r & 3) + 8 * (r >> 2);
        if ((unsigned)(dq - c) >= W) p0[r] = NEG;
        if ((unsigned)(dq - c - 32) >= W) p1[r] = NEG;
    }
}
__device__ __forceinline__ void partialSM(f32x16& p0, f32x16& p1, float& m_reg, float& mn, float& alpha) {
    float pmax = p0[0]; for (int r = 1; r < 16; ++r) pmax = fmaxf(pmax, p0[r]); for (int r = 0; r < 16; ++r) pmax = fmaxf(pmax, p1[r]);
    { unsigned pb_ = __float_as_uint(pmax); asm volatile("" : "+v"(pb_));
      auto rr = __builtin_amdgcn_permlane32_swap(__float_as_uint(pmax), pb_, false, false);
      pmax = fmaxf(__uint_as_float(rr[0]), __uint_as_float(rr[1])); }
    constexpr float C2 = 1.4426950408889634f * SCALE;
    if (__builtin_expect(__all((pmax - m_reg) * SCALE <= THR), 1)) { mn = m_reg; alpha = 1.f; }
    else { mn = fmaxf(m_reg, pmax); alpha = __builtin_amdgcn_exp2f((m_reg - mn) * C2); m_reg = mn; }
    const float mnL = -mn * C2;
    for (int r = 0; r < 16; ++r) p0[r] = fmaf(p0[r], C2, mnL); for (int r = 0; r < 16; ++r) p1[r] = fmaf(p1[r], C2, mnL);
    for (int r = 0; r < 16; ++r) p0[r] = __builtin_amdgcn_exp2f(p0[r]);
}
__device__ __forceinline__ void finishSM(f32x16& p0, f32x16& p1, float alpha, float& l_reg, bf16x8& pa0, bf16x8& pa1, bf16x8& pa2, bf16x8& pa3) {
    for (int r = 0; r < 16; ++r) p1[r] = __builtin_amdgcn_exp2f(p1[r]);
    float ps = 0; for (int r = 0; r < 16; ++r) ps += p0[r]; for (int r = 0; r < 16; ++r) ps += p1[r];
    { unsigned pb_ = __float_as_uint(ps); asm volatile("" : "+v"(pb_));
      auto rr = __builtin_amdgcn_permlane32_swap(__float_as_uint(ps), pb_, false, false);
      ps = __uint_as_float(rr[0]) + __uint_as_float(rr[1]); }
    l_reg = l_reg * alpha + ps;
#define PK4(P, B_, OUT) do { unsigned a0 = cvtpk(P[B_+0], P[B_+1]), a1 = cvtpk(P[B_+2], P[B_+3]);                          \
        unsigned b0 = cvtpk(P[B_+4], P[B_+5]), b1 = cvtpk(P[B_+6], P[B_+7]);                                             \
        auto r0 = __builtin_amdgcn_permlane32_swap(a0, b0, false, false); auto r1 = __builtin_amdgcn_permlane32_swap(a1, b1, false, false); \
        u32x4 w = {r0[0], r1[0], r0[1], r1[1]}; OUT = *reinterpret_cast<bf16x8*>(&w); } while (0)
    PK4(p0, 0, pa0); PK4(p0, 8, pa1); PK4(p1, 0, pa2); PK4(p1, 8, pa3);
#undef PK4
}
template <int KB, bool SK, bool BIAS = true>
__device__ __forceinline__ void qkt(f32x16& p0, f32x16& p1, const char* K_lds, int r32, int hi, const bf16x8* qr, bool act) {
    if (SK && !act) { const float NEG = -__builtin_inff();
#pragma unroll
        for (int r = 0; r < 16; ++r) { p0[r] = NEG; p1[r] = NEG; } return; }
    if constexpr (!BIAS) { p0 = f32x16{}; p1 = f32x16{}; } else
    {
        const char* ka = K_lds + (KA_OFF - 2 * SHM_V) + KB * SHM_KA; int hz = hi; asm volatile("" : "+v"(hz));
        const short one = hz ? (short)0 : (short)0x3F80;
        const bf16x8 qa = {one, one, one, 0, 0, 0, 0, 0};
        p0 = __builtin_amdgcn_mfma_f32_32x32x16_bf16(*reinterpret_cast<const bf16x8*>(ka + r32 * 16), qa, f32x16{}, 0, 0, 0);
        p1 = __builtin_amdgcn_mfma_f32_32x32x16_bf16(*reinterpret_cast<const bf16x8*>(ka + (32 + r32) * 16), qa, f32x16{}, 0, 0, 0); }
    const char* kb[4];
#pragma unroll
    for (int dd = 0; dd < 4; ++dd) kb[dd] = K_lds + KB * SHM_K + KSWZ(r32, (dd * 16 + hi * 8) * 2);
#pragma unroll
    for (int d0 = 0; d0 < 8; ++d0) { const char* a = kb[d0 & 3] + (d0 >> 2) * 128;
        bf16x8 b0 = *reinterpret_cast<const bf16x8*>(a);
        bf16x8 b1 = *reinterpret_cast<const bf16x8*>(a + 32 * 256);
        p0 = __builtin_amdgcn_mfma_f32_32x32x16_bf16(b0, qr[d0], p0, 0, 0, 0);
        p1 = __builtin_amdgcn_mfma_f32_32x32x16_bf16(b1, qr[d0], p1, 0, 0, 0); }

}
template <int VB, bool SK>
__device__ __forceinline__ void pv_tile(f32x16* o, int vb0, bf16x8 pa0, bf16x8 pa1, bf16x8 pa2, bf16x8 pa3, bool act) {
    if (SK && !act) return;
#define TRRD(dst, off) asm volatile("ds_read_b64_tr_b16 %0, %1 offset:%2" : "=&v"(dst) : "v"(vb0), "i"(off) : "memory")
#define PV_D0(d0) do { s16x4 l0, l1, l2, l3, h0, h1, h2, h3; constexpr int b_ = VB * SHM_V + v_rd_off(d0, 0, 0);     \
        TRRD(l0, b_); TRRD(h0, b_ + 2048); TRRD(l1, b_ + 4096); TRRD(h1, b_ + 6144); TRRD(l2, b_ + 8192); TRRD(h2, b_ + 10240); TRRD(l3, b_ + 12288); TRRD(h3, b_ + 14336); \
        asm volatile("s_waitcnt lgkmcnt(0)" ::: "memory"); SBAR();                 \
        o[d0] = __builtin_amdgcn_mfma_f32_32x32x16_bf16(pa0, (bf16x8){l0[0], l0[1], l0[2], l0[3], h0[0], h0[1], h0[2], h0[3]}, o[d0], 0, 0, 0);   \
        o[d0] = __builtin_amdgcn_mfma_f32_32x32x16_bf16(pa1, (bf16x8){l1[0], l1[1], l1[2], l1[3], h1[0], h1[1], h1[2], h1[3]}, o[d0], 0, 0, 0);   \
        o[d0] = __builtin_amdgcn_mfma_f32_32x32x16_bf16(pa2, (bf16x8){l2[0], l2[1], l2[2], l2[3], h2[0], h2[1], h2[2], h2[3]}, o[d0], 0, 0, 0);   \
        o[d0] = __builtin_amdgcn_mfma_f32_32x32x16_bf16(pa3, (bf16x8){l3[0], l3[1], l3[2], l3[3], h3[0], h3[1], h3[2], h3[3]}, o[d0], 0, 0, 0); } while (0)
    PV_D0(0); PV_D0(1); PV_D0(2); PV_D0(3);
#undef PV_D0
#undef TRRD
}

template <class TIn, class TOut> struct BlockRef { const TIn* Q; const TIn* K; const TIn* V; const TIn* KA; TOut* O; int P0; int JLO; };
template <class TIn> struct Seam {
    bf16x8 qr[8];
    bf16x8 st_v0, st_v1, st_k0, st_k1; f32x4 sf0, sf1, sf2, sf3;
    f32x4 tq[16];
};
__device__ __forceinline__ int swa_jlo(int P0, int W) { const int lowk = P0 - W + 1; return lowk > 0 ? lowk / KVBLK : 0; }
#define ROW(p, k0, rr) ((p) + (size_t)((k0) + (rr)) * D + sc)
#define VMW() asm volatile("s_waitcnt vmcnt(0)" ::: "memory")
#define VMWN(n) asm volatile("s_waitcnt vmcnt(%0)" :: "i"(n) : "memory")
#define SLOAD_H(Kp, Vp, KAp, k0, KABUF) do { S.st_v0 = load8<TIn>(ROW(Vp, k0, sr)); S.st_v1 = load8<TIn>(ROW(Vp, k0, 32 + sr));              \
                         S.st_k0 = load8<TIn>(ROW(Kp, k0, sr)); S.st_k1 = load8<TIn>(ROW(Kp, k0, 32 + sr));              \
                         if (wid == 0) __builtin_amdgcn_global_load_lds((const unsigned*)((KAp) + (size_t)((k0) + lane) * 8), (__attribute__((address_space(3))) unsigned*)(K_lds + (KA_OFF - 2 * SHM_V) + (KABUF) * SHM_KA), 16, 0, 0); } while (0)
#define SWRITE_HK(bf) do { *(bf16x8*)(K_lds + (bf) * SHM_K + kws) = S.st_k0; *(bf16x8*)(K_lds + (bf) * SHM_K + kws + 32 * 256) = S.st_k1; \
                        } while (0)
#define SWRITE_HV(bf) do { *(bf16x8*)(V_lds + (bf) * SHM_V + vst0) = S.st_v0; *(bf16x8*)(V_lds + (bf) * SHM_V + vst0 + 8192) = S.st_v1; } while (0)
#define SWRITE_H(bf) do { SWRITE_HV(bf); SWRITE_HK(bf); } while (0)
#define SLOAD_F(p, k0) do { S.sf0 = *(const f32x4*)ROW(p, k0, sr); S.sf1 = *(const f32x4*)(ROW(p, k0, sr) + 4);                \
                            S.sf2 = *(const f32x4*)ROW(p, k0, 32 + sr); S.sf3 = *(const f32x4*)(ROW(p, k0, 32 + sr) + 4); } while (0)
#define SWRITE_KF(bf) do { *(bf16x8*)(K_lds + (bf) * SHM_K + kws) = pack8(S.sf0, S.sf1); *(bf16x8*)(K_lds + (bf) * SHM_K + kws + 32 * 256) = pack8(S.sf2, S.sf3); } while (0)
#define SWRITE_VF(bf) do { *(bf16x8*)(V_lds + (bf) * SHM_V + vst0) = pack8(S.sf0, S.sf1); *(bf16x8*)(V_lds + (bf) * SHM_V + vst0 + 8192) = pack8(S.sf2, S.sf3); } while (0)
template <class TIn, class TOut>
__device__ __forceinline__ void causal_swa_prime(const BlockRef<TIn, TOut>& cur, int W, char* lds, Seam<TIn>& S, int wv) {
    constexpr bool F32 = same_t<TIn, float>::v;
    const int wid = wv, lane = lane_now(), tid = wid * 64 + lane, r32 = lane & 31, hi = lane >> 5;
    const int sr = tid >> 4, sc = (tid & 15) * 8, kws = KSWZ(sr, sc * 2); char* K_lds = lds + 2 * SHM_V;
    const int kb0 = cur.JLO * KVBLK; (void)W;
    for (int d0 = 0; d0 < 8; ++d0) S.qr[d0] = load8<TIn>(cur.Q + (size_t)(wid * QBLK + r32) * D + d0 * 16 + hi * 8);
    if constexpr (F32) { SLOAD_F((const float*)cur.K, kb0); VMW(); SWRITE_KF(0); SBAR(); SLOAD_F((const float*)cur.V, kb0); }
    else { SLOAD_H(cur.K, cur.V, cur.KA, kb0, 0); VMW(); SWRITE_HK(0); }
    __syncthreads();
}
template <class TIn, class TOut>
__device__ __forceinline__ void causal_swa_block(const BlockRef<TIn, TOut>& cur, const BlockRef<TIn, TOut>& nxt, int skv, int W, char* lds, Seam<TIn>& S, int wv) {
    constexpr bool F32 = same_t<TIn, float>::v;
    const int wid = wv, lane = lane_now(), tid = wid * 64 + lane, r32 = lane & 31, hi = lane >> 5;
    const int j_lo = cur.JLO;
    int j_hi = (cur.P0 + QB - 1) / KVBLK + 1; if (j_hi > skv / KVBLK) j_hi = skv / KVBLK;
    const int NT = j_hi - j_lo;
    const int kbn = nxt.JLO * KVBLK;
    const int qlo = cur.P0 + wid * QBLK, qm = qlo + r32 - 4 * hi;
    char* V_lds = lds; char* K_lds = lds + 2 * SHM_V;
    float* ws = (float*)(lds + 2 * SHM_V + 2 * SHM_K) + wid * 64; float* li_l = ws, * al_l = ws + 32;
    float m_reg = -1e30f, l_reg = 0; f32x16 o[4] = {};
    const int sr = tid >> 4, sc = (tid & 15) * 8, vst0 = v_st(sr, sc)  , kws = KSWZ(sr, sc * 2);
    const int vb0 = (int)(uintptr_t)V_lds + v_rd_base(lane);
    const TIn* Kh = cur.K; const TIn* Vh = cur.V; const TIn* KAh = cur.KA;
#define RESC(a) do { if (__any((a) < 1.f)) { if (hi == 0) al_l[r32] = (a); asm volatile("s_waitcnt lgkmcnt(0)" ::: "memory");              \
                     for (int d_ = 0; d_ < 4; ++d_) for (int r = 0; r < 16; ++r) o[d_][r] *= al_l[crow(r, hi)]; } } while (0)
#define KBASE(t) ((j_lo + (t)) * KVBLK)
#define ACT(t) (KBASE(t) <= qlo + QBLK - 1 && KBASE(t) + KVBLK - 1 >= qlo - W + 1)
#define MASKT(P0_, P1_, t) do { const int kb_ = KBASE(t); if ((!SK || ACT(t)) && (kb_ + KVBLK - 1 > qlo || kb_ <= qlo + QBLK - 1 - W)) mask_tile(P0_, P1_, qm - kb_, (unsigned)W); } while (0)
    constexpr int NQL = F32 ? 16 : 8;
    constexpr bool SK = WSKIP && !F32;
#define SEAM_K0() do { VMWN(NQL); if constexpr (F32) { SWRITE_KF(0); SBAR(); SLOAD_F((const float*)nxt.V, kbn); } else { SWRITE_HK(0); } SBAR(); } while (0)
    f32x16 pA0, pA1, pB0, pB1; float mnA, mnB, alA, alB; bf16x8 pa0, pa1, pa2, pa3;
    if constexpr (F32) { VMW(); SWRITE_VF(0); SBAR(); } else { SWRITE_HV(0); SBAR(); }
    if (NT > 1) { if constexpr (F32) SLOAD_F((const float*)Kh, KBASE(1)); else SLOAD_H(Kh, Vh, KAh, KBASE(1), 1); }
    SBAR(); qkt<0, SK>(pA0, pA1, K_lds, r32, hi, S.qr, ACT(0));
    if constexpr (F32) { if (NT > 1) { VMW(); SWRITE_KF(1); SBAR(); SLOAD_F((const float*)Vh, KBASE(1)); } }
    MASKT(pA0, pA1, 0); partialSM(pA0, pA1, m_reg, mnA, alA);
    if (NT > 1) { VMW(); if constexpr (F32) { SWRITE_VF(1); SBAR(); if (NT > 2) SLOAD_F((const float*)Kh, KBASE(2)); } else SWRITE_H(1); }
    __syncthreads();
#define HALF_STEP(PX0, PX1, mnX, alX, PY0, PY1, alY, t, KB, VB, SB) do {                                                      \
        SBAR(); qkt<KB, SK>(PX0, PX1, K_lds, r32, hi, S.qr, ACT(t));                                             \
        finishSM(PY0, PY1, alY, l_reg, pa0, pa1, pa2, pa3); SBAR();                                                           \
        if ((t) + 1 < NT) { if constexpr (F32) { VMW(); SWRITE_KF(SB); SBAR(); SLOAD_F((const float*)Vh, KBASE((t) + 1)); }  \
                            else { SLOAD_H(Kh, Vh, KAh, KBASE((t) + 1), SB); } SBAR(); }                                               \
        pv_tile<VB, SK>(o, vb0, pa0, pa1, pa2, pa3, ACT((t) - 1)); MASKT(PX0, PX1, (t)); partialSM(PX0, PX1, m_reg, mnX, alX);                                        \
        __syncthreads();                                                                                                      \
        if ((t) + 1 < NT) { VMW(); if constexpr (F32) { SWRITE_VF(SB); SBAR(); if ((t) + 2 < NT) SLOAD_F((const float*)Kh, KBASE((t) + 2)); } \
                            else { SWRITE_H(SB); } }                                                                          \
        RESC(alX); __syncthreads(); } while (0)
    for (int t = 1; t + 1 < NT; t += 2) {
        HALF_STEP(pB0, pB1, mnB, alB, pA0, pA1, alA, t, 1, 0, 0);
        HALF_STEP(pA0, pA1, mnA, alA, pB0, pB1, alB, t + 1, 0, 1, 1);
    }
    const bool even = (NT & 1) == 0;
    if (even) { SBAR(); qkt<1, SK>(pB0, pB1, K_lds, r32, hi, S.qr, ACT(NT - 1)); SBAR(); }
#define QROW(e) (nxt.Q + (size_t)(wid * QBLK + r32) * D + ((e) >> 1) * 16 + hi * 8 + ((e) & 1) * 4)
    if constexpr (F32) { SLOAD_F((const float*)nxt.K, kbn); SBAR();
#pragma unroll
        for (int e = 0; e < 8; ++e) S.tq[e] = *(const f32x4*)QROW(e); }
    else { SLOAD_H(nxt.K, nxt.V, nxt.KA, kbn, 0); SBAR();
#pragma unroll
        for (int d0 = 0; d0 < 8; ++d0) S.qr[d0] = load8<TIn>(nxt.Q + (size_t)(wid * QBLK + r32) * D + d0 * 16 + hi * 8); }
    SBAR();
    finishSM(pA0, pA1, alA, l_reg, pa0, pa1, pa2, pa3); SBAR();
    if constexpr (F32) {
#pragma unroll
        for (int e = 8; e < 16; ++e) S.tq[e] = *(const f32x4*)QROW(e); SBAR(); }
#undef QROW
    pv_tile<0, SK>(o, vb0, pa0, pa1, pa2, pa3, ACT(even ? NT - 2 : NT - 1));
    if (even) { MASKT(pB0, pB1, NT - 1); partialSM(pB0, pB1, m_reg, mnB, alB); __syncthreads(); RESC(alB);
        finishSM(pB0, pB1, alB, l_reg, pa0, pa1, pa2, pa3); SBAR(); pv_tile<1, SK>(o, vb0, pa0, pa1, pa2, pa3, ACT(NT - 1)); }
    SBAR(); SEAM_K0();
    if (hi == 0) li_l[r32] = l_reg; asm volatile("s_waitcnt lgkmcnt(0)" ::: "memory");
    float rli[16];
#pragma unroll
    for (int r = 0; r < 16; ++r) rli[r] = __builtin_amdgcn_rcpf(li_l[crow(r, hi)]);
    TOut* Ow = cur.O + (size_t)(wid * QBLK) * OSTR;
#pragma unroll
    for (int r = 0; r < 16; ++r) { const int orow = crow(r, hi);
#pragma unroll
        for (int d0 = 0; d0 < 4; ++d0) { const float v = o[d0][r] * rli[r];
            if constexpr (same_t<TOut, float>::v) { Ow[(size_t)orow * OSTR + d0 * 32 + r32] = v; }
            else { const float vn = __builtin_bit_cast(float, __builtin_amdgcn_ds_bpermute((lane ^ 1) << 2, __builtin_bit_cast(int, v)));
                   if ((r32 & 1) == 0) *(unsigned*)(Ow + (size_t)orow * OSTR + d0 * 32 + r32) = cvtpk(v, vn); } } }
    if constexpr (F32) {
#pragma unroll
        for (int d0 = 0; d0 < 8; ++d0) S.qr[d0] = pack8(S.tq[2 * d0], S.tq[2 * d0 + 1]); }
    __syncthreads();
#undef RESC
#undef KBASE
#undef ACT
#undef MASKT
#undef SEAM_K0
#undef HALF_STEP
}
#undef ROW
#undef VMW
#undef VMWN
#undef SLOAD_H
#undef SWRITE_HK
#undef SWRITE_HV
#undef SWRITE_H
#undef SLOAD_F
#undef SWRITE_KF
#undef SWRITE_VF

typedef BlockRef<bf16, bf16> BR;
__device__ __forceinline__ float fox_gmax(const bf16* Q, const bf16* K, const float* F, const unsigned* nrm, int item, char* lds, int wv) {
    const int qb = 63 - (item >> 4), bh = item & 15; const size_t hb = (size_t)bh * 16384; const int P0 = qb * QB;
    const int lane = lane_now(), row = wv * 32 + (lane & 31), hi = lane >> 5;
    const bf16* qp = Q + (hb + P0 + row) * D + hi * 64; const bf16* kp = K + (hb + P0 + row) * D + hi * 64;
    float acc = 0.f, qq = 0.f;
#pragma unroll 2
    for (int c = 0; c < 8; ++c) { const u32x4 a = *(const u32x4*)(qp + 8 * c), b = *(const u32x4*)(kp + 8 * c);
#pragma unroll
        for (int q = 0; q < 4; ++q) { const unsigned x = q == 0 ? a.x : q == 1 ? a.y : q == 2 ? a.z : a.w, y = q == 0 ? b.x : q == 1 ? b.y : q == 2 ? b.z : b.w;
            const float xl = __builtin_bit_cast(float, x << 16), xh = __builtin_bit_cast(float, x & 0xffff0000u);
            acc += xl * __builtin_bit_cast(float, y << 16) + xh * __builtin_bit_cast(float, y & 0xffff0000u); qq += xl * xl + xh * xh; } }
    acc += __builtin_bit_cast(float, __builtin_amdgcn_ds_bpermute((lane ^ 32) << 2, __builtin_bit_cast(int, acc)));
    qq += __builtin_bit_cast(float, __builtin_amdgcn_ds_bpermute((lane ^ 32) << 2, __builtin_bit_cast(int, qq)));
    const float km = sqrtf(__builtin_bit_cast(float, nrm[bh]));
    float g = F[hb + P0 + row] + (1.001f * sqrtf(qq) * km - acc) * SCALE;
#pragma unroll
    for (int o = 1; o < 32; o <<= 1) g = fmaxf(g, __builtin_bit_cast(float, __builtin_amdgcn_ds_bpermute((lane ^ o) << 2, __builtin_bit_cast(int, g))));
    volatile float* gm = (volatile float*)(lds + KA_OFF + 2 * SHM_KA + 16);
    if (lane == 0) gm[wv] = g;
    __syncthreads();
    float r = gm[0];
#pragma unroll
    for (int w = 1; w < NW; ++w) r = fmaxf(r, gm[w]);
    __syncthreads();
    return r;
}
__device__ __forceinline__ BR fox_ref(const bf16* Q, const bf16* K, const bf16* V, const bf16* KA, bf16* O, const float* F, const unsigned* nrm, int item, int lane, float gmax) {
    const int qb = 63 - (item >> 4), bh = item & 15;
    BR r; const size_t hb = (size_t)bh * 16384;
    r.Q = Q + (hb + (size_t)qb * QB) * D; r.K = K + hb * D; r.V = V + hb * D; r.KA = KA + hb * 8;
    r.O = O + ((size_t)(bh >> 3) * 16384 + (size_t)qb * QB) * OSTR + (bh & 7) * D; r.P0 = qb * QB;
    const float* Fh = F + hb;
    const int jmax = 4 * qb; float fe[4];
#pragma unroll
    for (int i = 0; i < 4; ++i) { const int j = 4 * lane + i; fe[i] = Fh[(j < jmax ? j : jmax) * KVBLK + 63]; }
    const float thr = gmax + 104.05f;
    int first = 4;
#pragma unroll
    for (int i = 3; i >= 0; --i) if (4 * lane + i <= jmax && fe[i] <= thr) first = i;
    const unsigned long long bal = __ballot(first < 4); const int l1 = __builtin_amdgcn_readfirstlane((int)__builtin_ctzll(bal));
    r.JLO = 4 * l1 + __builtin_amdgcn_readlane(first, l1);
    return r;
}
__device__ __forceinline__ void fox_phase(const bf16* Q, const bf16* K, const bf16* V, const bf16* KA, bf16* O, const float* F, unsigned* ctlq  , char* lds, int wv) {
    constexpr int TOTAL = 1024, SKV = 16384, W = 16384;
    volatile int* slot = (volatile int*)(lds + KA_OFF + 2 * SHM_KA);
    const unsigned* nrm = ctlq + 16;
    int lane = lane_now();
    if (wv == 0 && lane == 0) { slot[0] = (int)atomicAdd(ctlq, 1u); slot[1] = (int)atomicAdd(ctlq, 1u); }
    __syncthreads();
    int icur = __builtin_amdgcn_readfirstlane(slot[0]), inxt = __builtin_amdgcn_readfirstlane(slot[1]);
    __syncthreads();
    if (icur >= TOTAL) return;
    BR cur = fox_ref(Q, K, V, KA, O, F, nrm, icur, lane, fox_gmax(Q, K, F, nrm, icur, lds, wv));
    BR nxt = cur; if (inxt < TOTAL) nxt = fox_ref(Q, K, V, KA, O, F, nrm, inxt, lane, fox_gmax(Q, K, F, nrm, inxt, lds, wv));
    Seam<bf16> S;
    causal_swa_prime<bf16, bf16>(cur, W, lds, S, wv);
    for (;;) {
        const bool last = inxt >= TOTAL;
        if (!last && wv == 0 && lane_now() == 0) slot[2] = (int)atomicAdd(ctlq, 1u);
        causal_swa_block<bf16, bf16>(cur, nxt, SKV, W, lds, S, wv);
        if (last) break;
        const int inn = __builtin_amdgcn_readfirstlane(slot[2]);
        cur = nxt; icur = inxt; inxt = inn; lane = lane_now();
        if (inxt < TOTAL) nxt = fox_ref(Q, K, V, KA, O, F, nrm, inxt, lane, fox_gmax(Q, K, F, nrm, inxt, lds, wv)); else nxt = cur;
        __syncthreads();
    }
}
template <bool MASK>
__device__ __forceinline__ float sb_half(f32x16& p, int kb, int trow, int hi, int pidx, float cin) {
    constexpr float C = SCALE * 1.4426950408889634f;
    float m[16];
#pragma unroll
    for (int r = 0; r < 16; ++r) { const int key = kb + crow(r, hi);
        const float e = __builtin_amdgcn_exp2f(fminf(p[r] * C, 115.f)); const float om = __builtin_amdgcn_rcpf(1.f + e); const bool v = !MASK || key < trow; m[r] = v ? om : 1.f; p[r] = v ? e * om : 0.f; }
    float later[4]; float sp = 1.f;
#pragma unroll
    for (int q = 3; q >= 0; --q) { const float gs = (m[4 * q] * m[4 * q + 1]) * (m[4 * q + 2] * m[4 * q + 3]);
        const float gp = __builtin_bit_cast(float, __builtin_amdgcn_ds_bpermute(pidx, __builtin_bit_cast(int, gs)));
        const float g_lo = hi ? gp : gs, g_hi = hi ? gs : gp;
        later[q] = hi ? sp : sp * g_hi; sp *= g_lo * g_hi; }
#pragma unroll
    for (int q = 0; q < 4; ++q) { float gx = cin * later[q];
#pragma unroll
        for (int i = 3; i >= 0; --i) { const int r = 4 * q + i; p[r] *= gx; gx *= m[r]; } }
    return sp;
}
template <bool MASK>
__device__ __forceinline__ void sb_weights(f32x16& p0, f32x16& p1, int kb, int trow, int hi, int pidx, float& carry) {
    const float s1 = sb_half<MASK>(p1, kb + 32, trow, hi, pidx, carry);
    const float c1 = carry * s1;
    const float s0 = sb_half<MASK>(p0, kb, trow, hi, pidx, c1);
    carry = c1 * s0;
}
__device__ __forceinline__ void sb_pack(const f32x16& p0, const f32x16& p1, bf16x8& pa0, bf16x8& pa1, bf16x8& pa2, bf16x8& pa3) {
#define PK4(P, B_, OUT) do { unsigned a0 = cvtpk(P[B_+0], P[B_+1]), a1 = cvtpk(P[B_+2], P[B_+3]);                          \
        unsigned b0 = cvtpk(P[B_+4], P[B_+5]), b1 = cvtpk(P[B_+6], P[B_+7]);                                             \
        auto r0 = __builtin_amdgcn_permlane32_swap(a0, b0, false, false); auto r1 = __builtin_amdgcn_permlane32_swap(a1, b1, false, false); \
        u32x4 w = {r0[0], r1[0], r0[1], r1[1]}; OUT = *reinterpret_cast<bf16x8*>(&w); } while (0)
    PK4(p0, 0, pa0); PK4(p0, 8, pa1); PK4(p1, 0, pa2); PK4(p1, 8, pa3);
#undef PK4
}
__device__ __forceinline__ void sb_phase(const bf16* Q, const bf16* K, const bf16* V, bf16* O, char* lds, int G, int c, int wv) {
    const int wid = wv;
    char* V_lds = lds; char* K_lds = lds + 2 * SHM_V;
    volatile int* flags = (volatile int*)(lds + 2 * SHM_V + 2 * SHM_K);
    for (int it = c; it < 1024; it += G) {
        const int lane = lane_now(), tid = wid * 64 + lane, r32 = lane & 31, hi = lane >> 5;
        const int sr = tid >> 4, sc = (tid & 15) * 8, vst0 = v_st(sr, sc), kws = KSWZ(sr, sc * 2);
        const int vb0 = (int)(uintptr_t)V_lds + v_rd_base(lane);
        const int bh = it >> 6, qb = it & 63; const size_t hb = (size_t)bh * 16384;
        const bf16* Kh = K + hb * D; const bf16* Vh = V + hb * D; const bf16* Qb = Q + (hb + (size_t)qb * QB) * D;
        const int P0 = qb * QB, qlo = P0 + wid * QBLK, trow = qlo + r32;
        bf16x8 qr[8];
#pragma unroll
        for (int d0 = 0; d0 < 8; ++d0) qr[d0] = *reinterpret_cast<const bf16x8*>(Qb + (size_t)(wid * QBLK + r32) * D + d0 * 16 + hi * 8);
        f32x16 o[4] = {}; float carry = 1.f; int wdone = 0;
        int j = P0 / KVBLK + 3;
        bf16x8 ak0, ak1, av0, av1, bk0, bk1, bv0, bv1;
#define SB_LOAD(K0_, K1_, V0_, V1_, jj) do { const int jc_ = (jj) > 0 ? (jj) : 0; const size_t k0_ = (size_t)jc_ * KVBLK; V0_ = *reinterpret_cast<const bf16x8*>(Vh + (k0_ + sr) * D + sc); V1_ = *reinterpret_cast<const bf16x8*>(Vh + (k0_ + 32 + sr) * D + sc); \
                         K0_ = *reinterpret_cast<const bf16x8*>(Kh + (k0_ + sr) * D + sc); K1_ = *reinterpret_cast<const bf16x8*>(Kh + (k0_ + 32 + sr) * D + sc); } while (0)
#define SB_STAGE(K0_, K1_, V0_, V1_) { \
            *(bf16x8*)(V_lds + vst0) = V0_; *(bf16x8*)(V_lds + vst0 + 8192) = V1_; *(bf16x8*)(K_lds + kws) = K0_; *(bf16x8*)(K_lds + kws + 32 * 256) = K1_; \
            __syncthreads(); \
            SB_LOAD(K0_, K1_, V0_, V1_, j - 2);                                  \
            const int kb = j * KVBLK; \
            if (!wdone && kb < qlo + QBLK - 1) { \
                f32x16 p0, p1; bf16x8 pa0, pa1, pa2, pa3; \
                qkt<0, false, false>(p0, p1, K_lds, r32, hi, qr, true); \
                if (kb + KVBLK - 1 >= qlo) sb_weights<true>(p0, p1, kb, trow, hi, (lane ^ 32) << 2, carry); \
                else sb_weights<false>(p0, p1, kb, trow, hi, (lane ^ 32) << 2, carry); \
                sb_pack(p0, p1, pa0, pa1, pa2, pa3); \
                pv_tile<0, false>(o, vb0, pa0, pa1, pa2, pa3, true); \
                wdone = __all(carry == 0.f) ? 1 : 0; \
            } \
            if (lane == 0) flags[wid] = wdone; \
            __syncthreads(); \
            int all = 1; \
            _Pragma("unroll") for (int w = 0; w < NW; ++w) all &= flags[w]; \
            if (all || j == 0) break; \
            --j; }
        SB_LOAD(ak0, ak1, av0, av1, j); SB_LOAD(bk0, bk1, bv0, bv1, j - 1);
        for (;;) {
            SB_STAGE(ak0, ak1, av0, av1)
            SB_STAGE(bk0, bk1, bv0, bv1)
        }
#undef SB_STAGE
#undef SB_LOAD
        bf16* Ow = O + ((size_t)(bh >> 3) * 16384 + (size_t)qb * QB + wid * QBLK) * OSTR + (bh & 7) * D;
        const int lz = lane_now(), hz = lz >> 5;
#pragma unroll
        for (int r = 0; r < 16; ++r) { const int orow = crow(r, hz);
#pragma unroll
            for (int d0 = 0; d0 < 4; ++d0) { const float v = o[d0][r];
                const float vn = __builtin_bit_cast(float, __builtin_amdgcn_ds_bpermute((lz ^ 1) << 2, __builtin_bit_cast(int, v)));
                if ((lz & 1) == 0) *(unsigned*)(Ow + (size_t)orow * OSTR + d0 * 32 + (lz & 31)) = cvtpk(v, vn); } }
        __syncthreads();
    }
}
}
struct Args { const float* in[21]; float* out; unsigned char* ws; int ph_lo, ph_hi; };
enum { I_X = 0, I_C, I_FOX_WIN, I_FOX_BF, I_FOX_WO, I_SB_WIN, I_SB_WO, I_ADA_W, I_ADA_B, I_LNA_G, I_LNA_B, I_RW, I_RB, I_EG, I_EU, I_ED, I_SG, I_SU, I_SD, I_LNF_G, I_LNF_B };

__device__ __forceinline__ void convert_attn_weights(const Args& A, LAS unsigned char* lds, int gw, int NGW, int wave, int lane) {
    asm volatile("" : "+v"(lane));
    LAS unsigned short* scr = (LAS unsigned short*)(lds + RING_OFF + wave * 16384);
    constexpr int nQ = 16 * 48, nO = 16 * 16, nR = 32, nZ = 128, PER = nQ + nO + nR + nZ;
    for (int it = gw; it < 2 * PER; it += NGW) {
        const int l = it / PER; int r = it % PER;
        bf16* WQKV = (bf16*)(A.ws + WS_WATT + (size_t)l * WATT_STRIDE); bf16* WO = (bf16*)(A.ws + WS_WATT + (size_t)l * WATT_STRIDE + WATT_O); bf16* WR = (bf16*)(A.ws + WS_WATT + (size_t)l * WATT_STRIDE + WATT_R);
        if (r < nQ) { const int kb = r / 48, nb = r % 48; transpose_item(l == 0 ? A.in[I_FOX_WIN] : A.in[I_SB_WIN], l == 0 ? 3080 : 3072, 64 * kb, 64 * nb, WQKV, 1024, 64 * nb, 0, scr, lane); continue; } r -= nQ;
        if (r < nO) { const int kb = r / 16, nb = r % 16; transpose_item(l == 0 ? A.in[I_FOX_WO] : A.in[I_SB_WO], 1024, 64 * kb, 64 * nb, WO, 1024, 64 * nb, 0, scr, lane); continue; } r -= nO;
        if (r < nR) { const int kb = r >> 1, lo = r & 1; transpose_item(A.in[I_RW] + (size_t)l * 1024 * 64, 64, 64 * kb, 0, WR, 1024, lo ? 128 : 0, lo, scr, lane); continue; } r -= nR;
        { const int row = r < 64 ? 64 + r : 192 + (r - 64); unsigned zz = 0u; asm volatile("" : "+v"(zz)); v4u z = {zz, zz, zz, zz}; v4u* p = (v4u*)(WR + (size_t)row * 1024) + lane; p[0] = z; p[64] = z; }
    }
}
constexpr int CONV_PER_LAYER = 65 * 128 + 65 * 64, CONV_TOTAL = 2 * CONV_PER_LAYER;
__device__ __forceinline__ void convert_moe_item(const float* eg, const float* eu, const float* ed, const float* sg, const float* su, const float* sd, unsigned char* ws, int item, LAS unsigned short* scr, int lane) {
    const int l = item / CONV_PER_LAYER; int r = item % CONV_PER_LAYER;
    bf16* WGU = (bf16*)(ws + (l == 0 ? WS_WMOE0 : WS_WMOE1)); bf16* WD = (bf16*)(ws + (l == 0 ? WS_WMOE0 : WS_WMOE1) + WMOE_D);
    if (r < 65 * 128) { const int e = r / 128, r2 = r % 128, which = r2 / 64, r3 = r2 % 64, kb = r3 / 4, nb = r3 % 4, n0 = 64 * nb;
        const float* src;
        if (e < 64) { src = which ? eu : eg; src += (size_t)(l * 64 + e) * 1024 * 256; } else { src = which ? su : sg; src += (size_t)l * 1024 * 256; }
        transpose_item(src, 256, 64 * kb, n0, WGU, 1024, e * 512 + (n0 >> 7) * 256 + which * 128 + (n0 & 127), 0, scr, lane); return; }
    r -= 65 * 128;
    { const int e = r / 64, r2 = r % 64, kb = r2 / 16, nb = r2 % 16;
      const float* src;
      if (e < 64) src = ed + (size_t)(l * 64 + e) * 256 * 1024; else src = sd + (size_t)l * 256 * 1024;
      transpose_item(src, 1024, 64 * kb, 64 * nb, WD, 256, e * 1024 + 64 * nb, 0, scr, lane); }
}
__device__ __forceinline__ void convert_moe_drain(const float* eg, const float* eu, const float* ed, const float* sg, const float* su, const float* sd, unsigned char* ws, LAS unsigned char* lds, int wave) {
    asm volatile("" : "+s"(eg), "+s"(eu), "+s"(ed), "+s"(sg), "+s"(su), "+s"(sd));
    unsigned* q = (unsigned*)(ws + WS_CTL) + CW_CONVQ;
    LAS unsigned short* scr = (LAS unsigned short*)(lds + RING_OFF + wave * 16384);
    for (;;) {
        const int lane = lane_now(); int base = 0;
        if (lane == 0) base = (int)atomicAdd(q, 2u);
        base = __builtin_amdgcn_readfirstlane(base);
        if (base >= CONV_TOTAL) break;
        for (int i = 0; i < 2; ++i) if (base + i < CONV_TOTAL) convert_moe_item(eg, eu, ed, sg, su, sd, ws, base + i, scr, lane);
    }
}

__device__ __forceinline__ void input_pass(const Args& A, LAS unsigned char* lds, int gw, int NGW, int tid, int lane) {
    asm volatile("" : "+v"(tid), "+v"(lane));
    LAS float* Wf = (LAS float*)lds;
    const float* win = A.in[I_FOX_WIN];
    for (int i = tid; i < 8192; i += 512) { const int k = i >> 3, q = i & 7; Wf[q * 1024 + k] = win[(size_t)k * 3080 + 3072 + q]; }
    __syncthreads();
    const float* x = A.in[I_X]; const float* MOD = (const float*)(A.ws + WS_MOD); bf16* H = (bf16*)(A.ws + WS_H); float* LOGF = (float*)(A.ws + WS_LOGF);
    const float bfv = A.in[I_FOX_BF][(lane >> 3) & 7];
    double* BSUM = (double*)(A.ws + WS_BSUM);
    for (int rb = gw; rb < NTOK / 16; rb += NGW) {
        const int b = (rb * 16) >> 14; const float* modb = MOD + (size_t)(0 * 2 + b) * 6144;
        float sc[16], sh[16];
        double bs = 0.0;
#pragma unroll
        for (int j = 0; j < 2; ++j) { float a[8], c[8]; ld8f(modb + 1024 + 512 * j + 8 * lane, a); ld8f(modb + 512 * j + 8 * lane, c);
#pragma unroll
            for (int e = 0; e < 8; ++e) { sc[8 * j + e] = 1.f + a[e]; sh[8 * j + e] = c[e]; } }
        f32x4 xc[4], xn[4];
#pragma unroll
        for (int q = 0; q < 4; ++q) xc[q] = *(const f32x4*)(x + (size_t)(rb * 16) * 1024 + 512 * (q >> 1) + 8 * lane + 4 * (q & 1));
        for (int r = 0; r < 16; ++r) {
            const int t = rb * 16 + r; float h[16];
            { const int tn = rb * 16 + (r < 15 ? r + 1 : r);
#pragma unroll
              for (int q = 0; q < 4; ++q) xn[q] = *(const f32x4*)(x + (size_t)tn * 1024 + 512 * (q >> 1) + 8 * lane + 4 * (q & 1)); }
            __builtin_amdgcn_sched_barrier(0);
#pragma unroll
            for (int j = 0; j < 2; ++j) { float a[8]; a[0] = xc[2 * j].x; a[1] = xc[2 * j].y; a[2] = xc[2 * j].z; a[3] = xc[2 * j].w; a[4] = xc[2 * j + 1].x; a[5] = xc[2 * j + 1].y; a[6] = xc[2 * j + 1].z; a[7] = xc[2 * j + 1].w; float o[8];
#pragma unroll
                for (int e = 0; e < 8; ++e) { h[8 * j + e] = a[e] * sc[8 * j + e] + sh[8 * j + e]; o[e] = h[8 * j + e]; }
                st8bf(H + (size_t)t * 1024 + 512 * j + 8 * lane, o); }
            float fl[8];
#pragma unroll
            for (int q = 0; q < 8; ++q) { float s = 0.f;
#pragma unroll
                for (int j = 0; j < 2; ++j) { const LAS float* wp = Wf + q * 1024 + 512 * j + 8 * lane; const f32x4 w0 = *(const LAS f32x4*)wp, w1 = *(const LAS f32x4*)(wp + 4);
                    s += h[8 * j + 0] * w0.x + h[8 * j + 1] * w0.y + h[8 * j + 2] * w0.z + h[8 * j + 3] * w0.w + h[8 * j + 4] * w1.x + h[8 * j + 5] * w1.y + h[8 * j + 6] * w1.z + h[8 * j + 7] * w1.w; }
                fl[q] = s; }
            float mine;
            { const bool b5 = (lane & 32) != 0, b4 = (lane & 16) != 0, b3 = (lane & 8) != 0; float t4[4], t2[2];
#pragma unroll
              for (int i = 0; i < 4; ++i) { const float keep = b5 ? fl[4 + i] : fl[i], give = b5 ? fl[i] : fl[4 + i]; t4[i] = keep + __builtin_bit_cast(float, __builtin_amdgcn_ds_bpermute((lane ^ 32) << 2, __builtin_bit_cast(int, give))); }
#pragma unroll
              for (int i = 0; i < 2; ++i) { const float keep = b4 ? t4[2 + i] : t4[i], give = b4 ? t4[i] : t4[2 + i]; t2[i] = keep + __builtin_bit_cast(float, __builtin_amdgcn_ds_bpermute((lane ^ 16) << 2, __builtin_bit_cast(int, give))); }
              { const float keep = b3 ? t2[1] : t2[0], give = b3 ? t2[0] : t2[1]; mine = keep + __builtin_bit_cast(float, __builtin_amdgcn_ds_bpermute((lane ^ 8) << 2, __builtin_bit_cast(int, give))); }
#pragma unroll
              for (int o = 4; o > 0; o >>= 1) mine += __builtin_bit_cast(float, __builtin_amdgcn_ds_bpermute((lane ^ o) << 2, __builtin_bit_cast(int, mine))); }
            { const float lf = logsig(mine + bfv); bs += (double)lf; if ((lane & 7) == 0) LOGF[(size_t)t * 8 + (lane >> 3)] = lf; }
#pragma unroll
            for (int q = 0; q < 4; ++q) xc[q] = xn[q];
        }
        if ((lane & 7) == 0) BSUM[(size_t)rb * 8 + (lane >> 3)] = bs;
    }
    __syncthreads();
}

__device__ __forceinline__ double shfl_d(double v, int idx4) { const unsigned long long u = __builtin_bit_cast(unsigned long long, v);
    const unsigned lo = (unsigned)__builtin_amdgcn_ds_bpermute(idx4, (int)(unsigned)u), hi = (unsigned)__builtin_amdgcn_ds_bpermute(idx4, (int)(unsigned)(u >> 32));
    return __builtin_bit_cast(double, ((unsigned long long)hi << 32) | lo); }
__device__ __forceinline__ void fox_scan_seg(const Args& A, LAS unsigned char* lds, int task, int tid, int lane, int wave) {
    asm volatile("" : "+v"(tid), "+v"(lane));
    const float* LOGF = (const float*)(A.ws + WS_LOGF); float* F = (float*)(A.ws + WS_F); bf16* KAUG = (bf16*)(A.ws + WS_KAUG); const double* BSUM = (const double*)(A.ws + WS_BSUM);
    LAS double* red = (LAS double*)lds;
    const int bh = task >> 4, seg = task & 15, b = bh >> 3, h = bh & 7;
    double p = 0.0;
    for (int blk = tid; blk < seg * 64; blk += 512) p += BSUM[((size_t)b * 1024 + blk) * 8 + h];
#pragma unroll
    for (int o = 1; o < 64; o <<= 1) p += shfl_d(p, (lane ^ o) << 2);
    const int s0 = seg * 1024 + 2 * tid;
    const float a0 = LOGF[((size_t)b * SEQ + s0) * 8 + h], a1 = LOGF[((size_t)b * SEQ + s0 + 1) * 8 + h];
    const double loc = (double)a0 + (double)a1; double inc = loc;
#pragma unroll
    for (int o = 1; o < 64; o <<= 1) { const double up = shfl_d(inc, ((lane - o) & 63) << 2); if (lane >= o) inc += up; }
    if (lane == 63) red[8 + wave] = inc;
    if (lane == 0) red[wave] = p;
    __syncthreads();
    double run = 0.0;
#pragma unroll
    for (int w = 0; w < 8; ++w) run += red[w];
    for (int w = 0; w < wave; ++w) run += red[8 + w];
    run += inc - loc;
#pragma unroll
    for (int i = 0; i < 2; ++i) { run += (double)(i == 0 ? a0 : a1); const int s = s0 + i;
        const float f = (float)run; F[(size_t)bh * SEQ + s] = f;
        const float xv = -f / ATTN_SCALE; const unsigned hi = f2bf(xv); const float r1 = xv - __builtin_bit_cast(float, hi << 16); const unsigned mid = f2bf(r1);
        const float r2 = r1 - __builtin_bit_cast(float, mid << 16); const unsigned lo = f2bf(r2);
        v4u w; w.x = hi | (mid << 16); w.y = lo; w.z = 0u; w.w = 0u; *(v4u*)(KAUG + ((size_t)bh * SEQ + s) * 8) = w; }
    __syncthreads();
}

__device__ __forceinline__ void f8x16(const v4u w, float (&y)[16]) {
#pragma unroll
    for (int q = 0; q < 4; ++q) { const int d = (int)(q == 0 ? w.x : q == 1 ? w.y : q == 2 ? w.z : w.w);
        const auto lo = __builtin_amdgcn_cvt_pk_f32_fp8(d, false), hi = __builtin_amdgcn_cvt_pk_f32_fp8(d, true);
        y[4 * q + 0] = lo[0]; y[4 * q + 1] = lo[1]; y[4 * q + 2] = hi[0]; y[4 * q + 3] = hi[1]; }
}
__device__ __forceinline__ v4u ldnt(const void* p) { return __builtin_nontemporal_load((const v4u*)p); }
__device__ __forceinline__ void ld16f_nt(const float* p, float (&v)[16]) {
#pragma unroll
    for (int q = 0; q < 4; ++q) { const f32x4 a = __builtin_nontemporal_load((const f32x4*)(p + 4 * q)); v[4 * q] = a.x; v[4 * q + 1] = a.y; v[4 * q + 2] = a.z; v[4 * q + 3] = a.w; }
}
__device__ __forceinline__ void ld16bf_nt(const bf16* p, float (&v)[16]) {
#pragma unroll
    for (int q = 0; q < 2; ++q) { const v4u w = ldnt(p + 8 * q); v[8 * q + 0] = bflo(w.x); v[8 * q + 1] = bfhi(w.x); v[8 * q + 2] = bflo(w.y); v[8 * q + 3] = bfhi(w.y); v[8 * q + 4] = bflo(w.z); v[8 * q + 5] = bfhi(w.z); v[8 * q + 6] = bflo(w.w); v[8 * q + 7] = bfhi(w.w); }
}
__device__ __forceinline__ void ld16f(const float* p, float (&v)[16]) {
#pragma unroll
    for (int q = 0; q < 4; ++q) { const f32x4 a = *(const f32x4*)(p + 4 * q); v[4 * q] = a.x; v[4 * q + 1] = a.y; v[4 * q + 2] = a.z; v[4 * q + 3] = a.w; }
}
__device__ __forceinline__ void ld16bf(const bf16* p, float (&v)[16]) { float a[8], b[8]; ld8bf(p, a); ld8bf(p + 8, b);
#pragma unroll
    for (int e = 0; e < 8; ++e) { v[e] = a[e]; v[8 + e] = b[e]; } }
__device__ __forceinline__ void st16bf(bf16* p, const float (&v)[16]) { float a[8], b[8];
#pragma unroll
    for (int e = 0; e < 8; ++e) { a[e] = v[e]; b[e] = v[8 + e]; }
    st8bf(p, a); st8bf(p + 8, b); }
__device__ __forceinline__ void st16bf_nt(bf16* p, const float (&v)[16]) {
#pragma unroll
    for (int q = 0; q < 2; ++q) { v4u w; w.x = pg8::cvt_pk_bf16(v[8 * q], v[8 * q + 1]); w.y = pg8::cvt_pk_bf16(v[8 * q + 2], v[8 * q + 3]); w.z = pg8::cvt_pk_bf16(v[8 * q + 4], v[8 * q + 5]); w.w = pg8::cvt_pk_bf16(v[8 * q + 6], v[8 * q + 7]);
        __builtin_nontemporal_store(w, (v4u*)(p + 8 * q)); } }
__device__ __forceinline__ void ln1_pass(const Args& A, int l, int gw, int NGW, int lane) {
    asm volatile("" : "+v"(lane));
    const float* xin = A.in[I_X]; bf16* XB = (bf16*)(A.ws + WS_XB);
    const unsigned char* Y = (const unsigned char*)(A.ws + WS_Y); bf16* H = (bf16*)(A.ws + WS_H); const float* MOD = (const float*)(A.ws + WS_MOD);
    const float* gam_p = A.in[I_LNA_G] + l * 1024; const float* bet_p = A.in[I_LNA_B] + l * 1024;
    const int c0 = 16 * lane;
    for (int rb = gw; rb < NTOK / 16; rb += NGW) {
        const int b = (rb * 16) >> 14; const float* modb = MOD + (size_t)(l * 2 + b) * 6144;
        float gA[16], gam[16], bet[16], scm[16], shm[16];
        ld16f(modb + 2048 + c0, gA); ld16f(gam_p + c0, gam); ld16f(bet_p + c0, bet); ld16f(modb + 4096 + c0, scm); ld16f(modb + 3072 + c0, shm);
#pragma unroll
        for (int e = 0; e < 16; ++e) { gA[e] = (1.f + gA[e]) * (1.f / 16.f); scm[e] += 1.f; }
#define LN1_ISSUE(X0, X1, X2, X3, R0, R1, RY, t_) do { if (l == 0) { X0 = *(const f32x4*)(xin + (t_) * 1024 + c0); X1 = *(const f32x4*)(xin + (t_) * 1024 + c0 + 4); X2 = *(const f32x4*)(xin + (t_) * 1024 + c0 + 8); X3 = *(const f32x4*)(xin + (t_) * 1024 + c0 + 12); } \
            else { R0 = ldnt(XB + (t_) * 1024 + c0); R1 = ldnt(XB + (t_) * 1024 + c0 + 8); } RY = ldnt(Y + (t_) * 1024 + c0); } while (0)
        f32x4 cx0, cx1, cx2, cx3, nx0, nx1, nx2, nx3; v4u c0r, c1r, cyr, n0r, n1r, nyr;
        { float zf = 0.f; unsigned zz = 0u; asm volatile("" : "+v"(zf), "+v"(zz)); cx0 = (f32x4){zf, zf, zf, zf}; cx1 = cx0; cx2 = cx0; cx3 = cx0; nx0 = cx0; nx1 = cx0; nx2 = cx0; nx3 = cx0; c0r = (v4u){zz, zz, zz, zz}; c1r = c0r; n0r = c0r; n1r = c0r; }
        LN1_ISSUE(cx0, cx1, cx2, cx3, c0r, c1r, cyr, (size_t)rb * 16);
        for (int r = 0; r < 16; ++r) {
            const size_t t = (size_t)rb * 16 + r; float v[16], y[16];
            { const size_t tn = (size_t)rb * 16 + (r < 15 ? r + 1 : r); LN1_ISSUE(nx0, nx1, nx2, nx3, n0r, n1r, nyr, tn); }
            __builtin_amdgcn_sched_barrier(0);
            if (l == 0) {
#define F4(R, q) v[4 * q] = R.x; v[4 * q + 1] = R.y; v[4 * q + 2] = R.z; v[4 * q + 3] = R.w
                F4(cx0, 0); F4(cx1, 1); F4(cx2, 2); F4(cx3, 3);
#undef F4
            } else {
#define B8(R, q) v[8 * q] = bflo(R.x); v[8 * q + 1] = bfhi(R.x); v[8 * q + 2] = bflo(R.y); v[8 * q + 3] = bfhi(R.y); v[8 * q + 4] = bflo(R.z); v[8 * q + 5] = bfhi(R.z); v[8 * q + 6] = bflo(R.w); v[8 * q + 7] = bfhi(R.w)
                B8(c0r, 0); B8(c1r, 1);
#undef B8
            }
            f8x16(cyr, y);
            cx0 = nx0; cx1 = nx1; cx2 = nx2; cx3 = nx3; c0r = n0r; c1r = n1r; cyr = nyr;
            float s = 0.f;
#pragma unroll
            for (int e = 0; e < 16; ++e) { v[e] = ALPHA * v[e] + gA[e] * y[e]; s += v[e]; }
            const float mean = wave_sum(s, lane) * (1.f / 1024.f); float s2 = 0.f;
#pragma unroll
            for (int e = 0; e < 16; ++e) { v[e] -= mean; s2 += v[e] * v[e]; }
            const float rstd = 1.f / sqrtf(wave_sum(s2, lane) * (1.f / 1024.f) + LN_EPS);
            float o[16], hh[16];
#pragma unroll
            for (int e = 0; e < 16; ++e) { o[e] = v[e] * rstd * gam[e] + bet[e]; hh[e] = o[e] * scm[e] + shm[e]; }
            st16bf(XB + t * 1024 + c0, o); st16bf(H + t * 1024 + c0, hh);
        }
#undef LN1_ISSUE
    }
}

__device__ __forceinline__ void ln2_pass(const Args& A, LAS unsigned char* lds, int l, int hf, int c, int G, int wave, int r, int WL4, int lane) {
    asm volatile("" : "+v"(lane));
    float* xout = A.out; bf16* XB = (bf16*)(A.ws + WS_XB); const unsigned char* YR = (const unsigned char*)(A.ws + WS_YR); bf16* H = (bf16*)(A.ws + WS_H); const float* MOD = (const float*)(A.ws + WS_MOD);
    const int* SLOTOF = (const int*)(A.ws + WS_SLOTOF); const float* GATE = (const float*)(A.ws + WS_GATE);
    const LAS int* BBL = (const LAS int*)(lds + BBL_OFF) + hf * 68;
    const int shbase = __builtin_amdgcn_readfirstlane(BBL[64]) * 256;
    const float* gam_p = A.in[I_LNF_G] + l * 1024; const float* bet_p = A.in[I_LNF_B] + l * 1024;
    const float* modb = MOD + (size_t)(l * 2 + hf) * 6144; const float* modn = MOD + (size_t)(1 * 2 + hf) * 6144;
    const int c0 = 16 * lane;
    float gM[16], gam[16], bet[16];
    ld16f(modb + 5120 + c0, gM); ld16f(gam_p + c0, gam); ld16f(bet_p + c0, bet);
#pragma unroll
    for (int e = 0; e < 16; ++e) gM[e] = (1.f + gM[e]) * (1.f / 16.f);
    int sln[8]; float gwn[8];
    const int tw = r * 4 + (G - r) * WL4, cum0 = c < r ? c * 4 : r * 4 + (c - r) * WL4, cum1 = cum0 + (c < r ? 4 : WL4);
    const int row0 = __builtin_amdgcn_readfirstlane((int)((unsigned)(HTOK * cum0) / (unsigned)tw)), row1 = __builtin_amdgcn_readfirstlane((int)((unsigned)(HTOK * cum1) / (unsigned)tw));
    { const size_t t0 = (size_t)hf * HTOK + (row0 + wave < HTOK ? row0 + wave : 0);
      const int sv_ = SLOTOF[t0 * 8 + (lane & 7)], ss_ = BBL[sv_ >> 16] * 256 + (sv_ & 0xffff);
#pragma unroll
      for (int k = 0; k < 8; ++k) { sln[k] = __builtin_amdgcn_readlane(ss_, k); gwn[k] = __builtin_bit_cast(float, __builtin_amdgcn_readfirstlane(__builtin_bit_cast(int, GATE[t0 * 8 + k]))); } }
    for (int tl = row0 + wave; tl < row1; tl += NWAVES) {
        const size_t t = (size_t)hf * HTOK + tl;
        int sl[8]; float gw8[8];
#pragma unroll
        for (int k = 0; k < 8; ++k) { sl[k] = sln[k]; gw8[k] = gwn[k]; }
        { const int tn = tl + NWAVES < row1 ? tl + NWAVES : tl; const size_t t1 = (size_t)hf * HTOK + tn;
          const int sv_ = SLOTOF[t1 * 8 + (lane & 7)], ss_ = BBL[sv_ >> 16] * 256 + (sv_ & 0xffff);
#pragma unroll
          for (int k = 0; k < 8; ++k) { sln[k] = __builtin_amdgcn_readlane(ss_, k); gwn[k] = __builtin_bit_cast(float, __builtin_amdgcn_readfirstlane(__builtin_bit_cast(int, GATE[t1 * 8 + k]))); } }
        float v[16], ys[16], y[16];
        ld16bf_nt(XB + t * 1024 + c0, v);
        f8x16(ldnt(YR + ((size_t)shbase + tl) * 1024 + c0), ys);
#pragma unroll
        for (int k = 0; k < 8; ++k) { f8x16(ldnt(YR + (size_t)sl[k] * 1024 + c0), y);
#pragma unroll
            for (int e = 0; e < 16; ++e) ys[e] += gw8[k] * y[e]; }
        float s = 0.f;
#pragma unroll
        for (int e = 0; e < 16; ++e) { v[e] = ALPHA * v[e] + gM[e] * ys[e]; s += v[e]; }
        const float mean = wave_sum(s, lane) * (1.f / 1024.f); float s2 = 0.f;
#pragma unroll
        for (int e = 0; e < 16; ++e) { v[e] -= mean; s2 += v[e] * v[e]; }
        const float rstd = 1.f / sqrtf(wave_sum(s2, lane) * (1.f / 1024.f) + LN_EPS);
        float o[16];
#pragma unroll
        for (int e = 0; e < 16; ++e) o[e] = v[e] * rstd * gam[e] + bet[e];
        if (l == 1) {
#pragma unroll
            for (int q = 0; q < 4; ++q) *(f32x4*)(xout + t * 1024 + c0 + 4 * q) = (f32x4){o[4 * q], o[4 * q + 1], o[4 * q + 2], o[4 * q + 3]}; }
        else st16bf(XB + t * 1024 + c0, o);
        if (l == 0) { float h0[8], h1[8], scn[16], shn[16];
            { const float* mq = modn; asm volatile("" : "+s"(mq)); ld16f(mq + 1024 + c0, scn); ld16f(mq + c0, shn); }
#pragma unroll
            for (int e = 0; e < 8; ++e) { h0[e] = o[e] * (1.f + scn[e]) + shn[e]; h1[e] = o[8 + e] * (1.f + scn[8 + e]) + shn[8 + e]; }
            st8bf(H + t * 1024 + c0, h0); st8bf(H + t * 1024 + c0 + 8, h1); }
    }
}

__device__ __forceinline__ void build_block_tables(const unsigned* cnt, LAS unsigned char* lds, int wave, int lane) {
    asm volatile("" : "+v"(lane));
    LAS int* BT = (LAS int*)(lds + BT_OFF); LAS int* BBL = (LAS int*)(lds + BBL_OFF);
    if (wave < 2) { const int h = wave;
        const int n = (int)__hip_atomic_load(cnt + h * 64 + lane, __ATOMIC_RELAXED, __HIP_MEMORY_SCOPE_AGENT), nb = (n + 255) >> 8;
        int inc = nb;
#pragma unroll
        for (int o = 1; o < 64; o <<= 1) { const int up = __builtin_amdgcn_ds_bpermute(((lane - o) & 63) << 2, inc); if (lane >= o) inc += up; }
        const int excl = inc - nb, tot = __builtin_amdgcn_readlane(inc, 63);
        BBL[h * 68 + lane] = excl; if (lane == 0) { BBL[h * 68 + 64] = tot; BBL[h * 68 + 65] = tot + 64; }
        for (int j = 0; j < nb; ++j) BT[h * MAXBLK + excl + j] = lane | (j << 8);
        BT[h * MAXBLK + tot + lane] = 64 | (lane << 8);
    }
    __syncthreads();
}
constexpr int PH_PER_LAYER = 12, PH_BASE = 3, NPH = PH_BASE + DEPTH * PH_PER_LAYER;
#ifndef MK_PER_PHASE
#define MK_PER_PHASE 0
#endif

typedef const __attribute__((address_space(4))) Args* KArgsPtr;
__device__ __forceinline__ Args load_args() {
#if defined(__HIP_DEVICE_COMPILE__)
    KArgsPtr p = (KArgsPtr)__builtin_amdgcn_kernarg_segment_ptr(); asm volatile("" : "+s"(p));
    Args a;
#pragma unroll
    for (int i = 0; i < 21; ++i) a.in[i] = p->in[i];
    a.out = p->out; a.ws = p->ws; a.ph_lo = p->ph_lo; a.ph_hi = p->ph_hi; return a;
#else
    return Args{};
#endif
}
__global__ void __launch_bounds__(NWAVES * 64, 2) mk_fwd(Args args) {
    extern __shared__ __attribute__((aligned(16))) unsigned char lds_raw[];
    LAS unsigned char* lds = (LAS unsigned char*)lds_raw;
    volatile LAS unsigned* MISC = (volatile LAS unsigned*)(lds + MISC_OFF);
    const int wave = __builtin_amdgcn_readfirstlane((int)threadIdx.x >> 6);
    const int G = gridDim.x, bx = blockIdx.x; const int vcu = (G % 8 == 0) ? (bx % 8) * (G / 8) + bx / 8 : bx;
    const int gw = vcu * NWAVES + wave, NGW = G * NWAVES;
    unsigned* ctl = (unsigned*)(args.ws + WS_CTL);
    for (int u = wave * 64 + lane_now(); u < (LDS_BYTES - LDSCTL_OFF) / 4; u += NWAVES * 64) ((LAS unsigned*)(lds + LDSCTL_OFF))[u] = 0u;
    __syncthreads();
    const int lo = args.ph_lo, hi = args.ph_hi;
    XcdBarrier bar; bar.bar = ctl + CW_BAR; bar.x = 0; bar.st = MISC + 8; bar.wave = wave;
    if (hi - lo > 1) bar = xcd_barrier_post(ctl + CW_BAR, MISC + 8, wave);
#ifndef LN2_WL4
#define LN2_WL4 8
#endif
#ifndef PHMASK
#define PHMASK 0xFFFF
#endif
#define KIND(i) ((PHMASK >> (i)) & 1)
#define PH(k) (lo <= (k) && (k) < hi)
#define SEAM(k) do { if (PH(k) && PH((k) + 1)) { XcdBarrier _b = bar; asm volatile("" : "+s"(_b.bar)); xcd_barrier(_b); } } while (0)

    if (PH(0) && KIND(0)) { const Args A = load_args(); const int lane = lane_now(), tid = wave * 64 + lane; (void)tid; (void)lane; unsigned char* const ws = A.ws; (void)ws;
        convert_attn_weights(A, lds, gw, NGW, wave, lane);
        {
            const float* adaw = A.in[I_ADA_W]; const float* cv = A.in[I_C]; const float* adab = A.in[I_ADA_B]; float* MOD = (float*)(ws + WS_MOD);
            LAS float* sl = (LAS float*)(lds + 65536); LAS float* part = sl + 2048;
            __syncthreads();
            for (int i = tid; i < 2048; i += 512) { const float c0 = cv[i]; sl[i] = c0 / (1.f + expf(-c0)); }
            __syncthreads();
            for (int pb2 = bx; pb2 < 12288 / 48; pb2 += G) {
                const int jq = tid % 12, ks = tid / 12;
                const int pair = pb2 * 48 + 4 * jq, l = pair / 6144, j = pair % 6144;
                if (ks < 32) { f32x4 a0 = {0.f, 0.f, 0.f, 0.f}, a1 = a0;
#pragma unroll 1
                    for (int k0 = ks * 32; k0 < ks * 32 + 32; k0 += 16) { f32x4 w[16];
#pragma unroll
                        for (int i = 0; i < 16; ++i) w[i] = *(const f32x4*)(adaw + ((size_t)l * 1024 + k0 + i) * 6144 + j);
#pragma unroll
                        for (int i = 0; i < 16; ++i) { a0 += sl[k0 + i] * w[i]; a1 += sl[1024 + k0 + i] * w[i]; } }
#pragma unroll
                    for (int q = 0; q < 4; ++q) { part[(ks * 48 + 4 * jq + q) * 2] = a0[q]; part[(ks * 48 + 4 * jq + q) * 2 + 1] = a1[q]; } }
                __syncthreads();
                if (tid < 96) { const int jj = tid >> 1, b = tid & 1; const int pr = pb2 * 48 + jj, l2 = pr / 6144, j2 = pr % 6144; float s = adab[l2 * 6144 + j2];
                    for (int q = 0; q < 32; ++q) s += part[(q * 48 + jj) * 2 + b];
                    MOD[(size_t)(l2 * 2 + b) * 6144 + j2] = s; }
                __syncthreads();
            }
        }
    }
    SEAM(0);
    if (PH(2) && KIND(2)) { const Args A = load_args(); const int lane = lane_now(), tid = wave * 64 + lane; (void)tid; (void)lane; input_pass(A, lds, gw, NGW, tid, lane); }
    SEAM(2);

    for (int l = 0; l < DEPTH; ++l) {
        const int pb = PH_BASE + l * PH_PER_LAYER;
        if (PH(pb + 0) && KIND(3)) { const Args A = load_args(); const int lane = lane_now(), tid = wave * 64 + lane; (void)tid; (void)lane; unsigned char* const ws = A.ws; (void)ws;
            if (l == 0) { for (int task = bx; task < 256; task += G) fox_scan_seg(A, lds, task, tid, lane, wave); }
            pg8::Gemm g{(const bf16*)(ws + WS_H), (const bf16*)(ws + WS_WATT + (size_t)l * WATT_STRIDE), NTOK, 3 * DM, DM}; pg8::StaticOrder<NTOK / 256, 12> S; S.init(G, bx);
            pg8::EpiQKV E{(bf16*)(ws + WS_Q), (size_t)(WS_K - WS_Q) / 2, l == 0 ? ctl + CW_FOXQ + 16 : nullptr, (LAS float*)(lds + LDSCTL_OFF + 4096)};
            pg8::gemm_phase<pg8::EpiQKV, pg8::StaticOrder<NTOK / 256, 12>, true, false>(lds + RING_OFF, g, S, E, nullptr, wave);
        }
        SEAM(pb + 0);
        if (PH(pb + 1) && KIND(4)) { const Args A = load_args(); const int lane = lane_now(), tid = wave * 64 + lane; (void)tid; (void)lane; unsigned char* const ws = A.ws; (void)ws;
            if (l == 0) {
                const bool conv_first = ((bx >> 3) & 7) == 0;
                if (conv_first) { convert_moe_drain(A.in[I_EG], A.in[I_EU], A.in[I_ED], A.in[I_SG], A.in[I_SU], A.in[I_SD], ws, lds, wave); __syncthreads(); }
                fox::fox_phase((const bf16*)(ws + WS_Q), (const bf16*)(ws + WS_K), (const bf16*)(ws + WS_V), (const bf16*)(ws + WS_KAUG), (bf16*)(ws + WS_O), (const float*)(ws + WS_F), ctl + CW_FOXQ, (char*)lds_raw, wave); __syncthreads();
                convert_moe_drain(A.in[I_EG], A.in[I_EU], A.in[I_ED], A.in[I_SG], A.in[I_SU], A.in[I_SD], ws, lds, wave); __syncthreads(); }
            else { fox::sb_phase((const bf16*)(ws + WS_Q), (const bf16*)(ws + WS_K), (const bf16*)(ws + WS_V), (bf16*)(ws + WS_O), (char*)lds_raw, G, vcu, wave); __syncthreads(); }
        }
        SEAM(pb + 1);
        if (PH(pb + 2) && KIND(5)) { const Args A = load_args(); const int lane = lane_now(), tid = wave * 64 + lane; (void)tid; (void)lane; unsigned char* const ws = A.ws; (void)ws;
            pg8::Gemm g{(const bf16*)(ws + WS_O), (const bf16*)(ws + WS_WATT + (size_t)l * WATT_STRIDE + WATT_O), NTOK, DM, DM}; pg8::StaticOrder<NTOK / 256, 4> S; S.init(G, bx);
            pg8::EpiF8 E{(unsigned char*)(ws + WS_Y), DM, 0xffff};
            pg8::gemm_phase<pg8::EpiF8, pg8::StaticOrder<NTOK / 256, 4>, true, false>(lds + RING_OFF, g, S, E, nullptr, wave);
        }
        SEAM(pb + 2);
        if (PH(pb + 3) && KIND(6)) { const Args A = load_args(); const int lane = lane_now(), tid = wave * 64 + lane; (void)tid; (void)lane; ln1_pass(A, l, gw, NGW, lane); }
        SEAM(pb + 3);
        if (PH(pb + 4) && KIND(7)) { const Args A = load_args(); const int lane = lane_now(), tid = wave * 64 + lane; (void)tid; (void)lane; unsigned char* const ws = A.ws; (void)ws;
            pg8::Gemm g{(const bf16*)(ws + WS_H), (const bf16*)(ws + WS_WATT + (size_t)l * WATT_STRIDE + WATT_R), NTOK, 256, DM}; pg8::StaticOrder<NTOK / 256, 1> S; S.init(G, bx);
            pg8::EpiRouter E{A.in[I_RB] + l * 64, (float*)(ws + WS_GATE), ctl + CW_CNT + l * 128, (int*)(ws + WS_SLOTOF), (unsigned short*)(ws + WS_ROWTOK2)};
            pg8::gemm_phase<pg8::EpiRouter, pg8::StaticOrder<NTOK / 256, 1>, false, false>(lds + RING_OFF, g, S, E, nullptr, wave);
            __syncthreads();
        }
        SEAM(pb + 4);
        for (int hf = 0; hf < 2; ++hf) {
            const int ph = pb + 6 + 3 * hf;
            if (PH(ph) && KIND(9)) { const Args A = load_args(); const int lane = lane_now(), tid = wave * 64 + lane; (void)tid; (void)lane; unsigned char* const ws = A.ws; (void)ws;
                if (hf == 0) build_block_tables(ctl + CW_CNT + l * 128, lds, wave, lane);
                const int nblk = __builtin_amdgcn_readfirstlane(((const LAS int*)(lds + BBL_OFF))[hf * 68 + 65]);
                pg8::Gemm g{(const bf16*)(ws + WS_H) + (size_t)hf * HTOK * DM, (const bf16*)(ws + (l == 0 ? WS_WMOE0 : WS_WMOE1)), 0, 512, DM};
                pg8::MoeOrder S{nblk * 2, 1, G, vcu, (const LAS int*)(lds + BT_OFF) + hf * MAXBLK};
                pg8::EpiSwiglu E{(bf16*)(ws + WS_ACT)};
                pg8::gemm_phase<pg8::EpiSwiglu, pg8::MoeOrder, true, true>(lds + RING_OFF, g, S, E, (const unsigned short*)(ws + WS_ROWTOK2) + (size_t)hf * 65 * 16384, wave);
            }
            SEAM(ph);
            if (PH(ph + 1) && KIND(10)) { const Args A = load_args(); const int lane = lane_now(), tid = wave * 64 + lane; (void)tid; (void)lane; unsigned char* const ws = A.ws; (void)ws;
                const int nblk = __builtin_amdgcn_readfirstlane(((const LAS int*)(lds + BBL_OFF))[hf * 68 + 65]);
                pg8::Gemm g{(const bf16*)(ws + WS_ACT), (const bf16*)(ws + (l == 0 ? WS_WMOE0 : WS_WMOE1) + WMOE_D), 0, 1024, FE};
                pg8::MoeOrder S{nblk * 4, 2, G, vcu, (const LAS int*)(lds + BT_OFF) + hf * MAXBLK};
                pg8::EpiF8 E{(unsigned char*)(ws + WS_YR), DM, 3};
                pg8::gemm_phase<pg8::EpiF8, pg8::MoeOrder, true, false>(lds + RING_OFF, g, S, E, nullptr, wave);
            }
            SEAM(ph + 1);
            if (PH(ph + 2) && KIND(11)) { const Args A = load_args(); const int lane = lane_now(), tid = wave * 64 + lane; (void)tid; (void)lane; unsigned char* const ws = A.ws; (void)ws;
                int r = G, wl4 = 4;
                if (hf == 0) { const int nun = __builtin_amdgcn_readfirstlane(((const LAS int*)(lds + BBL_OFF))[1 * 68 + 65]) * 2; r = nun % G; wl4 = LN2_WL4; }
                ln2_pass(A, lds, l, hf, vcu, G, wave, r, wl4, lane);
            }
            if (hf == 1) SEAM(ph + 2);
        }
    }
#undef PH
#undef SEAM
}

extern "C" void kernel_launch(void* const* d_in, const int* in_sizes, int n_in, void* d_out, int out_size, void* d_ws, size_t ws_size, hipStream_t stream) {
    static int grid = 0;
    if (grid == 0) {
        if (n_in != 21 || in_sizes[0] != NTOK * DM || out_size != NTOK * DM || ws_size < WS_END) {
            fprintf(stderr, "kernel_launch: unexpected shapes (n_in %d, in0 %d, out %d, ws %zu < %zu); nothing launched\n", n_in, n_in > 0 ? in_sizes[0] : -1, out_size, ws_size, (size_t)WS_END); grid = -1; return; }
        int dev = 0, cus = 0;
        if (hipGetDevice(&dev) != hipSuccess || hipDeviceGetAttribute(&cus, hipDeviceAttributeMultiprocessorCount, dev) != hipSuccess) { grid = -1; return; }
        if (hipFuncSetAttribute((const void*)mk_fwd, hipFuncAttributeMaxDynamicSharedMemorySize, LDS_BYTES) != hipSuccess) { fprintf(stderr, "kernel_launch: hipFuncSetAttribute failed\n"); grid = -1; return; }
        int per_cu = 0;
        if (hipOccupancyMaxActiveBlocksPerMultiprocessor(&per_cu, (const void*)mk_fwd, NWAVES * 64, LDS_BYTES) != hipSuccess || per_cu < 1) { fprintf(stderr, "kernel_launch: occupancy query reports %d\n", per_cu); }
        (void)hipGetLastError();
        grid = cus;
        if (grid < 128) { fprintf(stderr, "kernel_launch: needs >= 128 CUs\n"); grid = -1; return; }
    }
    if (grid < 0) return;
    if (hipMemsetAsync((char*)d_ws + WS_CTL, 0, CTL_ZERO_BYTES, stream) != hipSuccess) return;
    Args a{};
    for (int i = 0; i < 21; ++i) a.in[i] = (const float*)d_in[i];
    a.out = (float*)d_out; a.ws = (unsigned char*)d_ws;
#if MK_PER_PHASE
    for (int p = 0; p < NPH; ++p) { a.ph_lo = p; a.ph_hi = p + 1; hipLaunchKernelGGL(mk_fwd, dim3(grid), dim3(NWAVES * 64), LDS_BYTES, stream, a); }
#else
    a.ph_lo = 0; a.ph_hi = NPH;
    hipLaunchKernelGGL(mk_fwd, dim3(grid), dim3(NWAVES * 64), LDS_BYTES, stream, a);
#endif
}
```

```cpp
#include <hip/hip_runtime.h>
#include <cstdio>
#include <cstdint>
#include <cmath>
__device__ __forceinline__ int lane_now() { int l; asm volatile("v_mbcnt_lo_u32_b32 %0, -1, 0\n\tv_mbcnt_hi_u32_b32 %0, -1, %0" : "=v"(l)); return l; }
namespace pg8 {
#define PG8_LAS __attribute__((address_space(3)))
typedef unsigned short bf16_t;
typedef short bf16x8 __attribute__((ext_vector_type(8)));
typedef float f32x4 __attribute__((ext_vector_type(4)));
typedef unsigned u32x4 __attribute__((ext_vector_type(4)));
constexpr int RTL_OFF = 131072 + 8192;
constexpr int BM = 256, BK = 64, HALF = 128, HTB = HALF * BK * 2  , STAGE_BYTES = 8 * HTB, NXCD = 8, WGM = 8;

__host__ __device__ __forceinline__ int lds_byte(int r, int c) { const int st = (r >> 4) * 2 + (c >> 5), rr = r & 15, cc = c & 31, ob = rr * 64 + cc * 2; return st * 1024 + (ob ^ (((ob >> 9) & 1) << 5)); }
__host__ __device__ __forceinline__ void stage_rc(int b, int& R, int& C) { const int st = b / 1024, sb = b % 1024, swz = sb ^ (((sb >> 9) & 1) << 5); R = (st >> 1) * 16 + swz / 64; C = (st & 1) * 32 + (swz % 64) / 2; }
__host__ __device__ __forceinline__ int perm32(int rho) { const int n = rho >> 4, i = rho & 15; return 8 * (i >> 2) + 4 * n + (i & 3); }

struct Unit { int pm, pn, aux; };
struct Gemm { const bf16_t* A; const bf16_t* Bt; int M, N, K; };

template <int NM, int NN> struct StaticOrder {
    int G, c;
    __host__ __device__ void init(int G_, int c_) { G = G_; c = c_; }
    __host__ __device__ bool next(int i, Unit& u) const {
        constexpr int nwg = NM * NN;
        const int L = i * G + c; if (L >= nwg) return false;
        int wgid = L; { constexpr int q = nwg / NXCD, r = nwg % NXCD; const int xcd = wgid % NXCD, off = wgid / NXCD; wgid = (xcd < r ? xcd * (q + 1) : r * (q + 1) + (xcd - r) * q) + off; }
        constexpr int nig = WGM * NN; const int gid = wgid / nig, fm = gid * WGM, gsz = (NM - fm) < WGM ? (NM - fm) : WGM;
        u.pm = fm + ((wgid % nig) % gsz); u.pn = (wgid % nig) / gsz; u.aux = 0; return true;
    }
};
struct MoeOrder {
    int nunits, sh, G, c; const PG8_LAS int* bt;
    __device__ __forceinline__ bool next(int i, Unit& u) const {
        const long L = (long)i * G + c; if (L >= nunits) return false;
        const int blk = (int)(L >> sh), pnl = (int)L & ((1 << sh) - 1);
        const int v = __builtin_amdgcn_readfirstlane(bt[blk]);
        u.pm = blk; u.pn = ((v & 255) << sh) + pnl; u.aux = v; return true;
    }
};

__device__ __forceinline__ unsigned cvt_pk_bf16(float lo, float hi) { unsigned r; asm volatile("v_cvt_pk_bf16_f32 %0, %1, %2" : "=v"(r) : "v"(lo), "v"(hi)); return r; }


struct EpiBf16 {
    static constexpr int PERMW = 1; static constexpr bool AFTER_DRAIN = false;
    bf16_t* O; int ldc; int pn_mask;
    __device__ __forceinline__ void operator()(const f32x4 (&acc)[2][2][4][2], const Unit& u, int wr, int wc, int fr, int fq) const {
        { const int tz = lane_now(); fr = tz & 15; fq = (tz >> 4) & 3; }
        char* base = (char*)(O + (size_t)(u.pm * BM + wr * 64) * ldc + (u.pn & pn_mask) * BM + wc * 32);
        const unsigned lo = (unsigned)(fr * ldc + 8 * fq) * 2u;
#pragma unroll
        for (int ai = 0; ai < 2; ++ai)
#pragma unroll
            for (int m = 0; m < 4; ++m)
#pragma unroll
                for (int bj = 0; bj < 2; ++bj) { const f32x4 v0 = acc[ai][bj][m][0], v1 = acc[ai][bj][m][1];
                    u32x4 w; w.x = cvt_pk_bf16(v0[0], v0[1]); w.y = cvt_pk_bf16(v0[2], v0[3]); w.z = cvt_pk_bf16(v1[0], v1[1]); w.w = cvt_pk_bf16(v1[2], v1[3]);
                    *(u32x4*)(base + (size_t)(lo + (unsigned)(((ai * HALF + m * 16) * ldc + bj * HALF) * 2))) = w; }
    }
};
struct EpiQKV {
    static constexpr int PERMW = 1; static constexpr bool AFTER_DRAIN = false;
    bf16_t* Q; size_t qkv_stride;
    unsigned* nrm; PG8_LAS float* rs;
    __device__ __forceinline__ void operator()(const f32x4 (&acc)[2][2][4][2], const Unit& u, int wr, int wc, int fr, int fq) const {
        const int lz = lane_now(); fr = lz & 15; fq = (lz >> 4) & 3;
        const int which = u.pn >> 2; bf16_t* base = Q + (size_t)which * qkv_stride;
        const int r0 = u.pm * BM + wr * 64 + fr, b = r0 >> 14, s0 = r0 & 16383;
        const bool norms = nrm != nullptr && which == 1;
        if (norms) { rs[wr * 256 + wc * 64 + lz] = 0.f; asm volatile("s_waitcnt lgkmcnt(0)" ::: "memory"); __builtin_amdgcn_s_barrier(); }
#pragma unroll
        for (int ai = 0; ai < 2; ++ai)
#pragma unroll
            for (int m = 0; m < 4; ++m) { const int s = s0 + ai * HALF + m * 16;
#pragma unroll
                for (int bj = 0; bj < 2; ++bj) { const int head = 2 * (u.pn & 3) + bj;
                    bf16_t* p = base + ((size_t)(b * 8 + head) * 16384 + s) * 128 + wc * 32 + 8 * fq;
                    const f32x4 v0 = acc[ai][bj][m][0], v1 = acc[ai][bj][m][1];
                    u32x4 w; w.x = cvt_pk_bf16(v0[0], v0[1]); w.y = cvt_pk_bf16(v0[2], v0[3]); w.z = cvt_pk_bf16(v1[0], v1[1]); w.w = cvt_pk_bf16(v1[2], v1[3]);
                    *(u32x4*)p = w;
                    if (norms) { float ss = 0.f;
#pragma unroll
                        for (int q = 0; q < 4; ++q) { const unsigned d = q == 0 ? w.x : q == 1 ? w.y : q == 2 ? w.z : w.w; const float lo = __builtin_bit_cast(float, d << 16), hi = __builtin_bit_cast(float, d & 0xffff0000u); ss += lo * lo + hi * hi; }
                        ss += __builtin_bit_cast(float, __builtin_amdgcn_ds_bpermute((lz ^ 16) << 2, __builtin_bit_cast(int, ss)));
                        ss += __builtin_bit_cast(float, __builtin_amdgcn_ds_bpermute((lz ^ 32) << 2, __builtin_bit_cast(int, ss)));
                        if (fq == 0) (void)__hip_atomic_fetch_add(rs + (ai * HALF + wr * 64 + m * 16 + fr) * 2 + bj, ss, __ATOMIC_RELAXED, __HIP_MEMORY_SCOPE_WORKGROUP); } } }
        if (norms) { asm volatile("s_waitcnt lgkmcnt(0)" ::: "memory"); __builtin_amdgcn_s_barrier();
            float mx = rs[wr * 256 + wc * 64 + lz];
#pragma unroll
            for (int o = 2; o < 64; o <<= 1) mx = fmaxf(mx, __builtin_bit_cast(float, __builtin_amdgcn_ds_bpermute((lz ^ o) << 2, __builtin_bit_cast(int, mx))));
            if (lz < 2) { const int bh = b * 8 + 2 * (u.pn & 3) + lz;
                atomicMax(nrm + bh, __builtin_bit_cast(unsigned, mx * 1.001f)); }
            asm volatile("s_waitcnt lgkmcnt(0)" ::: "memory"); __builtin_amdgcn_s_barrier(); }
    }
};
__device__ __forceinline__ float silu_f(float g) { return g * __builtin_amdgcn_rcpf(1.0f + __builtin_amdgcn_exp2f(-1.4426950408889634f * g)); }
struct EpiSwiglu {
    static constexpr int PERMW = 1; static constexpr bool AFTER_DRAIN = false;
    bf16_t* ACT;
    __device__ __forceinline__ void operator()(const f32x4 (&acc)[2][2][4][2], const Unit& u, int wr, int wc, int fr, int fq) const {
        { const int tz = lane_now(); fr = tz & 15; fq = (tz >> 4) & 3; }
        const int row0 = u.pm * BM + wr * 64 + fr; const int col0 = (u.pn & 1) * 128 + wc * 32 + 8 * fq;
#pragma unroll
        for (int ai = 0; ai < 2; ++ai)
#pragma unroll
            for (int m = 0; m < 4; ++m) { bf16_t* rowp = ACT + (size_t)(row0 + ai * HALF + m * 16) * 256 + col0;
                const f32x4 g0 = acc[ai][0][m][0], g1 = acc[ai][0][m][1], u0 = acc[ai][1][m][0], u1 = acc[ai][1][m][1];
                float a[8];
#pragma unroll
                for (int j = 0; j < 4; ++j) { a[j] = silu_f(g0[j]) * u0[j]; a[4 + j] = silu_f(g1[j]) * u1[j]; }
                u32x4 w; w.x = cvt_pk_bf16(a[0], a[1]); w.y = cvt_pk_bf16(a[2], a[3]); w.z = cvt_pk_bf16(a[4], a[5]); w.w = cvt_pk_bf16(a[6], a[7]);
                *(u32x4*)rowp = w; }
    }
};
struct EpiF8 {
    static constexpr int PERMW = 2; static constexpr bool AFTER_DRAIN = false;
    unsigned char* O; int ldc; int pn_mask;
    __device__ __forceinline__ void operator()(const f32x4 (&acc)[2][2][4][2], const Unit& u, int wr, int wc, int fr, int fq) const {
        { const int tz = lane_now(); fr = tz & 15; fq = (tz >> 4) & 3; }
        char* base = (char*)(O + (size_t)(u.pm * BM + wr * 64) * ldc + (u.pn & pn_mask) * BM + wc * 64);
        const unsigned lo = (unsigned)(fr * ldc + 16 * fq);
#pragma unroll
        for (int ai = 0; ai < 2; ++ai)
#pragma unroll
            for (int m = 0; m < 4; ++m) { u32x4 w;
                { const f32x4 a = acc[ai][0][m][0] * 16.f, b = acc[ai][0][m][1] * 16.f; int t = 0; t = __builtin_amdgcn_cvt_pk_fp8_f32(a[0], a[1], t, false); t = __builtin_amdgcn_cvt_pk_fp8_f32(a[2], a[3], t, true); w.x = (unsigned)t;
                  int t2 = 0; t2 = __builtin_amdgcn_cvt_pk_fp8_f32(b[0], b[1], t2, false); t2 = __builtin_amdgcn_cvt_pk_fp8_f32(b[2], b[3], t2, true); w.y = (unsigned)t2; }
                { const f32x4 a = acc[ai][1][m][0] * 16.f, b = acc[ai][1][m][1] * 16.f; int t = 0; t = __builtin_amdgcn_cvt_pk_fp8_f32(a[0], a[1], t, false); t = __builtin_amdgcn_cvt_pk_fp8_f32(a[2], a[3], t, true); w.z = (unsigned)t;
                  int t2 = 0; t2 = __builtin_amdgcn_cvt_pk_fp8_f32(b[0], b[1], t2, false); t2 = __builtin_amdgcn_cvt_pk_fp8_f32(b[2], b[3], t2, true); w.w = (unsigned)t2; }
                __builtin_nontemporal_store(w, (u32x4*)(base + (size_t)(lo + (unsigned)((ai * HALF + m * 16) * ldc)))); }
    }
};
struct EpiRouter {
    static constexpr int PERMW = 0; static constexpr bool AFTER_DRAIN = true;
    const float* rbias; float* gate; unsigned* cnt; int* slotof; unsigned short* rowtok2;
    __device__ __forceinline__ void fused(const f32x4 (&acc)[2][2][4][2], const Unit& u, int wr, int wc, int fr, int fq, PG8_LAS unsigned char* lds, int wid, int lane) const {
        PG8_LAS float* L = (PG8_LAS float*)lds;
        PG8_LAS float* Bs = (PG8_LAS float*)(lds + 256 * 65 * 4);
        PG8_LAS unsigned* H = (PG8_LAS unsigned*)(lds + 256 * 65 * 4 + 256);
        PG8_LAS unsigned* GB = H + 64;
        { const int tz = lane_now(); lane = tz; fr = tz & 15; fq = (tz >> 4) & 3; }
        const int tid = wid * 64 + lane;
        if (tid < 64) { Bs[tid] = rbias[tid]; H[tid] = 0u; }
        if (wc < 2) {
#pragma unroll
            for (int ai = 0; ai < 2; ++ai)
#pragma unroll
                for (int m = 0; m < 4; ++m)
#pragma unroll
                    for (int n = 0; n < 2; ++n) { const int row = 128 * ai + 64 * wr + 16 * m + fr, col = 32 * wc + 16 * n + 4 * fq;
                        const f32x4 v = acc[ai][0][m][n] + acc[ai][1][m][n];
                        L[row * 65 + col + 0] = v[0]; L[row * 65 + col + 1] = v[1]; L[row * 65 + col + 2] = v[2]; L[row * 65 + col + 3] = v[3]; }
        }
        __syncthreads();
        const int half = (u.pm * BM) >> 14;
        int si[8]; unsigned lr[8];
        if (tid < 256) {
            const int t = u.pm * BM + tid; PG8_LAS float* Lr = L + tid * 65;
            for (int e = 0; e < 64; ++e) { const float x = Lr[e]; Lr[e] = 1.0f / (1.0f + expf(-x)) + Bs[e]; }
            float sv[8]; float sum = 0.f;
#pragma unroll
            for (int p = 0; p < 8; ++p) { float bv = -3.0e38f; int bi = 0;
                for (int e = 0; e < 64; ++e) { const float x = Lr[e]; if (x > bv) { bv = x; bi = e; } }
                si[p] = bi; sv[p] = bv - Bs[bi]; sum += sv[p]; Lr[bi] = -3.0e38f; }
            const float inv = 2.5f / sum;
#pragma unroll
            for (int p = 0; p < 8; ++p) { gate[(size_t)t * 8 + p] = sv[p] * inv; lr[p] = atomicAdd((unsigned*)&H[si[p]], 1u); }
        }
        __syncthreads();
        if (tid < 64) { const unsigned h = H[tid]; GB[tid] = h ? atomicAdd(cnt + half * 64 + tid, h) : 0u; }
        __syncthreads();
        if (tid < 256) {
            const int t = u.pm * BM + tid, tl = t - half * 16384;
#pragma unroll
            for (int p = 0; p < 8; ++p) { const unsigned pos = GB[si[p]] + lr[p];
                slotof[(size_t)t * 8 + p] = (int)(((unsigned)si[p] << 16) | pos);
                rowtok2[((size_t)(half * 65 + si[p]) << 14) + pos] = (unsigned short)tl; }
            rowtok2[((size_t)(half * 65 + 64) << 14) + tl] = (unsigned short)tl;
        }
    }
};

template <class Epi, class Sched, bool ALIGN_EPI, bool GATHER>
__device__ __forceinline__ void gemm_phase(PG8_LAS unsigned char* lds, const Gemm g, const Sched& S, const Epi& E, const unsigned short* __restrict__ rowtok, int wave) {
    const int wid = wave, lane = lane_now(), tid = wid * 64 + lane;
    const int wr = wid >> 2, wc = wid & 3, fr = lane & 15, fq = lane >> 4;
    const int K = g.K, nt = K / BK;
    unsigned voffB[2];
#pragma unroll
    for (int i = 0; i < 2; ++i) { int R, C; stage_rc(tid * 16 + i * 8192, R, C); const int Rb = Epi::PERMW == 1 ? ((R & ~31) + perm32(R & 31)) : Epi::PERMW == 2 ? (64 * (R >> 5) + 16 * ((R & 15) >> 2) + 4 * ((R >> 4) & 1) + (R & 3)) : R;
        voffB[i] = (unsigned)(Rb * K + C) * 2u; }
    const size_t kstep = (size_t)(BK * 2);
    const size_t hstep = (size_t)HALF * K * 2;
    const size_t tstep = 2 * hstep;
    const size_t bstep = Epi::PERMW == 2 ? (size_t)8 * K * 2 : hstep;
    const unsigned ldsw = (unsigned)wid * 1024u;
    const int aoff = lds_byte(wr * 64 + fr, fq * 8), boff = lds_byte(wc * 32 + fr, fq * 8);
#define PG8_SA(b, h) (((b) * 2 + (h)) * HTB)
#define PG8_SB(b, h) ((4 + (b) * 2 + (h)) * HTB)
#define PG8_STAGE_B(bufoff, gbase) do { _Pragma("unroll") for (int _i = 0; _i < 2; ++_i) \
        __builtin_amdgcn_global_load_lds((const unsigned*)((const char*)(gbase) + voffB[_i]), (PG8_LAS unsigned*)(lds + (bufoff) + ldsw + _i * 8192), 16, 0, 0); } while (0)
#define PG8_STAGE_A(bufoff, gbase, h, OFFS) do { const char* _gb = (const char*)(gbase) + (GATHER ? (size_t)0 : (size_t)(h) * hstep); \
        __builtin_amdgcn_global_load_lds((const unsigned*)(_gb + (GATHER ? OFFS[h][0] : OFFS[0][0])), (PG8_LAS unsigned*)(lds + (bufoff) + ldsw), 16, 0, 0); \
        __builtin_amdgcn_global_load_lds((const unsigned*)(_gb + (GATHER ? OFFS[h][1] : OFFS[0][1])), (PG8_LAS unsigned*)(lds + (bufoff) + ldsw + 8192), 16, 0, 0); } while (0)
#define PG8_LDA(dst, b, h) do { _Pragma("unroll") for (int m = 0; m < 4; ++m) _Pragma("unroll") for (int k = 0; k < 2; ++k) dst[m][k] = *(const PG8_LAS bf16x8*)(lds + PG8_SA(b, h) + aoff + m * 2048 + k * 1024); } while (0)
#define PG8_LDB(dst, b, h) do { _Pragma("unroll") for (int n = 0; n < 2; ++n) _Pragma("unroll") for (int k = 0; k < 2; ++k) dst[n][k] = *(const PG8_LAS bf16x8*)(lds + PG8_SB(b, h) + boff + n * 2048 + k * 1024); } while (0)
#define PG8_MMA(ai, bj, At, Bt) do { __builtin_amdgcn_s_setprio(1); _Pragma("unroll") for (int m = 0; m < 4; ++m) _Pragma("unroll") for (int n = 0; n < 2; ++n) _Pragma("unroll") for (int k = 0; k < 2; ++k) \
        acc[ai][bj][m][n] = __builtin_amdgcn_mfma_f32_16x16x32_bf16(Bt[n][k], At[m][k], acc[ai][bj][m][n], 0, 0, 0); __builtin_amdgcn_s_setprio(0); } while (0)
#define PG8_WAIT_V(n) asm volatile("s_waitcnt vmcnt(" #n ")" ::: "memory")
#define PG8_WAIT_L(n) asm volatile("s_waitcnt lgkmcnt(" #n ")" ::: "memory")
#define PG8_BAR __builtin_amdgcn_s_barrier()
#define PG8_SCHED __builtin_amdgcn_sched_barrier(0)
#define PG8_VA(dst, U) do { const int _tz = wid * 64 + lane_now(); _Pragma("unroll") for (int _i = 0; _i < 2; ++_i) { int _R, _C; stage_rc(_tz * 16 + _i * 8192, _R, _C); \
        _Pragma("unroll") for (int _h = 0; _h < 2; ++_h) { \
        if constexpr (GATHER) dst[_h][_i] = (unsigned)rowtok[(((U).aux & 255) << 14) + ((U).aux >> 8) * BM + _h * HALF + _R] * (unsigned)(K * 2) + (unsigned)(_C * 2); \
        else dst[_h][_i] = (unsigned)(_R * K + _C) * 2u; } } } while (0)
#define PG8_VA_LDS(dst) do { int _R, _C; stage_rc((wid * 64 + lane_now()) * 16, _R, _C); const PG8_LAS unsigned short* _rp = (const PG8_LAS unsigned short*)(lds + RTL_OFF) + _R;     \
        const unsigned _cb = (unsigned)(_C * 2), _ks = (unsigned)(K * 2); dst[0][0] = _rp[0] * _ks + _cb; dst[0][1] = _rp[64] * _ks + _cb; dst[1][0] = _rp[128] * _ks + _cb; dst[1][1] = _rp[192] * _ks + _cb; } while (0)
    Unit cur, nxt; int ui = 0;
    if (!S.next(0, cur)) return;
    f32x4 acc[2][2][4][2];
#pragma unroll
    for (int a = 0; a < 2; ++a)
#pragma unroll
        for (int b = 0; b < 2; ++b)
#pragma unroll
            for (int m = 0; m < 4; ++m)
#pragma unroll
                for (int n = 0; n < 2; ++n) acc[a][b][m][n] = (f32x4){0.f, 0.f, 0.f, 0.f};
    bf16x8 At[4][2], B0[2][2], B1[2][2];
    unsigned vaC[2][2], vaN[2][2];
    PG8_VA(vaC, cur);
    const char* cA = GATHER ? (const char*)g.A : (const char*)g.A + (size_t)cur.pm * tstep; const char* cB = (const char*)g.Bt + (size_t)cur.pn * tstep;
    PG8_STAGE_B(PG8_SB(0, 0), cB); PG8_STAGE_B(PG8_SB(0, 1), cB + bstep); PG8_STAGE_A(PG8_SA(0, 0), cA, 0, vaC); PG8_STAGE_A(PG8_SA(0, 1), cA, 1, vaC);
    if (wr == 1) PG8_BAR;
    PG8_WAIT_V(2); PG8_BAR;
    PG8_STAGE_B(PG8_SB(1, 0), cB + kstep); PG8_STAGE_A(PG8_SA(1, 0), cA + kstep, 0, vaC); PG8_STAGE_B(PG8_SB(1, 1), cB + bstep + kstep);
    PG8_WAIT_V(6); PG8_BAR;
    for (;;) {
        const bool has_next = S.next(ui + 1, nxt);
        const char* nA = GATHER ? (const char*)g.A : (has_next ? (const char*)g.A + (size_t)nxt.pm * tstep : cA); const char* nB = has_next ? (const char*)g.Bt + (size_t)nxt.pn * tstep : cB;
        if constexpr (GATHER) {
            if (has_next && wid < 2) __builtin_amdgcn_global_load_lds((const unsigned*)(rowtok + ((nxt.aux & 255) << 14) + (nxt.aux >> 8) * BM) + wid * 64 + lane_now(), (PG8_LAS unsigned*)(lds + RTL_OFF + wid * 256), 4, 0, 0); }
#pragma unroll
        for (int h = 0; h < 2; ++h)
#pragma unroll
            for (int i = 0; i < 2; ++i) vaN[h][i] = vaC[h][i];
#pragma nounroll
        for (int t = 0; t < nt; t += 2) {
            const bool last = (t == nt - 2);
            const char* a1 = cA + (size_t)(t + 1) * kstep;
            const char* a2 = last ? nA : cA + (size_t)(t + 2) * kstep; const char* b2 = last ? nB : cB + (size_t)(t + 2) * kstep;
            const char* a3 = a2 + kstep; const char* b3 = b2 + kstep;
            if constexpr (GATHER) { if (last && has_next) { PG8_VA_LDS(vaN); } }
            unsigned o2[2][2];
#pragma unroll
            for (int h = 0; h < 2; ++h)
#pragma unroll
                for (int i = 0; i < 2; ++i) o2[h][i] = (GATHER && last) ? vaN[h][i] : vaC[h][i];
            PG8_LDB(B0, 0, 0); PG8_LDB(B1, 0, 1); PG8_SCHED; PG8_LDA(At, 0, 0); PG8_STAGE_A(PG8_SA(1, 1), a1, 1, vaC);
            PG8_WAIT_V(8); PG8_WAIT_L(0); PG8_BAR; PG8_MMA(0, 0, At, B0); PG8_MMA(0, 1, At, B1); PG8_BAR; PG8_SCHED;
            PG8_LDA(At, 0, 1); PG8_STAGE_B(PG8_SB(0, 0), b2); PG8_STAGE_B(PG8_SB(0, 1), b2 + bstep); PG8_STAGE_A(PG8_SA(0, 0), a2, 0, o2);
            PG8_WAIT_V(8); PG8_WAIT_L(0); PG8_BAR; PG8_MMA(1, 0, At, B0); PG8_MMA(1, 1, At, B1); PG8_BAR; PG8_SCHED;
            PG8_LDB(B0, 1, 0); PG8_LDB(B1, 1, 1); PG8_SCHED; PG8_LDA(At, 1, 0); PG8_STAGE_A(PG8_SA(0, 1), a2, 1, o2);
            PG8_WAIT_V(8); PG8_WAIT_L(0); PG8_BAR; PG8_MMA(0, 0, At, B0); PG8_MMA(0, 1, At, B1); PG8_BAR; PG8_SCHED;
            PG8_LDA(At, 1, 1); PG8_STAGE_B(PG8_SB(1, 0), b3); PG8_STAGE_B(PG8_SB(1, 1), b3 + bstep); PG8_STAGE_A(PG8_SA(1, 0), a3, 0, o2);
            PG8_WAIT_V(8); PG8_WAIT_L(0); PG8_BAR; PG8_MMA(1, 0, At, B0); PG8_MMA(1, 1, At, B1); PG8_BAR; PG8_SCHED;
        }
        if constexpr (ALIGN_EPI) { if (wr == 0) PG8_BAR; }
        if constexpr (!Epi::AFTER_DRAIN) { E(acc, cur, wr, wc, fr, fq); }
        if (!has_next) break;
#pragma unroll
        for (int a = 0; a < 2; ++a)
#pragma unroll
            for (int b = 0; b < 2; ++b)
#pragma unroll
                for (int m = 0; m < 4; ++m)
#pragma unroll
                    for (int n = 0; n < 2; ++n) acc[a][b][m][n] = (f32x4){0.f, 0.f, 0.f, 0.f};
        cur = nxt; cA = nA; cB = nB; ++ui;
#pragma unroll
        for (int h = 0; h < 2; ++h)
#pragma unroll
            for (int i = 0; i < 2; ++i) vaC[h][i] = vaN[h][i];
        if constexpr (ALIGN_EPI) { if (wr == 1) PG8_BAR; }
    }
    PG8_WAIT_V(0);
    if constexpr (!ALIGN_EPI) { if (wr == 0) PG8_BAR; }
    PG8_BAR;
    if constexpr (Epi::AFTER_DRAIN) { E.fused(acc, cur, wr, wc, fr, fq, lds, wid, lane); }
#undef PG8_SA
#undef PG8_SB
#undef PG8_STAGE_A
#undef PG8_STAGE_B
#undef PG8_LDA
#undef PG8_LDB
#undef PG8_MMA
#undef PG8_WAIT_V
#undef PG8_WAIT_L
#undef PG8_BAR
#undef PG8_SCHED
#undef PG8_VA
#undef PG8_VA_LDS
}
}
constexpr int NWAVES = 8;
constexpr int NB = 2, SEQ = 16384, DM = 1024, NH = 8, HD = 128, NE = 64, TOPK = 8, FE = 256, DEPTH = 2;
constexpr int NTOK = NB * SEQ;
constexpr int HTOK = NTOK / 2;
constexpr int NSLOT = 9;
constexpr float LN_EPS = 1e-5f, ALPHA = 1.4142135623730951f, ATTN_SCALE = 0.08838834764831845f;
constexpr int MAXBLK = 640;

constexpr size_t MiB = 1u << 20;
constexpr size_t WS_CTL = 0, CTL_ZERO_BYTES = 1 * MiB;
constexpr size_t WS_MOD = 1 * MiB;
constexpr size_t WS_BSUM = WS_MOD + 128 * 1024;
constexpr size_t WS_ROUTE = 3 * MiB;
constexpr size_t WS_IDX = WS_ROUTE, WS_GATE = WS_ROUTE + 1 * MiB;
constexpr size_t ROWS_HALF = (size_t)MAXBLK * 256;
constexpr size_t WS_ROWTOK = WS_ROUTE + 2 * MiB, WS_SLOTOF = WS_ROWTOK + 2 * ROWS_HALF * 4  , WS_BLKEXP = WS_SLOTOF + 1 * MiB + 512 * 1024;
constexpr size_t WS_ROWTOK2 = 10 * MiB;
constexpr size_t WS_AUX = 10 * MiB;
constexpr size_t WS_LOGF = WS_AUX, WS_F = WS_AUX + 1 * MiB, WS_KAUG = WS_AUX + 2 * MiB;
constexpr size_t WS_WATT = 16 * MiB, WATT_STRIDE = 9 * MiB;
constexpr size_t WATT_O = 6 * MiB, WATT_R = 8 * MiB;
constexpr size_t WS_WMOE0 = 34 * MiB, WS_WMOE1 = 500 * MiB, WMOE_D = 65 * MiB;
constexpr size_t WS_H = 132 * MiB;
constexpr size_t WS_BIG = 196 * MiB;
constexpr size_t WS_Q = WS_BIG, WS_K = WS_BIG + 64 * MiB, WS_V = WS_BIG + 128 * MiB, WS_O = WS_H, WS_Y = WS_Q;
constexpr size_t WS_ACT = WS_BIG, WS_YR = WS_BIG + 80 * MiB;
constexpr size_t WS_XB = 436 * MiB;
static_assert(WS_YR + (size_t)MAXBLK * 256 * 1024 <= WS_XB && WS_V + 64 * MiB <= WS_XB && WS_XB + 64 * MiB <= WS_WMOE1 && WS_WMOE0 + 98 * MiB <= WS_H && WS_WATT + 2 * WATT_STRIDE <= WS_WMOE0, "d_ws map (1)");
constexpr size_t WS_END = WS_WMOE1 + WMOE_D + (size_t)65 * 1024 * 256 * 2;
static_assert(WS_ROWTOK2 + (size_t)2 * 65 * 16384 * 2 <= WS_WATT && WS_V - WS_K == WS_K - WS_Q && WS_BLKEXP + 4 * MAXBLK * 4 + 64 <= WS_AUX && WS_SLOTOF + (size_t)NTOK * 8 * 4 <= WS_BLKEXP && WS_END <= (size_t)598 * MiB, "d_ws map");
constexpr int CW_BAR = 4096;
constexpr int CW_CNT = 8192;
constexpr int CW_CUR = 8192 + 256;
constexpr int CW_CONVQ = 12288;
constexpr int CW_FOXQ = 16384;

constexpr int RING_OFF = 0, RING_BYTES = 131072;
constexpr int LDSCTL_OFF = RING_BYTES, MISC_OFF = LDSCTL_OFF + 320;
static_assert(pg8::RTL_OFF == LDSCTL_OFF + 8192, "LDS map");
constexpr int BT_OFF = LDSCTL_OFF + 9216;
constexpr int BBL_OFF = BT_OFF + 2 * MAXBLK * 4;
static_assert(BBL_OFF + 2 * 68 * 4 <= 147456, "LDS map (2)");
constexpr int LDS_BYTES = 147456;

#define GAS __attribute__((address_space(1)))
#define LAS __attribute__((address_space(3)))
typedef unsigned short bf16;
typedef unsigned v4u __attribute__((ext_vector_type(4)));
typedef float f32x4 __attribute__((ext_vector_type(4)));
#define LDS_WAIT() asm volatile("s_waitcnt lgkmcnt(0)" ::: "memory")
#define VM_WAIT() asm volatile("s_waitcnt vmcnt(0)" ::: "memory")
__device__ __forceinline__ unsigned f2bf(float f) { unsigned u = __builtin_bit_cast(unsigned, f); return (u + 0x7fffu + ((u >> 16) & 1u)) >> 16; }
__device__ __forceinline__ unsigned pk2(float lo, float hi) { return f2bf(lo) | (f2bf(hi) << 16); }
__device__ __forceinline__ float bflo(unsigned w) { return __builtin_bit_cast(float, w << 16); }
__device__ __forceinline__ float bfhi(unsigned w) { return __builtin_bit_cast(float, w & 0xffff0000u); }

#define XB_TMO      128
#define XB_XCNT(j)  (256  + 64 * (j))
#define XB_XSUB(j)  (1280 + 64 * (j))
#define XB_XGEN(j)  (2304 + 64 * (j))
#define XB_TOP      3328
#define XB_TOPGEN   3392
#define XCD_BAR_WORDS 3456
#define XB_SPIN_CAP (1u << 26)

__device__ __forceinline__ unsigned xb_ld(unsigned* p)              { return __hip_atomic_load(p, __ATOMIC_RELAXED, __HIP_MEMORY_SCOPE_AGENT); }
__device__ __forceinline__ unsigned xb_add(unsigned* p, unsigned v) { return __hip_atomic_fetch_add(p, v, __ATOMIC_RELAXED, __HIP_MEMORY_SCOPE_AGENT); }
__device__ __forceinline__ unsigned xb_xcc_id() { return (unsigned)__builtin_amdgcn_s_getreg((3 << 11) | 20) & 0xFu; }
#define XB_SPIN(cond, bar) do { unsigned _sp = 0; while (cond) { __builtin_amdgcn_s_sleep(1); \
    if ((++_sp & 255u) == 0u) { if (xb_ld(&(bar)[XB_TMO])) break; if (_sp > XB_SPIN_CAP) { atomicAdd(&(bar)[XB_TMO], 1u); break; } } } } while (0)

struct XcdBarrier {
    unsigned* bar; unsigned x; int wave;
    volatile LAS unsigned* st;
};
__device__ __forceinline__ XcdBarrier xcd_barrier_post(unsigned* bar, volatile LAS unsigned* st, int wave) {
    XcdBarrier b; b.bar = bar; b.x = xb_xcc_id(); b.st = st; b.wave = wave;
    if (wave == 0 && lane_now() == 0) (void)xb_add(&bar[XB_XCNT(b.x)], 1u);
    return b;
}
__device__ __forceinline__ void xcd_barrier_complete(unsigned* bar, unsigned x, unsigned& nloc, unsigned& nx) {
    const unsigned G = gridDim.x * gridDim.y * gridDim.z;
    unsigned sum, cnt, mine, sp = 0u;
    for (;;) {
        sum = 0u; cnt = 0u; mine = 0u;
#pragma unroll
        for (unsigned j = 0; j < 16; ++j) { const unsigned c = xb_ld(&bar[XB_XCNT(j)]); sum += c; cnt += (c > 0u) ? 1u : 0u; mine = (j == x) ? c : mine; }
        if (sum == G) break;
        __builtin_amdgcn_s_sleep(1);
        if ((++sp & 255u) == 0u) { if (xb_ld(&bar[XB_TMO])) break; if (sp > XB_SPIN_CAP) { atomicAdd(&bar[XB_TMO], 1u); break; } }
    }
    nloc = mine > 0u ? mine : 1u; nx = cnt > 0u ? cnt : 1u;
}
__device__ __forceinline__ void xcd_barrier(const XcdBarrier& b) {
    asm volatile("s_waitcnt vmcnt(0)" ::: "memory");
    __syncthreads();
    if (b.wave == 0 && lane_now() == 0) {
        unsigned* bar = b.bar;
        __builtin_amdgcn_s_waitcnt(0);
        unsigned nloc = b.st[0], nx = b.st[1];
        if (nloc == 0u) { xcd_barrier_complete(bar, b.x, nloc, nx); b.st[0] = nloc; b.st[1] = nx; }
        const unsigned old = xb_add(&bar[XB_XSUB(b.x)], 1u);
        const unsigned gen = old / nloc;
        if (old == gen * nloc) asm volatile("buffer_wbl2 sc1" ::: "memory");
        if (old + 1u == (gen + 1u) * nloc) {
            __builtin_amdgcn_fence(__ATOMIC_RELEASE, "agent");
            asm volatile("s_waitcnt vmcnt(0)" ::: "memory");
            const unsigned og = xb_add(&bar[XB_TOP], 1u);
            const unsigned tg = og / nx;
            if (og + 1u == (tg + 1u) * nx) xb_add(&bar[XB_TOPGEN], 1u);
            else XB_SPIN(xb_ld(&bar[XB_TOPGEN]) == tg, bar);
            __builtin_amdgcn_fence(__ATOMIC_ACQUIRE, "agent");
            xb_add(&bar[XB_XGEN(b.x)], 1u);
            asm volatile("s_waitcnt vmcnt(0)" ::: "memory");
        } else {
            XB_SPIN(xb_ld(&bar[XB_XGEN(b.x)]) == gen, bar);
            __builtin_amdgcn_fence(__ATOMIC_ACQUIRE, "agent");
            asm volatile("s_waitcnt vmcnt(0)" ::: "memory");
        }
    }
    __syncthreads();
}

__device__ __forceinline__ float wave_sum(float v, int lane) {
#pragma unroll
    for (int o = 1; o < 64; o <<= 1) v += __builtin_bit_cast(float, __builtin_amdgcn_ds_bpermute((lane ^ o) << 2, __builtin_bit_cast(int, v)));
    return v;
}
__device__ __forceinline__ float logsig(float z) { return fminf(z, 0.f) - log1pf(__expf(-fabsf(z))); }
__device__ __forceinline__ void ld8f_nt(const float* p, float (&v)[8]) { const f32x4 a = __builtin_nontemporal_load((const f32x4*)p), b = __builtin_nontemporal_load((const f32x4*)(p + 4)); v[0] = a.x; v[1] = a.y; v[2] = a.z; v[3] = a.w; v[4] = b.x; v[5] = b.y; v[6] = b.z; v[7] = b.w; }
__device__ __forceinline__ void ld8f(const float* p, float (&v)[8]) { const f32x4 a = *(const f32x4*)p, b = *(const f32x4*)(p + 4); v[0] = a.x; v[1] = a.y; v[2] = a.z; v[3] = a.w; v[4] = b.x; v[5] = b.y; v[6] = b.z; v[7] = b.w; }
__device__ __forceinline__ void st8f(float* p, const float (&v)[8]) { *(f32x4*)p = (f32x4){v[0], v[1], v[2], v[3]}; *(f32x4*)(p + 4) = (f32x4){v[4], v[5], v[6], v[7]}; }
__device__ __forceinline__ void ld8bf(const bf16* p, float (&v)[8]) { const v4u w = *(const v4u*)p; v[0] = bflo(w.x); v[1] = bfhi(w.x); v[2] = bflo(w.y); v[3] = bfhi(w.y); v[4] = bflo(w.z); v[5] = bfhi(w.z); v[6] = bflo(w.w); v[7] = bfhi(w.w); }
__device__ __forceinline__ void st8bf(bf16* p, const float (&v)[8]) { v4u w; w.x = pk2(v[0], v[1]); w.y = pk2(v[2], v[3]); w.z = pk2(v[4], v[5]); w.w = pk2(v[6], v[7]); *(v4u*)p = w; }

__device__ __forceinline__ void transpose_item(const float* W, int ldw, int k0, int n0, bf16* WT, int Kd, int drow, int lo, LAS unsigned short* scr, int lane) {
    constexpr int KP = 72;
    const int nq = (lane & 15) * 4, kr = lane >> 4;
    f32x4 vv[16];
#pragma unroll
    for (int i = 0; i < 16; ++i) vv[i] = __builtin_nontemporal_load((const f32x4*)(W + (size_t)(k0 + 4 * i + kr) * ldw + n0 + nq));
#pragma unroll
    for (int i = 0; i < 16; ++i) { const int k = 4 * i + kr; f32x4 v = vv[i];
        if (lo) { v.x -= __builtin_bit_cast(float, f2bf(v.x) << 16); v.y -= __builtin_bit_cast(float, f2bf(v.y) << 16); v.z -= __builtin_bit_cast(float, f2bf(v.z) << 16); v.w -= __builtin_bit_cast(float, f2bf(v.w) << 16); }
        scr[(nq + 0) * KP + k] = (unsigned short)f2bf(v.x); scr[(nq + 1) * KP + k] = (unsigned short)f2bf(v.y); scr[(nq + 2) * KP + k] = (unsigned short)f2bf(v.z); scr[(nq + 3) * KP + k] = (unsigned short)f2bf(v.w); }
    LDS_WAIT(); asm volatile("" ::: "memory");
    const int c = lane & 7;
#pragma unroll
    for (int j = 0; j < 8; ++j) { const int n = (lane >> 3) + 8 * j; const v4u o = *(const LAS v4u*)(scr + n * KP + 8 * c);
        __builtin_nontemporal_store(o, (v4u*)(WT + (size_t)(drow + n) * Kd + k0 + 8 * c)); }
    LDS_WAIT(); asm volatile("" ::: "memory");
}
namespace fox {
constexpr int D = 128;
constexpr float THR = 8.f;
constexpr bool WSKIP = false;
constexpr float SCALE = 0.08838834764831845f;
constexpr int NW = 8, QBLK = 32, KVBLK = 64, QB = NW * QBLK;
constexpr int SHM_V = KVBLK * D * 2, SHM_K = KVBLK * D * 2;
constexpr int SHM_KA = KVBLK * 16;
constexpr int KA_OFF = 2 * SHM_V + 2 * SHM_K + NW * 64 * 4;
constexpr int LDS_BYTES = KA_OFF + 2 * SHM_KA;
constexpr int OSTR = 1024;
typedef unsigned short bf16;
typedef short bf16x8 __attribute__((ext_vector_type(8)));
typedef short s16x4 __attribute__((ext_vector_type(4)));
typedef float f32x16 __attribute__((ext_vector_type(16)));
typedef float f32x4 __attribute__((ext_vector_type(4)));
typedef unsigned u32x4 __attribute__((ext_vector_type(4)));
template <class A, class Bt> struct same_t { static constexpr bool v = false; };
template <class A> struct same_t<A, A> { static constexpr bool v = true; };
#define KSWZ(row, colB) ((row) * 256 + ((colB) ^ (((row) & 7) << 4)))
#define SBAR() __builtin_amdgcn_sched_barrier(0)
__device__ __forceinline__ int v_st(int k, int c) { const int kk = (k & ~0xC) | ((k & 4) << 1) | ((k & 8) >> 1); return ((kk >> 3) * 4 + (c >> 5)) * 512 + ((kk & 7) * 32 + (c & 31)) * 2; }
__device__ __forceinline__ int v_rd_base(int lane) { return ((lane & 3) << 3) | (((lane >> 2) & 3) << 6) | (((lane >> 4) & 1) << 5) | (((lane >> 5) & 1) << 8); }
constexpr int v_rd_off(int d0, int ks, int half) { return d0 * 512 + ks * 4096 + half * 2048; }
__device__ __forceinline__ int crow(int r, int hi) { return (r & 3) + 8 * (r >> 2) + 4 * hi; }
__device__ __forceinline__ unsigned cvtpk(float lo, float hi) {
    unsigned r; asm volatile("v_cvt_pk_bf16_f32 %0, %1, %2" : "=v"(r) : "v"(lo), "v"(hi)); return r;
}
__device__ __forceinline__ bf16x8 pack8(f32x4 a, f32x4 b) {
    u32x4 w = {cvtpk(a[0], a[1]), cvtpk(a[2], a[3]), cvtpk(b[0], b[1]), cvtpk(b[2], b[3])};
    return *reinterpret_cast<bf16x8*>(&w);
}
template <class T> __device__ __forceinline__ bf16x8 load8(const T* p) {
    if constexpr (same_t<T, float>::v) { return pack8(*(const f32x4*)p, *(const f32x4*)(p + 4)); }
    else { return *reinterpret_cast<const bf16x8*>(p); }
}
__device__ __forceinline__ void mask_tile(f32x16& p0, f32x16& p1, int dq, unsigned W) {
    const float NEG = -__builtin_inff();
#pragma unroll
    for (int r = 0; r < 16; ++r) {
        const int c = (r & 3) + 8 * (r >> 2);
        if ((unsigned)(dq - c) >= W) p0[r] = NEG;
        if ((unsigned)(dq - c - 32) >= W) p1[r] = NEG;
    }
}
__device__ __forceinline__ void partialSM(f32x16& p0, f32x16& p1, float& m_reg, float& mn, float& alpha) {
    float pmax = p0[0]; for (int r = 1; r < 16; ++r) pmax = fmaxf(pmax, p0[r]); for (int r = 0; r < 16; ++r) pmax = fmaxf(pmax, p1[r]);
    { unsigned pb_ = __float_as_uint(pmax); asm volatile("" : "+v"(pb_));
      auto rr = __builtin_amdgcn_permlane32_swap(__float_as_uint(pmax), pb_, false, false);
      pmax = fmaxf(__uint_as_float(rr[0]), __uint_as_float(rr[1])); }
    constexpr float C2 = 1.4426950408889634f * SCALE;
    if (__builtin_expect(__all((pmax - m_reg) * SCALE <= THR), 1)) { mn = m_reg; alpha = 1.f; }
    else { mn = fmaxf(m_reg, pmax); alpha = __builtin_amdgcn_exp2f((m_reg - mn) * C2); m_reg = mn; }
    const float mnL = -mn * C2;
    for (int r = 0; r < 16; ++r) p0[r] = fmaf(p0[r], C2, mnL); for (int r = 0; r < 16; ++r) p1[r] = fmaf(p1[r], C2, mnL);
    for (int r = 0; r < 16; ++r) p0[r] = __builtin_amdgcn_exp2f(p0[r]);
}
__device__ __forceinline__ void finishSM(f32x16& p0, f32x16& p1, float alpha, float& l_reg, bf16x8& pa0, bf16x8& pa1, bf16x8& pa2, bf16x8& pa3) {
    for (int r = 0; r < 16; ++r) p1[r] = __builtin_amdgcn_exp2f(p1[r]);
    float ps = 0; for (int r = 0; r < 16; ++r) ps += p0[r]; for (int r = 0; r < 16; ++r) ps += p1[r];
    { unsigned pb_ = __float_as_uint(ps); asm volatile("" : "+v"(pb_));
      auto rr = __builtin_amdgcn_permlane32_swap(__float_as_uint(ps), pb_, false, false);
      ps = __uint_as_float(rr[0]) + __uint_as_float(rr[1]); }
    l_reg = l_reg * alpha + ps;
#define PK4(P, B_, OUT) do { unsigned a0 = cvtpk(P[B_+0], P[B_+1]), a1 = cvtpk(P[B_+2], P[B_+3]);                          \
        unsigned b0 = cvtpk(P[B_+4], P[B_+5]), b1 = cvtpk(P[B_+6], P[B_+7]);                                             \
        auto r0 = __builtin_amdgcn_permlane32_swap(a0, b0, false, false); auto r1 = __builtin_amdgcn_permlane32_swap(a1, b1, false, false); \
        u32x4 w = {r0[0], r1[0], r0[1], r1[1]}; OUT = *reinterpret_cast<bf16x8*>(&w); } while (0)
    PK4(p0, 0, pa0); PK4(p0, 8, pa1); PK4(p1, 0, pa2); PK4(p1, 8, pa3);
#undef PK4
}
template <int KB, bool SK, bool BIAS = true>
__device__ __forceinline__ void qkt(f32x16& p0, f32x16& p1, const char* K_lds, int r32, int hi, const bf16x8* qr, bool act) {
    if (SK && !act) { const float NEG = -__builtin_inff();
#pragma unroll
        for (int r = 0; r < 16; ++r) { p0[r] = NEG; p1[r] = NEG; } return; }
    if constexpr (!BIAS) { p0 = f32x16{}; p1 = f32x16{}; } else
    {
        const char* ka = K_lds + (KA_OFF - 2 * SHM_V) + KB * SHM_KA; int hz = hi; asm volatile("" : "+v"(hz));
        const short one = hz ? (short)0 : (short)0x3F80;
        const bf16x8 qa = {one, one, one, 0, 0, 0, 0, 0};
        p0 = __builtin_amdgcn_mfma_f32_32x32x16_bf16(*reinterpret_cast<const bf16x8*>(ka + r32 * 16), qa, f32x16{}, 0, 0, 0);
        p1 = __builtin_amdgcn_mfma_f32_32x32x16_bf16(*reinterpret_cast<const bf16x8*>(ka + (32 + r32) * 16), qa, f32x16{}, 0, 0, 0); }
    const char* kb[4];
#pragma unroll
    for (int dd = 0; dd < 4; ++dd) kb[dd] = K_lds + KB * SHM_K + KSWZ(r32, (dd * 16 + hi * 8) * 2);
#pragma unroll
    for (int d0 = 0; d0 < 8; ++d0) { const char* a = kb[d0 & 3] + (d0 >> 2) * 128;
        bf16x8 b0 = *reinterpret_cast<const bf16x8*>(a);
        bf16x8 b1 = *reinterpret_cast<const bf16x8*>(a + 32 * 256);
        p0 = __builtin_amdgcn_mfma_f32_32x32x16_bf16(b0, qr[d0], p0, 0, 0, 0);
        p1 = __builtin_amdgcn_mfma_f32_32x32x16_bf16(b1, qr[d0], p1, 0, 0, 0); }

}
template <int VB, bool SK>
__device__ __forceinline__ void pv_tile(f32x16* o, int vb0, bf16x8 pa0, bf16x8 pa1, bf16x8 pa2, bf16x8 pa3, bool act) {
    if (SK && !act) return;
#define TRRD(dst, off) asm volatile("ds_read_b64_tr_b16 %0, %1 offset:%2" : "=&v"(dst) : "v"(vb0), "i"(off) : "memory")
#define PV_D0(d0) do { s16x4 l0, l1, l2, l3, h0, h1, h2, h3; constexpr int b_ = VB * SHM_V + v_rd_off(d0, 0, 0);     \
        TRRD(l0, b_); TRRD(h0, b_ + 2048); TRRD(l1, b_ + 4096); TRRD(h1, b_ + 6144); TRRD(l2, b_ + 8192); TRRD(h2, b_ + 10240); TRRD(l3, b_ + 12288); TRRD(h3, b_ + 14336); \
        asm volatile("s_waitcnt lgkmcnt(0)" ::: "memory"); SBAR();                 \
        o[d0] = __builtin_amdgcn_mfma_f32_32x32x16_bf16(pa0, (bf16x8){l0[0], l0[1], l0[2], l0[3], h0[0], h0[1], h0[2], h0[3]}, o[d0], 0, 0, 0);   \
        o[d0] = __builtin_amdgcn_mfma_f32_32x32x16_bf16(pa1, (bf16x8){l1[0], l1[1], l1[2], l1[3], h1[0], h1[1], h1[2], h1[3]}, o[d0], 0, 0, 0);   \
        o[d0] = __builtin_amdgcn_mfma_f32_32x32x16_bf16(pa2, (bf16x8){l2[0], l2[1], l2[2], l2[3], h2[0], h2[1], h2[2], h2[3]}, o[d0], 0, 0, 0);   \
        o[d0] = __builtin_amdgcn_mfma_f32_32x32x16_bf16(pa3, (bf16x8){l3[0], l3[1], l3[2], l3[3], h3[0], h3[1], h3[2], h3[3]}, o[d0], 0, 0, 0); } while (0)
    PV_D0(0); PV_D0(1); PV_D0(2); PV_D0(3);
#undef PV_D0
#undef TRRD
}

template <class TIn, class TOut> struct BlockRef { const TIn* Q; const TIn* K; const TIn* V; const TIn* KA; TOut* O; int P0; int JLO; };
template <class TIn> struct Seam {
    bf16x8 qr[8];
    bf16x8 st_v0, st_v1, st_k0, st_k1; f32x4 sf0, sf1, sf2, sf3;
    f32x4 tq[16];
};
__device__ __forceinline__ int swa_jlo(int P0, int W) { const int lowk = P0 - W + 1; return lowk > 0 ? lowk / KVBLK : 0; }
#define ROW(p, k0, rr) ((p) + (size_t)((k0) + (rr)) * D + sc)
#define VMW() asm volatile("s_waitcnt vmcnt(0)" ::: "memory")
#define VMWN(n) asm volatile("s_waitcnt vmcnt(%0)" :: "i"(n) : "memory")
#define SLOAD_H(Kp, Vp, KAp, k0, KABUF) do { S.st_v0 = load8<TIn>(ROW(Vp, k0, sr)); S.st_v1 = load8<TIn>(ROW(Vp, k0, 32 + sr));              \
                         S.st_k0 = load8<TIn>(ROW(Kp, k0, sr)); S.st_k1 = load8<TIn>(ROW(Kp, k0, 32 + sr));              \
                         if (wid == 0) __builtin_amdgcn_global_load_lds((const unsigned*)((KAp) + (size_t)((k0) + lane) * 8), (__attribute__((address_space(3))) unsigned*)(K_lds + (KA_OFF - 2 * SHM_V) + (KABUF) * SHM_KA), 16, 0, 0); } while (0)
#define SWRITE_HK(bf) do { *(bf16x8*)(K_lds + (bf) * SHM_K + kws) = S.st_k0; *(bf16x8*)(K_lds + (bf) * SHM_K + kws + 32 * 256) = S.st_k1; \
                        } while (0)
#define SWRITE_HV(bf) do { *(bf16x8*)(V_lds + (bf) * SHM_V + vst0) = S.st_v0; *(bf16x8*)(V_lds + (bf) * SHM_V + vst0 + 8192) = S.st_v1; } while (0)
#define SWRITE_H(bf) do { SWRITE_HV(bf); SWRITE_HK(bf); } while (0)
#define SLOAD_F(p, k0) do { S.sf0 = *(const f32x4*)ROW(p, k0, sr); S.sf1 = *(const f32x4*)(ROW(p, k0, sr) + 4);                \
                            S.sf2 = *(const f32x4*)ROW(p, k0, 32 + sr); S.sf3 = *(const f32x4*)(ROW(p, k0, 32 + sr) + 4); } while (0)
#define SWRITE_KF(bf) do { *(bf16x8*)(K_lds + (bf) * SHM_K + kws) = pack8(S.sf0, S.sf1); *(bf16x8*)(K_lds + (bf) * SHM_K + kws + 32 * 256) = pack8(S.sf2, S.sf3); } while (0)
#define SWRITE_VF(bf) do { *(bf16x8*)(V_lds + (bf) * SHM_V + vst0) = pack8(S.sf0, S.sf1); *(bf16x8*)(V_lds + (bf) * SHM_V + vst0 + 8192) = pack8(S.sf2, S.sf3); } while (0)
template <class TIn, class TOut>
__device__ __forceinline__ void causal_swa_prime(const BlockRef<TIn, TOut>& cur, int W, char* lds, Seam<TIn>& S, int wv) {
    constexpr bool F32 = same_t<TIn, float>::v;
    const int wid = wv, lane = lane_now(), tid = wid * 64 + lane, r32 = lane & 31, hi = lane >> 5;
    const int sr = tid >> 4, sc = (tid & 15) * 8, kws = KSWZ(sr, sc * 2); char* K_lds = lds + 2 * SHM_V;
    const int kb0 = cur.JLO * KVBLK; (void)W;
    for (int d0 = 0; d0 < 8; ++d0) S.qr[d0] = load8<TIn>(cur.Q + (size_t)(wid * QBLK + r32) * D + d0 * 16 + hi * 8);
    if constexpr (F32) { SLOAD_F((const float*)cur.K, kb0); VMW(); SWRITE_KF(0); SBAR(); SLOAD_F((const float*)cur.V, kb0); }
    else { SLOAD_H(cur.K, cur.V, cur.KA, kb0, 0); VMW(); SWRITE_HK(0); }
    __syncthreads();
}
template <class TIn, class TOut>
__device__ __forceinline__ void causal_swa_block(const BlockRef<TIn, TOut>& cur, const BlockRef<TIn, TOut>& nxt, int skv, int W, char* lds, Seam<TIn>& S, int wv) {
    constexpr bool F32 = same_t<TIn, float>::v;
    const int wid = wv, lane = lane_now(), tid = wid * 64 + lane, r32 = lane & 31, hi = lane >> 5;
    const int j_lo = cur.JLO;
    int j_hi = (cur.P0 + QB - 1) / KVBLK + 1; if (j_hi > skv / KVBLK) j_hi = skv / KVBLK;
    const int NT = j_hi - j_lo;
    const int kbn = nxt.JLO * KVBLK;
    const int qlo = cur.P0 + wid * QBLK, qm = qlo + r32 - 4 * hi;
    char* V_lds = lds; char* K_lds = lds + 2 * SHM_V;
    float* ws = (float*)(lds + 2 * SHM_V + 2 * SHM_K) + wid * 64; float* li_l = ws, * al_l = ws + 32;
    float m_reg = -1e30f, l_reg = 0; f32x16 o[4] = {};
    const int sr = tid >> 4, sc = (tid & 15) * 8, vst0 = v_st(sr, sc)  , kws = KSWZ(sr, sc * 2);
    const int vb0 = (int)(uintptr_t)V_lds + v_rd_base(lane);
    const TIn* Kh = cur.K; const TIn* Vh = cur.V; const TIn* KAh = cur.KA;
#define RESC(a) do { if (__any((a) < 1.f)) { if (hi == 0) al_l[r32] = (a); asm volatile("s_waitcnt lgkmcnt(0)" ::: "memory");              \
                     for (int d_ = 0; d_ < 4; ++d_) for (int r = 0; r < 16; ++r) o[d_][r] *= al_l[crow(r, hi)]; } } while (0)
#define KBASE(t) ((j_lo + (t)) * KVBLK)
#define ACT(t) (KBASE(t) <= qlo + QBLK - 1 && KBASE(t) + KVBLK - 1 >= qlo - W + 1)
#define MASKT(P0_, P1_, t) do { const int kb_ = KBASE(t); if ((!SK || ACT(t)) && (kb_ + KVBLK - 1 > qlo || kb_ <= qlo + QBLK - 1 - W)) mask_tile(P0_, P1_, qm - kb_, (unsigned)W); } while (0)
    constexpr int NQL = F32 ? 16 : 8;
    constexpr bool SK = WSKIP && !F32;
#define SEAM_K0() do { VMWN(NQL); if constexpr (F32) { SWRITE_KF(0); SBAR(); SLOAD_F((const float*)nxt.V, kbn); } else { SWRITE_HK(0); } SBAR(); } while (0)
    f32x16 pA0, pA1, pB0, pB1; float mnA, mnB, alA, alB; bf16x8 pa0, pa1, pa2, pa3;
    if constexpr (F32) { VMW(); SWRITE_VF(0); SBAR(); } else { SWRITE_HV(0); SBAR(); }
    if (NT > 1) { if constexpr (F32) SLOAD_F((const float*)Kh, KBASE(1)); else SLOAD_H(Kh, Vh, KAh, KBASE(1), 1); }
    SBAR(); qkt<0, SK>(pA0, pA1, K_lds, r32, hi, S.qr, ACT(0));
    if constexpr (F32) { if (NT > 1) { VMW(); SWRITE_KF(1); SBAR(); SLOAD_F((const float*)Vh, KBASE(1)); } }
    MASKT(pA0, pA1, 0); partialSM(pA0, pA1, m_reg, mnA, alA);
    if (NT > 1) { VMW(); if constexpr (F32) { SWRITE_VF(1); SBAR(); if (NT > 2) SLOAD_F((const float*)Kh, KBASE(2)); } else SWRITE_H(1); }
    __syncthreads();
#define HALF_STEP(PX0, PX1, mnX, alX, PY0, PY1, alY, t, KB, VB, SB) do {                                                      \
        SBAR(); qkt<KB, SK>(PX0, PX1, K_lds, r32, hi, S.qr, ACT(t));                                             \
        finishSM(PY0, PY1, alY, l_reg, pa0, pa1, pa2, pa3); SBAR();                                                           \
        if ((t) + 1 < NT) { if constexpr (F32) { VMW(); SWRITE_KF(SB); SBAR(); SLOAD_F((const float*)Vh, KBASE((t) + 1)); }  \
                            else { SLOAD_H(Kh, Vh, KAh, KBASE((t) + 1), SB); } SBAR(); }                                               \
        pv_tile<VB, SK>(o, vb0, pa0, pa1, pa2, pa3, ACT((t) - 1)); MASKT(PX0, PX1, (t)); partialSM(PX0, PX1, m_reg, mnX, alX);                                        \
        __syncthreads();                                                                                                      \
        if ((t) + 1 < NT) { VMW(); if constexpr (F32) { SWRITE_VF(SB); SBAR(); if ((t) + 2 < NT) SLOAD_F((const float*)Kh, KBASE((t) + 2)); } \
                            else { SWRITE_H(SB); } }                                                                          \
        RESC(alX); __syncthreads(); } while (0)
    for (int t = 1; t + 1 < NT; t += 2) {
        HALF_STEP(pB0, pB1, mnB, alB, pA0, pA1, alA, t, 1, 0, 0);
        HALF_STEP(pA0, pA1, mnA, alA, pB0, pB1, alB, t + 1, 0, 1, 1);
    }
    const bool even = (NT & 1) == 0;
    if (even) { SBAR(); qkt<1, SK>(pB0, pB1, K_lds, r32, hi, S.qr, ACT(NT - 1)); SBAR(); }
#define QROW(e) (nxt.Q + (size_t)(wid * QBLK + r32) * D + ((e) >> 1) * 16 + hi * 8 + ((e) & 1) * 4)
    if constexpr (F32) { SLOAD_F((const float*)nxt.K, kbn); SBAR();
#pragma unroll
        for (int e = 0; e < 8; ++e) S.tq[e] = *(const f32x4*)QROW(e); }
    else { SLOAD_H(nxt.K, nxt.V, nxt.KA, kbn, 0); SBAR();
#pragma unroll
        for (int d0 = 0; d0 < 8; ++d0) S.qr[d0] = load8<TIn>(nxt.Q + (size_t)(wid * QBLK + r32) * D + d0 * 16 + hi * 8); }
    SBAR();
    finishSM(pA0, pA1, alA, l_reg, pa0, pa1, pa2, pa3); SBAR();
    if constexpr (F32) {
#pragma unroll
        for (int e = 8; e < 16; ++e) S.tq[e] = *(const f32x4*)QROW(e); SBAR(); }
#undef QROW
    pv_tile<0, SK>(o, vb0, pa0, pa1, pa2, pa3, ACT(even ? NT - 2 : NT - 1));
    if (even) { MASKT(pB0, pB1, NT - 1); partialSM(pB0, pB1, m_reg, mnB, alB); __syncthreads(); RESC(alB);
        finishSM(pB0, pB1, alB, l_reg, pa0, pa1, pa2, pa3); SBAR(); pv_tile<1, SK>(o, vb0, pa0, pa1, pa2, pa3, ACT(NT - 1)); }
    SBAR(); SEAM_K0();
    if (hi == 0) li_l[r32] = l_reg; asm volatile("s_waitcnt lgkmcnt(0)" ::: "memory");
    float rli[16];
#pragma unroll
    for (int r = 0; r < 16; ++r) rli[r] = __builtin_amdgcn_rcpf(li_l[crow(r, hi)]);
    TOut* Ow = cur.O + (size_t)(wid * QBLK) * OSTR;
#pragma unroll
    for (int r = 0; r < 16; ++r) { const int orow = crow(r, hi);
#pragma unroll
        for (int d0 = 0; d0 < 4; ++d0) { const float v = o[d0][r] * rli[r];
            if constexpr (same_t<TOut, float>::v) { Ow[(size_t)orow * OSTR + d0 * 32 + r32] = v; }
            else { const float vn = __builtin_bit_cast(float, __builtin_amdgcn_ds_bpermute((lane ^ 1) << 2, __builtin_bit_cast(int, v)));
                   if ((r32 & 1) == 0) *(unsigned*)(Ow + (size_t)orow * OSTR + d0 * 32 + r32) = cvtpk(v, vn); } } }
    if constexpr (F32) {
#pragma unroll
        for (int d0 = 0; d0 < 8; ++d0) S.qr[d0] = pack8(S.tq[2 * d0], S.tq[2 * d0 + 1]); }
    __syncthreads();
#undef RESC
#undef KBASE
#undef ACT
#undef MASKT
#undef SEAM_K0
#undef HALF_STEP
}
#undef ROW
#undef VMW
#undef VMWN
#undef SLOAD_H
#undef SWRITE_HK
#undef SWRITE_HV
#undef SWRITE_H
#undef SLOAD_F
#undef SWRITE_KF
#undef SWRITE_VF

typedef BlockRef<bf16, bf16> BR;
__device__ __forceinline__ float fox_gmax(const bf16* Q, const bf16* K, const float* F, const unsigned* nrm, int item, char* lds, int wv) {
    const int qb = 63 - (item >> 4), bh = item & 15; const size_t hb = (size_t)bh * 16384; const int P0 = qb * QB;
    const int lane = lane_now(), row = wv * 32 + (lane & 31), hi = lane >> 5;
    const bf16* qp = Q + (hb + P0 + row) * D + hi * 64; const bf16* kp = K + (hb + P0 + row) * D + hi * 64;
    float acc = 0.f, qq = 0.f;
#pragma unroll
    for (int c = 0; c < 8; ++c) { const u32x4 a = *(const u32x4*)(qp + 8 * c), b = *(const u32x4*)(kp + 8 * c);
#pragma unroll
        for (int q = 0; q < 4; ++q) { const unsigned x = q == 0 ? a.x : q == 1 ? a.y : q == 2 ? a.z : a.w, y = q == 0 ? b.x : q == 1 ? b.y : q == 2 ? b.z : b.w;
            const float xl = __builtin_bit_cast(float, x << 16), xh = __builtin_bit_cast(float, x & 0xffff0000u);
            acc += xl * __builtin_bit_cast(float, y << 16) + xh * __builtin_bit_cast(float, y & 0xffff0000u); qq += xl * xl + xh * xh; } }
    acc += __builtin_bit_cast(float, __builtin_amdgcn_ds_bpermute((lane ^ 32) << 2, __builtin_bit_cast(int, acc)));
    qq += __builtin_bit_cast(float, __builtin_amdgcn_ds_bpermute((lane ^ 32) << 2, __builtin_bit_cast(int, qq)));
    const float km = sqrtf(__builtin_bit_cast(float, nrm[bh]));
    float g = F[hb + P0 + row] + (1.001f * sqrtf(qq) * km - acc) * SCALE;
#pragma unroll
    for (int o = 1; o < 32; o <<= 1) g = fmaxf(g, __builtin_bit_cast(float, __builtin_amdgcn_ds_bpermute((lane ^ o) << 2, __builtin_bit_cast(int, g))));
    volatile float* gm = (volatile float*)(lds + KA_OFF + 2 * SHM_KA + 16);
    if (lane == 0) gm[wv] = g;
    __syncthreads();
    float r = gm[0];
#pragma unroll
    for (int w = 1; w < NW; ++w) r = fmaxf(r, gm[w]);
    __syncthreads();
    return r;
}
__device__ __forceinline__ BR fox_ref(const bf16* Q, const bf16* K, const bf16* V, const bf16* KA, bf16* O, const float* F, const unsigned* nrm, int item, int lane, float gmax) {
    const int qb = 63 - (item >> 4), bh = item & 15;
    BR r; const size_t hb = (size_t)bh * 16384;
    r.Q = Q + (hb + (size_t)qb * QB) * D; r.K = K + hb * D; r.V = V + hb * D; r.KA = KA + hb * 8;
    r.O = O + ((size_t)(bh >> 3) * 16384 + (size_t)qb * QB) * OSTR + (bh & 7) * D; r.P0 = qb * QB;
    const float* Fh = F + hb;
    const int jmax = 4 * qb; float fe[4];
#pragma unroll
    for (int i = 0; i < 4; ++i) { const int j = 4 * lane + i; fe[i] = Fh[(j < jmax ? j : jmax) * KVBLK + 63]; }
    const float thr = gmax + 104.05f;
    int first = 4;
#pragma unroll
    for (int i = 3; i >= 0; --i) if (4 * lane + i <= jmax && fe[i] <= thr) first = i;
    const unsigned long long bal = __ballot(first < 4); const int l1 = __builtin_amdgcn_readfirstlane((int)__builtin_ctzll(bal));
    r.JLO = 4 * l1 + __builtin_amdgcn_readlane(first, l1);
    return r;
}
__device__ __forceinline__ void fox_phase(const bf16* Q, const bf16* K, const bf16* V, const bf16* KA, bf16* O, const float* F, unsigned* ctlq  , char* lds, int wv) {
    constexpr int TOTAL = 1024, SKV = 16384, W = 16384;
    volatile int* slot = (volatile int*)(lds + KA_OFF + 2 * SHM_KA);
    const unsigned* nrm = ctlq + 16;
    int lane = lane_now();
    if (wv == 0 && lane == 0) { slot[0] = (int)atomicAdd(ctlq, 1u); slot[1] = (int)atomicAdd(ctlq, 1u); }
    __syncthreads();
    int icur = __builtin_amdgcn_readfirstlane(slot[0]), inxt = __builtin_amdgcn_readfirstlane(slot[1]);
    __syncthreads();
    if (icur >= TOTAL) return;
    BR cur = fox_ref(Q, K, V, KA, O, F, nrm, icur, lane, fox_gmax(Q, K, F, nrm, icur, lds, wv));
    BR nxt = cur; if (inxt < TOTAL) nxt = fox_ref(Q, K, V, KA, O, F, nrm, inxt, lane, fox_gmax(Q, K, F, nrm, inxt, lds, wv));
    Seam<bf16> S;
    causal_swa_prime<bf16, bf16>(cur, W, lds, S, wv);
    for (;;) {
        const bool last = inxt >= TOTAL;
        if (!last && wv == 0 && lane_now() == 0) slot[2] = (int)atomicAdd(ctlq, 1u);
        causal_swa_block<bf16, bf16>(cur, nxt, SKV, W, lds, S, wv);
        if (last) break;
        const int inn = __builtin_amdgcn_readfirstlane(slot[2]);
        cur = nxt; icur = inxt; inxt = inn; lane = lane_now();
        if (inxt < TOTAL) nxt = fox_ref(Q, K, V, KA, O, F, nrm, inxt, lane, fox_gmax(Q, K, F, nrm, inxt, lds, wv)); else nxt = cur;
        __syncthreads();
    }
}
template <bool MASK>
__device__ __forceinline__ float sb_half(f32x16& p, int kb, int trow, int hi, int pidx, float cin) {
    constexpr float C = SCALE * 1.4426950408889634f;
    float m[16];
#pragma unroll
    for (int r = 0; r < 16; ++r) { const int key = kb + crow(r, hi);
        const float e = __builtin_amdgcn_exp2f(fminf(p[r] * C, 115.f)); const float om = __builtin_amdgcn_rcpf(1.f + e); const bool v = !MASK || key < trow; m[r] = v ? om : 1.f; p[r] = v ? e * om : 0.f; }
    float later[4]; float sp = 1.f;
#pragma unroll
    for (int q = 3; q >= 0; --q) { const float gs = (m[4 * q] * m[4 * q + 1]) * (m[4 * q + 2] * m[4 * q + 3]);
        const float gp = __builtin_bit_cast(float, __builtin_amdgcn_ds_bpermute(pidx, __builtin_bit_cast(int, gs)));
        const float g_lo = hi ? gp : gs, g_hi = hi ? gs : gp;
        later[q] = hi ? sp : sp * g_hi; sp *= g_lo * g_hi; }
#pragma unroll
    for (int q = 0; q < 4; ++q) { float gx = cin * later[q];
#pragma unroll
        for (int i = 3; i >= 0; --i) { const int r = 4 * q + i; p[r] *= gx; gx *= m[r]; } }
    return sp;
}
template <bool MASK>
__device__ __forceinline__ void sb_weights(f32x16& p0, f32x16& p1, int kb, int trow, int hi, int pidx, float& carry) {
    const float s1 = sb_half<MASK>(p1, kb + 32, trow, hi, pidx, carry);
    const float c1 = carry * s1;
    const float s0 = sb_half<MASK>(p0, kb, trow, hi, pidx, c1);
    carry = c1 * s0;
}
__device__ __forceinline__ void sb_pack(const f32x16& p0, const f32x16& p1, bf16x8& pa0, bf16x8& pa1, bf16x8& pa2, bf16x8& pa3) {
#define PK4(P, B_, OUT) do { unsigned a0 = cvtpk(P[B_+0], P[B_+1]), a1 = cvtpk(P[B_+2], P[B_+3]);                          \
        unsigned b0 = cvtpk(P[B_+4], P[B_+5]), b1 = cvtpk(P[B_+6], P[B_+7]);                                             \
        auto r0 = __builtin_amdgcn_permlane32_swap(a0, b0, false, false); auto r1 = __builtin_amdgcn_permlane32_swap(a1, b1, false, false); \
        u32x4 w = {r0[0], r1[0], r0[1], r1[1]}; OUT = *reinterpret_cast<bf16x8*>(&w); } while (0)
    PK4(p0, 0, pa0); PK4(p0, 8, pa1); PK4(p1, 0, pa2); PK4(p1, 8, pa3);
#undef PK4
}
__device__ __forceinline__ void sb_phase(const bf16* Q, const bf16* K, const bf16* V, bf16* O, char* lds, int G, int c, int wv) {
    const int wid = wv;
    char* V_lds = lds; char* K_lds = lds + 2 * SHM_V;
    volatile int* flags = (volatile int*)(lds + 2 * SHM_V + 2 * SHM_K);
    for (int it = c; it < 1024; it += G) {
        const int lane = lane_now(), tid = wid * 64 + lane, r32 = lane & 31, hi = lane >> 5;
        const int sr = tid >> 4, sc = (tid & 15) * 8, vst0 = v_st(sr, sc), kws = KSWZ(sr, sc * 2);
        const int vb0 = (int)(uintptr_t)V_lds + v_rd_base(lane);
        const int bh = it >> 6, qb = it & 63; const size_t hb = (size_t)bh * 16384;
        const bf16* Kh = K + hb * D; const bf16* Vh = V + hb * D; const bf16* Qb = Q + (hb + (size_t)qb * QB) * D;
        const int P0 = qb * QB, qlo = P0 + wid * QBLK, trow = qlo + r32;
        bf16x8 qr[8];
#pragma unroll
        for (int d0 = 0; d0 < 8; ++d0) qr[d0] = *reinterpret_cast<const bf16x8*>(Qb + (size_t)(wid * QBLK + r32) * D + d0 * 16 + hi * 8);
        f32x16 o[4] = {}; float carry = 1.f; int wdone = 0;
        int j = P0 / KVBLK + 3;
        bf16x8 ak0, ak1, av0, av1, bk0, bk1, bv0, bv1;
#define SB_LOAD(K0_, K1_, V0_, V1_, jj) do { const int jc_ = (jj) > 0 ? (jj) : 0; const size_t k0_ = (size_t)jc_ * KVBLK; V0_ = *reinterpret_cast<const bf16x8*>(Vh + (k0_ + sr) * D + sc); V1_ = *reinterpret_cast<const bf16x8*>(Vh + (k0_ + 32 + sr) * D + sc); \
                         K0_ = *reinterpret_cast<const bf16x8*>(Kh + (k0_ + sr) * D + sc); K1_ = *reinterpret_cast<const bf16x8*>(Kh + (k0_ + 32 + sr) * D + sc); } while (0)
#define SB_STAGE(K0_, K1_, V0_, V1_) { \
            *(bf16x8*)(V_lds + vst0) = V0_; *(bf16x8*)(V_lds + vst0 + 8192) = V1_; *(bf16x8*)(K_lds + kws) = K0_; *(bf16x8*)(K_lds + kws + 32 * 256) = K1_; \
            __syncthreads(); \
            SB_LOAD(K0_, K1_, V0_, V1_, j - 2);                                  \
            const int kb = j * KVBLK; \
            if (!wdone && kb < qlo + QBLK - 1) { \
                f32x16 p0, p1; bf16x8 pa0, pa1, pa2, pa3; \
                qkt<0, false, false>(p0, p1, K_lds, r32, hi, qr, true); \
                if (kb + KVBLK - 1 >= qlo) sb_weights<true>(p0, p1, kb, trow, hi, (lane ^ 32) << 2, carry); \
                else sb_weights<false>(p0, p1, kb, trow, hi, (lane ^ 32) << 2, carry); \
                sb_pack(p0, p1, pa0, pa1, pa2, pa3); \
                pv_tile<0, false>(o, vb0, pa0, pa1, pa2, pa3, true); \
                wdone = __all(carry == 0.f) ? 1 : 0; \
            } \
            if (lane == 0) flags[wid] = wdone; \
            __syncthreads(); \
            int all = 1; \
            _Pragma("unroll") for (int w = 0; w < NW; ++w) all &= flags[w]; \
            if (all || j == 0) break; \
            --j; }
        SB_LOAD(ak0, ak1, av0, av1, j); SB_LOAD(bk0, bk1, bv0, bv1, j - 1);
        for (;;) {
            SB_STAGE(ak0, ak1, av0, av1)
            SB_STAGE(bk0, bk1, bv0, bv1)
        }
#undef SB_STAGE
#undef SB_LOAD
        bf16* Ow = O + ((size_t)(bh >> 3) * 16384 + (size_t)qb * QB + wid * QBLK) * OSTR + (bh & 7) * D;
        const int lz = lane_now(), hz = lz >> 5;
#pragma unroll
        for (int r = 0; r < 16; ++r) { const int orow = crow(r, hz);
#pragma unroll
            for (int d0 = 0; d0 < 4; ++d0) { const float v = o[d0][r];
                const float vn = __builtin_bit_cast(float, __builtin_amdgcn_ds_bpermute((lz ^ 1) << 2, __builtin_bit_cast(int, v)));
                if ((lz & 1) == 0) *(unsigned*)(Ow + (size_t)orow * OSTR + d0 * 32 + (lz & 31)) = cvtpk(v, vn); } }
        __syncthreads();
    }
}
}
struct Args { const float* in[21]; float* out; unsigned char* ws; int ph_lo, ph_hi; };
enum { I_X = 0, I_C, I_FOX_WIN, I_FOX_BF, I_FOX_WO, I_SB_WIN, I_SB_WO, I_ADA_W, I_ADA_B, I_LNA_G, I_LNA_B, I_RW, I_RB, I_EG, I_EU, I_ED, I_SG, I_SU, I_SD, I_LNF_G, I_LNF_B };

__device__ __forceinline__ void convert_attn_weights(const Args& A, LAS unsigned char* lds, int gw, int NGW, int wave, int lane) {
    asm volatile("" : "+v"(lane));
    LAS unsigned short* scr = (LAS unsigned short*)(lds + RING_OFF + wave * 16384);
    constexpr int nQ = 16 * 48, nO = 16 * 16, nR = 32, nZ = 128, PER = nQ + nO + nR + nZ;
    for (int it = gw; it < 2 * PER; it += NGW) {
        const int l = it / PER; int r = it % PER;
        bf16* WQKV = (bf16*)(A.ws + WS_WATT + (size_t)l * WATT_STRIDE); bf16* WO = (bf16*)(A.ws + WS_WATT + (size_t)l * WATT_STRIDE + WATT_O); bf16* WR = (bf16*)(A.ws + WS_WATT + (size_t)l * WATT_STRIDE + WATT_R);
        if (r < nQ) { const int kb = r / 48, nb = r % 48; transpose_item(l == 0 ? A.in[I_FOX_WIN] : A.in[I_SB_WIN], l == 0 ? 3080 : 3072, 64 * kb, 64 * nb, WQKV, 1024, 64 * nb, 0, scr, lane); continue; } r -= nQ;
        if (r < nO) { const int kb = r / 16, nb = r % 16; transpose_item(l == 0 ? A.in[I_FOX_WO] : A.in[I_SB_WO], 1024, 64 * kb, 64 * nb, WO, 1024, 64 * nb, 0, scr, lane); continue; } r -= nO;
        if (r < nR) { const int kb = r >> 1, lo = r & 1; transpose_item(A.in[I_RW] + (size_t)l * 1024 * 64, 64, 64 * kb, 0, WR, 1024, lo ? 128 : 0, lo, scr, lane); continue; } r -= nR;
        { const int row = r < 64 ? 64 + r : 192 + (r - 64); unsigned zz = 0u; asm volatile("" : "+v"(zz)); v4u z = {zz, zz, zz, zz}; v4u* p = (v4u*)(WR + (size_t)row * 1024) + lane; p[0] = z; p[64] = z; }
    }
}
constexpr int CONV_PER_LAYER = 65 * 128 + 65 * 64, CONV_TOTAL = 2 * CONV_PER_LAYER;
__device__ __forceinline__ void convert_moe_item(const float* eg, const float* eu, const float* ed, const float* sg, const float* su, const float* sd, unsigned char* ws, int item, LAS unsigned short* scr, int lane) {
    const int l = item / CONV_PER_LAYER; int r = item % CONV_PER_LAYER;
    bf16* WGU = (bf16*)(ws + (l == 0 ? WS_WMOE0 : WS_WMOE1)); bf16* WD = (bf16*)(ws + (l == 0 ? WS_WMOE0 : WS_WMOE1) + WMOE_D);
    if (r < 65 * 128) { const int e = r / 128, r2 = r % 128, which = r2 / 64, r3 = r2 % 64, kb = r3 / 4, nb = r3 % 4, n0 = 64 * nb;
        const float* src;
        if (e < 64) { src = which ? eu : eg; src += (size_t)(l * 64 + e) * 1024 * 256; } else { src = which ? su : sg; src += (size_t)l * 1024 * 256; }
        transpose_item(src, 256, 64 * kb, n0, WGU, 1024, e * 512 + (n0 >> 7) * 256 + which * 128 + (n0 & 127), 0, scr, lane); return; }
    r -= 65 * 128;
    { const int e = r / 64, r2 = r % 64, kb = r2 / 16, nb = r2 % 16;
      const float* src;
      if (e < 64) src = ed + (size_t)(l * 64 + e) * 256 * 1024; else src = sd + (size_t)l * 256 * 1024;
      transpose_item(src, 1024, 64 * kb, 64 * nb, WD, 256, e * 1024 + 64 * nb, 0, scr, lane); }
}
__device__ __forceinline__ void convert_moe_drain(const float* eg, const float* eu, const float* ed, const float* sg, const float* su, const float* sd, unsigned char* ws, LAS unsigned char* lds, int wave) {
    asm volatile("" : "+s"(eg), "+s"(eu), "+s"(ed), "+s"(sg), "+s"(su), "+s"(sd));
    unsigned* q = (unsigned*)(ws + WS_CTL) + CW_CONVQ;
    LAS unsigned short* scr = (LAS unsigned short*)(lds + RING_OFF + wave * 16384);
    for (;;) {
        const int lane = lane_now(); int base = 0;
        if (lane == 0) base = (int)atomicAdd(q, 2u);
        base = __builtin_amdgcn_readfirstlane(base);
        if (base >= CONV_TOTAL) break;
        for (int i = 0; i < 2; ++i) if (base + i < CONV_TOTAL) convert_moe_item(eg, eu, ed, sg, su, sd, ws, base + i, scr, lane);
    }
}

__device__ __forceinline__ void input_pass(const Args& A, LAS unsigned char* lds, int gw, int NGW, int tid, int lane) {
    asm volatile("" : "+v"(tid), "+v"(lane));
    LAS float* Wf = (LAS float*)lds;
    const float* win = A.in[I_FOX_WIN];
    for (int i = tid; i < 8192; i += 512) { const int k = i >> 3, q = i & 7; Wf[q * 1024 + k] = win[(size_t)k * 3080 + 3072 + q]; }
    __syncthreads();
    const float* x = A.in[I_X]; const float* MOD = (const float*)(A.ws + WS_MOD); bf16* H = (bf16*)(A.ws + WS_H); float* LOGF = (float*)(A.ws + WS_LOGF);
    const float bfv = A.in[I_FOX_BF][(lane >> 3) & 7];
    double* BSUM = (double*)(A.ws + WS_BSUM);
    for (int rb = gw; rb < NTOK / 16; rb += NGW) {
        const int b = (rb * 16) >> 14; const float* modb = MOD + (size_t)(0 * 2 + b) * 6144;
        float sc[16], sh[16];
        double bs = 0.0;
#pragma unroll
        for (int j = 0; j < 2; ++j) { float a[8], c[8]; ld8f(modb + 1024 + 512 * j + 8 * lane, a); ld8f(modb + 512 * j + 8 * lane, c);
#pragma unroll
            for (int e = 0; e < 8; ++e) { sc[8 * j + e] = 1.f + a[e]; sh[8 * j + e] = c[e]; } }
        f32x4 xc[4], xn[4];
#pragma unroll
        for (int q = 0; q < 4; ++q) xc[q] = *(const f32x4*)(x + (size_t)(rb * 16) * 1024 + 512 * (q >> 1) + 8 * lane + 4 * (q & 1));
        for (int r = 0; r < 16; ++r) {
            const int t = rb * 16 + r; float h[16];
            { const int tn = rb * 16 + (r < 15 ? r + 1 : r);
#pragma unroll
              for (int q = 0; q < 4; ++q) xn[q] = *(const f32x4*)(x + (size_t)tn * 1024 + 512 * (q >> 1) + 8 * lane + 4 * (q & 1)); }
            __builtin_amdgcn_sched_barrier(0);
#pragma unroll
            for (int j = 0; j < 2; ++j) { float a[8]; a[0] = xc[2 * j].x; a[1] = xc[2 * j].y; a[2] = xc[2 * j].z; a[3] = xc[2 * j].w; a[4] = xc[2 * j + 1].x; a[5] = xc[2 * j + 1].y; a[6] = xc[2 * j + 1].z; a[7] = xc[2 * j + 1].w; float o[8];
#pragma unroll
                for (int e = 0; e < 8; ++e) { h[8 * j + e] = a[e] * sc[8 * j + e] + sh[8 * j + e]; o[e] = h[8 * j + e]; }
                st8bf(H + (size_t)t * 1024 + 512 * j + 8 * lane, o); }
            float fl[8];
#pragma unroll
            for (int q = 0; q < 8; ++q) { float s = 0.f;
#pragma unroll
                for (int j = 0; j < 2; ++j) { const LAS float* wp = Wf + q * 1024 + 512 * j + 8 * lane; const f32x4 w0 = *(const LAS f32x4*)wp, w1 = *(const LAS f32x4*)(wp + 4);
                    s += h[8 * j + 0] * w0.x + h[8 * j + 1] * w0.y + h[8 * j + 2] * w0.z + h[8 * j + 3] * w0.w + h[8 * j + 4] * w1.x + h[8 * j + 5] * w1.y + h[8 * j + 6] * w1.z + h[8 * j + 7] * w1.w; }
                fl[q] = s; }
            float mine;
            { const bool b5 = (lane & 32) != 0, b4 = (lane & 16) != 0, b3 = (lane & 8) != 0; float t4[4], t2[2];
#pragma unroll
              for (int i = 0; i < 4; ++i) { const float keep = b5 ? fl[4 + i] : fl[i], give = b5 ? fl[i] : fl[4 + i]; t4[i] = keep + __builtin_bit_cast(float, __builtin_amdgcn_ds_bpermute((lane ^ 32) << 2, __builtin_bit_cast(int, give))); }
#pragma unroll
              for (int i = 0; i < 2; ++i) { const float keep = b4 ? t4[2 + i] : t4[i], give = b4 ? t4[i] : t4[2 + i]; t2[i] = keep + __builtin_bit_cast(float, __builtin_amdgcn_ds_bpermute((lane ^ 16) << 2, __builtin_bit_cast(int, give))); }
              { const float keep = b3 ? t2[1] : t2[0], give = b3 ? t2[0] : t2[1]; mine = keep + __builtin_bit_cast(float, __builtin_amdgcn_ds_bpermute((lane ^ 8) << 2, __builtin_bit_cast(int, give))); }
#pragma unroll
              for (int o = 4; o > 0; o >>= 1) mine += __builtin_bit_cast(float, __builtin_amdgcn_ds_bpermute((lane ^ o) << 2, __builtin_bit_cast(int, mine))); }
            { const float lf = logsig(mine + bfv); bs += (double)lf; if ((lane & 7) == 0) LOGF[(size_t)t * 8 + (lane >> 3)] = lf; }
#pragma unroll
            for (int q = 0; q < 4; ++q) xc[q] = xn[q];
        }
        if ((lane & 7) == 0) BSUM[(size_t)rb * 8 + (lane >> 3)] = bs;
    }
    __syncthreads();
}

__device__ __forceinline__ double shfl_d(double v, int idx4) { const unsigned long long u = __builtin_bit_cast(unsigned long long, v);
    const unsigned lo = (unsigned)__builtin_amdgcn_ds_bpermute(idx4, (int)(unsigned)u), hi = (unsigned)__builtin_amdgcn_ds_bpermute(idx4, (int)(unsigned)(u >> 32));
    return __builtin_bit_cast(double, ((unsigned long long)hi << 32) | lo); }
__device__ __forceinline__ void fox_scan_seg(const Args& A, LAS unsigned char* lds, int task, int tid, int lane, int wave) {
    asm volatile("" : "+v"(tid), "+v"(lane));
    const float* LOGF = (const float*)(A.ws + WS_LOGF); float* F = (float*)(A.ws + WS_F); bf16* KAUG = (bf16*)(A.ws + WS_KAUG); const double* BSUM = (const double*)(A.ws + WS_BSUM);
    LAS double* red = (LAS double*)lds;
    const int bh = task >> 4, seg = task & 15, b = bh >> 3, h = bh & 7;
    double p = 0.0;
    for (int blk = tid; blk < seg * 64; blk += 512) p += BSUM[((size_t)b * 1024 + blk) * 8 + h];
#pragma unroll
    for (int o = 1; o < 64; o <<= 1) p += shfl_d(p, (lane ^ o) << 2);
    const int s0 = seg * 1024 + 2 * tid;
    const float a0 = LOGF[((size_t)b * SEQ + s0) * 8 + h], a1 = LOGF[((size_t)b * SEQ + s0 + 1) * 8 + h];
    const double loc = (double)a0 + (double)a1; double inc = loc;
#pragma unroll
    for (int o = 1; o < 64; o <<= 1) { const double up = shfl_d(inc, ((lane - o) & 63) << 2); if (lane >= o) inc += up; }
    if (lane == 63) red[8 + wave] = inc;
    if (lane == 0) red[wave] = p;
    __syncthreads();
    double run = 0.0;
#pragma unroll
    for (int w = 0; w < 8; ++w) run += red[w];
    for (int w = 0; w < wave; ++w) run += red[8 + w];
    run += inc - loc;
#pragma unroll
    for (int i = 0; i < 2; ++i) { run += (double)(i == 0 ? a0 : a1); const int s = s0 + i;
        const float f = (float)run; F[(size_t)bh * SEQ + s] = f;
        const float xv = -f / ATTN_SCALE; const unsigned hi = f2bf(xv); const float r1 = xv - __builtin_bit_cast(float, hi << 16); const unsigned mid = f2bf(r1);
        const float r2 = r1 - __builtin_bit_cast(float, mid << 16); const unsigned lo = f2bf(r2);
        v4u w; w.x = hi | (mid << 16); w.y = lo; w.z = 0u; w.w = 0u; *(v4u*)(KAUG + ((size_t)bh * SEQ + s) * 8) = w; }
    __syncthreads();
}

__device__ __forceinline__ void f8x16(const v4u w, float (&y)[16]) {
#pragma unroll
    for (int q = 0; q < 4; ++q) { const int d = (int)(q == 0 ? w.x : q == 1 ? w.y : q == 2 ? w.z : w.w);
        const auto lo = __builtin_amdgcn_cvt_pk_f32_fp8(d, false), hi = __builtin_amdgcn_cvt_pk_f32_fp8(d, true);
        y[4 * q + 0] = lo[0]; y[4 * q + 1] = lo[1]; y[4 * q + 2] = hi[0]; y[4 * q + 3] = hi[1]; }
}
__device__ __forceinline__ v4u ldnt(const void* p) { return __builtin_nontemporal_load((const v4u*)p); }
__device__ __forceinline__ void ld16f_nt(const float* p, float (&v)[16]) {
#pragma unroll
    for (int q = 0; q < 4; ++q) { const f32x4 a = __builtin_nontemporal_load((const f32x4*)(p + 4 * q)); v[4 * q] = a.x; v[4 * q + 1] = a.y; v[4 * q + 2] = a.z; v[4 * q + 3] = a.w; }
}
__device__ __forceinline__ void ld16bf_nt(const bf16* p, float (&v)[16]) {
#pragma unroll
    for (int q = 0; q < 2; ++q) { const v4u w = ldnt(p + 8 * q); v[8 * q + 0] = bflo(w.x); v[8 * q + 1] = bfhi(w.x); v[8 * q + 2] = bflo(w.y); v[8 * q + 3] = bfhi(w.y); v[8 * q + 4] = bflo(w.z); v[8 * q + 5] = bfhi(w.z); v[8 * q + 6] = bflo(w.w); v[8 * q + 7] = bfhi(w.w); }
}
__device__ __forceinline__ void ld16f(const float* p, float (&v)[16]) {
#pragma unroll
    for (int q = 0; q < 4; ++q) { const f32x4 a = *(const f32x4*)(p + 4 * q); v[4 * q] = a.x; v[4 * q + 1] = a.y; v[4 * q + 2] = a.z; v[4 * q + 3] = a.w; }
}
__device__ __forceinline__ void ld16bf(const bf16* p, float (&v)[16]) { float a[8], b[8]; ld8bf(p, a); ld8bf(p + 8, b);
#pragma unroll
    for (int e = 0; e < 8; ++e) { v[e] = a[e]; v[8 + e] = b[e]; } }
__device__ __forceinline__ void st16bf(bf16* p, const float (&v)[16]) { float a[8], b[8];
#pragma unroll
    for (int e = 0; e < 8; ++e) { a[e] = v[e]; b[e] = v[8 + e]; }
    st8bf(p, a); st8bf(p + 8, b); }
__device__ __forceinline__ void st16bf_nt(bf16* p, const float (&v)[16]) {
#pragma unroll
    for (int q = 0; q < 2; ++q) { v4u w; w.x = pg8::cvt_pk_bf16(v[8 * q], v[8 * q + 1]); w.y = pg8::cvt_pk_bf16(v[8 * q + 2], v[8 * q + 3]); w.z = pg8::cvt_pk_bf16(v[8 * q + 4], v[8 * q + 5]); w.w = pg8::cvt_pk_bf16(v[8 * q + 6], v[8 * q + 7]);
        __builtin_nontemporal_store(w, (v4u*)(p + 8 * q)); } }
__device__ __forceinline__ void ln1_pass(const Args& A, int l, int gw, int NGW, int lane) {
    asm volatile("" : "+v"(lane));
    const float* xin = A.in[I_X]; bf16* XB = (bf16*)(A.ws + WS_XB);
    const unsigned char* Y = (const unsigned char*)(A.ws + WS_Y); bf16* H = (bf16*)(A.ws + WS_H); const float* MOD = (const float*)(A.ws + WS_MOD);
    const float* gam_p = A.in[I_LNA_G] + l * 1024; const float* bet_p = A.in[I_LNA_B] + l * 1024;
    const int c0 = 16 * lane;
    for (int rb = gw; rb < NTOK / 16; rb += NGW) {
        const int b = (rb * 16) >> 14; const float* modb = MOD + (size_t)(l * 2 + b) * 6144;
        float gA[16], gam[16], bet[16], scm[16], shm[16];
        ld16f(modb + 2048 + c0, gA); ld16f(gam_p + c0, gam); ld16f(bet_p + c0, bet); ld16f(modb + 4096 + c0, scm); ld16f(modb + 3072 + c0, shm);
#pragma unroll
        for (int e = 0; e < 16; ++e) { gA[e] = (1.f + gA[e]) * (1.f / 16.f); scm[e] += 1.f; }
#define LN1_ISSUE(X0, X1, X2, X3, R0, R1, RY, t_) do { if (l == 0) { X0 = *(const f32x4*)(xin + (t_) * 1024 + c0); X1 = *(const f32x4*)(xin + (t_) * 1024 + c0 + 4); X2 = *(const f32x4*)(xin + (t_) * 1024 + c0 + 8); X3 = *(const f32x4*)(xin + (t_) * 1024 + c0 + 12); } \
            else { R0 = ldnt(XB + (t_) * 1024 + c0); R1 = ldnt(XB + (t_) * 1024 + c0 + 8); } RY = ldnt(Y + (t_) * 1024 + c0); } while (0)
        f32x4 cx0, cx1, cx2, cx3, nx0, nx1, nx2, nx3; v4u c0r, c1r, cyr, n0r, n1r, nyr;
        { float zf = 0.f; unsigned zz = 0u; asm volatile("" : "+v"(zf), "+v"(zz)); cx0 = (f32x4){zf, zf, zf, zf}; cx1 = cx0; cx2 = cx0; cx3 = cx0; nx0 = cx0; nx1 = cx0; nx2 = cx0; nx3 = cx0; c0r = (v4u){zz, zz, zz, zz}; c1r = c0r; n0r = c0r; n1r = c0r; }
        LN1_ISSUE(cx0, cx1, cx2, cx3, c0r, c1r, cyr, (size_t)rb * 16);
        for (int r = 0; r < 16; ++r) {
            const size_t t = (size_t)rb * 16 + r; float v[16], y[16];
            { const size_t tn = (size_t)rb * 16 + (r < 15 ? r + 1 : r); LN1_ISSUE(nx0, nx1, nx2, nx3, n0r, n1r, nyr, tn); }
            __builtin_amdgcn_sched_barrier(0);
            if (l == 0) {
#define F4(R, q) v[4 * q] = R.x; v[4 * q + 1] = R.y; v[4 * q + 2] = R.z; v[4 * q + 3] = R.w
                F4(cx0, 0); F4(cx1, 1); F4(cx2, 2); F4(cx3, 3);
#undef F4
            } else {
#define B8(R, q) v[8 * q] = bflo(R.x); v[8 * q + 1] = bfhi(R.x); v[8 * q + 2] = bflo(R.y); v[8 * q + 3] = bfhi(R.y); v[8 * q + 4] = bflo(R.z); v[8 * q + 5] = bfhi(R.z); v[8 * q + 6] = bflo(R.w); v[8 * q + 7] = bfhi(R.w)
                B8(c0r, 0); B8(c1r, 1);
#undef B8
            }
            f8x16(cyr, y);
            cx0 = nx0; cx1 = nx1; cx2 = nx2; cx3 = nx3; c0r = n0r; c1r = n1r; cyr = nyr;
            float s = 0.f;
#pragma unroll
            for (int e = 0; e < 16; ++e) { v[e] = ALPHA * v[e] + gA[e] * y[e]; s += v[e]; }
            const float mean = wave_sum(s, lane) * (1.f / 1024.f); float s2 = 0.f;
#pragma unroll
            for (int e = 0; e < 16; ++e) { v[e] -= mean; s2 += v[e] * v[e]; }
            const float rstd = 1.f / sqrtf(wave_sum(s2, lane) * (1.f / 1024.f) + LN_EPS);
            float o[16], hh[16];
#pragma unroll
            for (int e = 0; e < 16; ++e) { o[e] = v[e] * rstd * gam[e] + bet[e]; hh[e] = o[e] * scm[e] + shm[e]; }
            st16bf(XB + t * 1024 + c0, o); st16bf(H + t * 1024 + c0, hh);
        }
#undef LN1_ISSUE
    }
}

__device__ __forceinline__ void ln2_pass(const Args& A, LAS unsigned char* lds, int l, int hf, int c, int G, int wave, int r, int WL4, int lane) {
    asm volatile("" : "+v"(lane));
    float* xout = A.out; bf16* XB = (bf16*)(A.ws + WS_XB); const unsigned char* YR = (const unsigned char*)(A.ws + WS_YR); bf16* H = (bf16*)(A.ws + WS_H); const float* MOD = (const float*)(A.ws + WS_MOD);
    const int* SLOTOF = (const int*)(A.ws + WS_SLOTOF); const float* GATE = (const float*)(A.ws + WS_GATE);
    const LAS int* BBL = (const LAS int*)(lds + BBL_OFF) + hf * 68;
    const int shbase = __builtin_amdgcn_readfirstlane(BBL[64]) * 256;
    const float* gam_p = A.in[I_LNF_G] + l * 1024; const float* bet_p = A.in[I_LNF_B] + l * 1024;
    const float* modb = MOD + (size_t)(l * 2 + hf) * 6144; const float* modn = MOD + (size_t)(1 * 2 + hf) * 6144;
    const int c0 = 16 * lane;
    float gM[16], gam[16], bet[16];
    ld16f(modb + 5120 + c0, gM); ld16f(gam_p + c0, gam); ld16f(bet_p + c0, bet);
#pragma unroll
    for (int e = 0; e < 16; ++e) gM[e] = (1.f + gM[e]) * (1.f / 16.f);
    int sln[8]; float gwn[8];
    const int tw = r * 4 + (G - r) * WL4, cum0 = c < r ? c * 4 : r * 4 + (c - r) * WL4, cum1 = cum0 + (c < r ? 4 : WL4);
    const int row0 = __builtin_amdgcn_readfirstlane((int)((unsigned)(HTOK * cum0) / (unsigned)tw)), row1 = __builtin_amdgcn_readfirstlane((int)((unsigned)(HTOK * cum1) / (unsigned)tw));
    { const size_t t0 = (size_t)hf * HTOK + (row0 + wave < HTOK ? row0 + wave : 0);
      const int sv_ = SLOTOF[t0 * 8 + (lane & 7)], ss_ = BBL[sv_ >> 16] * 256 + (sv_ & 0xffff);
#pragma unroll
      for (int k = 0; k < 8; ++k) { sln[k] = __builtin_amdgcn_readlane(ss_, k); gwn[k] = __builtin_bit_cast(float, __builtin_amdgcn_readfirstlane(__builtin_bit_cast(int, GATE[t0 * 8 + k]))); } }
    for (int tl = row0 + wave; tl < row1; tl += NWAVES) {
        const size_t t = (size_t)hf * HTOK + tl;
        int sl[8]; float gw8[8];
#pragma unroll
        for (int k = 0; k < 8; ++k) { sl[k] = sln[k]; gw8[k] = gwn[k]; }
        { const int tn = tl + NWAVES < row1 ? tl + NWAVES : tl; const size_t t1 = (size_t)hf * HTOK + tn;
          const int sv_ = SLOTOF[t1 * 8 + (lane & 7)], ss_ = BBL[sv_ >> 16] * 256 + (sv_ & 0xffff);
#pragma unroll
          for (int k = 0; k < 8; ++k) { sln[k] = __builtin_amdgcn_readlane(ss_, k); gwn[k] = __builtin_bit_cast(float, __builtin_amdgcn_readfirstlane(__builtin_bit_cast(int, GATE[t1 * 8 + k]))); } }
        float v[16], ys[16], y[16];
        ld16bf_nt(XB + t * 1024 + c0, v);
        f8x16(ldnt(YR + ((size_t)shbase + tl) * 1024 + c0), ys);
#pragma unroll
        for (int k = 0; k < 8; ++k) { f8x16(ldnt(YR + (size_t)sl[k] * 1024 + c0), y);
#pragma unroll
            for (int e = 0; e < 16; ++e) ys[e] += gw8[k] * y[e]; }
        float s = 0.f;
#pragma unroll
        for (int e = 0; e < 16; ++e) { v[e] = ALPHA * v[e] + gM[e] * ys[e]; s += v[e]; }
        const float mean = wave_sum(s, lane) * (1.f / 1024.f); float s2 = 0.f;
#pragma unroll
        for (int e = 0; e < 16; ++e) { v[e] -= mean; s2 += v[e] * v[e]; }
        const float rstd = 1.f / sqrtf(wave_sum(s2, lane) * (1.f / 1024.f) + LN_EPS);
        float o[16];
#pragma unroll
        for (int e = 0; e < 16; ++e) o[e] = v[e] * rstd * gam[e] + bet[e];
        if (l == 1) {
#pragma unroll
            for (int q = 0; q < 4; ++q) *(f32x4*)(xout + t * 1024 + c0 + 4 * q) = (f32x4){o[4 * q], o[4 * q + 1], o[4 * q + 2], o[4 * q + 3]}; }
        else st16bf(XB + t * 1024 + c0, o);
        if (l == 0) { float h0[8], h1[8], scn[16], shn[16];
            { const float* mq = modn; asm volatile("" : "+s"(mq)); ld16f(mq + 1024 + c0, scn); ld16f(mq + c0, shn); }
#pragma unroll
            for (int e = 0; e < 8; ++e) { h0[e] = o[e] * (1.f + scn[e]) + shn[e]; h1[e] = o[8 + e] * (1.f + scn[8 + e]) + shn[8 + e]; }
            st8bf(H + t * 1024 + c0, h0); st8bf(H + t * 1024 + c0 + 8, h1); }
    }
}

__device__ __forceinline__ void build_block_tables(const unsigned* cnt, LAS unsigned char* lds, int wave, int lane) {
    asm volatile("" : "+v"(lane));
    LAS int* BT = (LAS int*)(lds + BT_OFF); LAS int* BBL = (LAS int*)(lds + BBL_OFF);
    if (wave < 2) { const int h = wave;
        const int n = (int)__hip_atomic_load(cnt + h * 64 + lane, __ATOMIC_RELAXED, __HIP_MEMORY_SCOPE_AGENT), nb = (n + 255) >> 8;
        int inc = nb;
#pragma unroll
        for (int o = 1; o < 64; o <<= 1) { const int up = __builtin_amdgcn_ds_bpermute(((lane - o) & 63) << 2, inc); if (lane >= o) inc += up; }
        const int excl = inc - nb, tot = __builtin_amdgcn_readlane(inc, 63);
        BBL[h * 68 + lane] = excl; if (lane == 0) { BBL[h * 68 + 64] = tot; BBL[h * 68 + 65] = tot + 64; }
        for (int j = 0; j < nb; ++j) BT[h * MAXBLK + excl + j] = lane | (j << 8);
        BT[h * MAXBLK + tot + lane] = 64 | (lane << 8);
    }
    __syncthreads();
}
constexpr int PH_PER_LAYER = 12, PH_BASE = 3, NPH = PH_BASE + DEPTH * PH_PER_LAYER;
#ifndef MK_PER_PHASE
#define MK_PER_PHASE 0
#endif

typedef const __attribute__((address_space(4))) Args* KArgsPtr;
__device__ __forceinline__ Args load_args() {
#if defined(__HIP_DEVICE_COMPILE__)
    KArgsPtr p = (KArgsPtr)__builtin_amdgcn_kernarg_segment_ptr(); asm volatile("" : "+s"(p));
    Args a;
#pragma unroll
    for (int i = 0; i < 21; ++i) a.in[i] = p->in[i];
    a.out = p->out; a.ws = p->ws; a.ph_lo = p->ph_lo; a.ph_hi = p->ph_hi; return a;
#else
    return Args{};
#endif
}
__global__ void __launch_bounds__(NWAVES * 64, 2) mk_fwd(Args args) {
    extern __shared__ __attribute__((aligned(16))) unsigned char lds_raw[];
    LAS unsigned char* lds = (LAS unsigned char*)lds_raw;
    volatile LAS unsigned* MISC = (volatile LAS unsigned*)(lds + MISC_OFF);
    const int wave = __builtin_amdgcn_readfirstlane((int)threadIdx.x >> 6);
    const int G = gridDim.x, bx = blockIdx.x; const int vcu = (G % 8 == 0) ? (bx % 8) * (G / 8) + bx / 8 : bx;
    const int gw = vcu * NWAVES + wave, NGW = G * NWAVES;
    unsigned* ctl = (unsigned*)(args.ws + WS_CTL);
    for (int u = wave * 64 + lane_now(); u < (LDS_BYTES - LDSCTL_OFF) / 4; u += NWAVES * 64) ((LAS unsigned*)(lds + LDSCTL_OFF))[u] = 0u;
    __syncthreads();
    const int lo = args.ph_lo, hi = args.ph_hi;
    XcdBarrier bar; bar.bar = ctl + CW_BAR; bar.x = 0; bar.st = MISC + 8; bar.wave = wave;
    if (hi - lo > 1) bar = xcd_barrier_post(ctl + CW_BAR, MISC + 8, wave);
#ifndef LN2_WL4
#define LN2_WL4 8
#endif
#ifndef PHMASK
#define PHMASK 0xFFFF
#endif
#define KIND(i) ((PHMASK >> (i)) & 1)
#define PH(k) (lo <= (k) && (k) < hi)
#define SEAM(k) do { if (PH(k) && PH((k) + 1)) { XcdBarrier _b = bar; asm volatile("" : "+s"(_b.bar)); xcd_barrier(_b); } } while (0)

    if (PH(0) && KIND(0)) { const Args A = load_args(); const int lane = lane_now(), tid = wave * 64 + lane; (void)tid; (void)lane; unsigned char* const ws = A.ws; (void)ws;
        convert_attn_weights(A, lds, gw, NGW, wave, lane);
        {
            const float* adaw = A.in[I_ADA_W]; const float* cv = A.in[I_C]; const float* adab = A.in[I_ADA_B]; float* MOD = (float*)(ws + WS_MOD);
            LAS float* sl = (LAS float*)(lds + 65536); LAS float* part = sl + 2048;
            __syncthreads();
            for (int i = tid; i < 2048; i += 512) { const float c0 = cv[i]; sl[i] = c0 / (1.f + expf(-c0)); }
            __syncthreads();
            for (int pb2 = bx; pb2 < 12288 / 48; pb2 += G) {
                const int jq = tid % 12, ks = tid / 12;
                const int pair = pb2 * 48 + 4 * jq, l = pair / 6144, j = pair % 6144;
                if (ks < 32) { f32x4 a0 = {0.f, 0.f, 0.f, 0.f}, a1 = a0;
#pragma unroll 1
                    for (int k0 = ks * 32; k0 < ks * 32 + 32; k0 += 16) { f32x4 w[16];
#pragma unroll
                        for (int i = 0; i < 16; ++i) w[i] = *(const f32x4*)(adaw + ((size_t)l * 1024 + k0 + i) * 6144 + j);
#pragma unroll
                        for (int i = 0; i < 16; ++i) { a0 += sl[k0 + i] * w[i]; a1 += sl[1024 + k0 + i] * w[i]; } }
#pragma unroll
                    for (int q = 0; q < 4; ++q) { part[(ks * 48 + 4 * jq + q) * 2] = a0[q]; part[(ks * 48 + 4 * jq + q) * 2 + 1] = a1[q]; } }
                __syncthreads();
                if (tid < 96) { const int jj = tid >> 1, b = tid & 1; const int pr = pb2 * 48 + jj, l2 = pr / 6144, j2 = pr % 6144; float s = adab[l2 * 6144 + j2];
                    for (int q = 0; q < 32; ++q) s += part[(q * 48 + jj) * 2 + b];
                    MOD[(size_t)(l2 * 2 + b) * 6144 + j2] = s; }
                __syncthreads();
            }
        }
    }
    SEAM(0);
    if (PH(2) && KIND(2)) { const Args A = load_args(); const int lane = lane_now(), tid = wave * 64 + lane; (void)tid; (void)lane; input_pass(A, lds, gw, NGW, tid, lane); }
    SEAM(2);

    for (int l = 0; l < DEPTH; ++l) {
        const int pb = PH_BASE + l * PH_PER_LAYER;
        if (PH(pb + 0) && KIND(3)) { const Args A = load_args(); const int lane = lane_now(), tid = wave * 64 + lane; (void)tid; (void)lane; unsigned char* const ws = A.ws; (void)ws;
            if (l == 0) { for (int task = bx; task < 256; task += G) fox_scan_seg(A, lds, task, tid, lane, wave); }
            pg8::Gemm g{(const bf16*)(ws + WS_H), (const bf16*)(ws + WS_WATT + (size_t)l * WATT_STRIDE), NTOK, 3 * DM, DM}; pg8::StaticOrder<NTOK / 256, 12> S; S.init(G, bx);
            pg8::EpiQKV E{(bf16*)(ws + WS_Q), (size_t)(WS_K - WS_Q) / 2, l == 0 ? ctl + CW_FOXQ + 16 : nullptr, (LAS float*)(lds + LDSCTL_OFF + 4096)};
            pg8::gemm_phase<pg8::EpiQKV, pg8::StaticOrder<NTOK / 256, 12>, true, false>(lds + RING_OFF, g, S, E, nullptr, wave);
        }
        SEAM(pb + 0);
        if (PH(pb + 1) && KIND(4)) { const Args A = load_args(); const int lane = lane_now(), tid = wave * 64 + lane; (void)tid; (void)lane; unsigned char* const ws = A.ws; (void)ws;
            if (l == 0) {
                const bool conv_first = ((bx >> 3) & 7) == 0;
                if (conv_first) { convert_moe_drain(A.in[I_EG], A.in[I_EU], A.in[I_ED], A.in[I_SG], A.in[I_SU], A.in[I_SD], ws, lds, wave); __syncthreads(); }
                fox::fox_phase((const bf16*)(ws + WS_Q), (const bf16*)(ws + WS_K), (const bf16*)(ws + WS_V), (const bf16*)(ws + WS_KAUG), (bf16*)(ws + WS_O), (const float*)(ws + WS_F), ctl + CW_FOXQ, (char*)lds_raw, wave); __syncthreads();
                convert_moe_drain(A.in[I_EG], A.in[I_EU], A.in[I_ED], A.in[I_SG], A.in[I_SU], A.in[I_SD], ws, lds, wave); __syncthreads(); }
            else { fox::sb_phase((const bf16*)(ws + WS_Q), (const bf16*)(ws + WS_K), (const bf16*)(ws + WS_V), (bf16*)(ws + WS_O), (char*)lds_raw, G, vcu, wave); __syncthreads(); }
        }
        SEAM(pb + 1);
        if (PH(pb + 2) && KIND(5)) { const Args A = load_args(); const int lane = lane_now(), tid = wave * 64 + lane; (void)tid; (void)lane; unsigned char* const ws = A.ws; (void)ws;
            pg8::Gemm g{(const bf16*)(ws + WS_O), (const bf16*)(ws + WS_WATT + (size_t)l * WATT_STRIDE + WATT_O), NTOK, DM, DM}; pg8::StaticOrder<NTOK / 256, 4> S; S.init(G, bx);
            pg8::EpiF8 E{(unsigned char*)(ws + WS_Y), DM, 0xffff};
            pg8::gemm_phase<pg8::EpiF8, pg8::StaticOrder<NTOK / 256, 4>, true, false>(lds + RING_OFF, g, S, E, nullptr, wave);
        }
        SEAM(pb + 2);
        if (PH(pb + 3) && KIND(6)) { const Args A = load_args(); const int lane = lane_now(), tid = wave * 64 + lane; (void)tid; (void)lane; ln1_pass(A, l, gw, NGW, lane); }
        SEAM(pb + 3);
        if (PH(pb + 4) && KIND(7)) { const Args A = load_args(); const int lane = lane_now(), tid = wave * 64 + lane; (void)tid; (void)lane; unsigned char* const ws = A.ws; (void)ws;
            pg8::Gemm g{(const bf16*)(ws + WS_H), (const bf16*)(ws + WS_WATT + (size_t)l * WATT_STRIDE + WATT_R), NTOK, 256, DM}; pg8::StaticOrder<NTOK / 256, 1> S; S.init(G, bx);
            pg8::EpiRouter E{A.in[I_RB] + l * 64, (float*)(ws + WS_GATE), ctl + CW_CNT + l * 128, (int*)(ws + WS_SLOTOF), (unsigned short*)(ws + WS_ROWTOK2)};
            pg8::gemm_phase<pg8::EpiRouter, pg8::StaticOrder<NTOK / 256, 1>, false, false>(lds + RING_OFF, g, S, E, nullptr, wave);
            __syncthreads();
        }
        SEAM(pb + 4);
        for (int hf = 0; hf < 2; ++hf) {
            const int ph = pb + 6 + 3 * hf;
            if (PH(ph) && KIND(9)) { const Args A = load_args(); const int lane = lane_now(), tid = wave * 64 + lane; (void)tid; (void)lane; unsigned char* const ws = A.ws; (void)ws;
                if (hf == 0) build_block_tables(ctl + CW_CNT + l * 128, lds, wave, lane);
                const int nblk = __builtin_amdgcn_readfirstlane(((const LAS int*)(lds + BBL_OFF))[hf * 68 + 65]);
                pg8::Gemm g{(const bf16*)(ws + WS_H) + (size_t)hf * HTOK * DM, (const bf16*)(ws + (l == 0 ? WS_WMOE0 : WS_WMOE1)), 0, 512, DM};
                pg8::MoeOrder S{nblk * 2, 1, G, vcu, (const LAS int*)(lds + BT_OFF) + hf * MAXBLK};
                pg8::EpiSwiglu E{(bf16*)(ws + WS_ACT)};
                pg8::gemm_phase<pg8::EpiSwiglu, pg8::MoeOrder, true, true>(lds + RING_OFF, g, S, E, (const unsigned short*)(ws + WS_ROWTOK2) + (size_t)hf * 65 * 16384, wave);
            }
            SEAM(ph);
            if (PH(ph + 1) && KIND(10)) { const Args A = load_args(); const int lane = lane_now(), tid = wave * 64 + lane; (void)tid; (void)lane; unsigned char* const ws = A.ws; (void)ws;
                const int nblk = __builtin_amdgcn_readfirstlane(((const LAS int*)(lds + BBL_OFF))[hf * 68 + 65]);
                pg8::Gemm g{(const bf16*)(ws + WS_ACT), (const bf16*)(ws + (l == 0 ? WS_WMOE0 : WS_WMOE1) + WMOE_D), 0, 1024, FE};
                pg8::MoeOrder S{nblk * 4, 2, G, vcu, (const LAS int*)(lds + BT_OFF) + hf * MAXBLK};
                pg8::EpiF8 E{(unsigned char*)(ws + WS_YR), DM, 3};
                pg8::gemm_phase<pg8::EpiF8, pg8::MoeOrder, true, false>(lds + RING_OFF, g, S, E, nullptr, wave);
            }
            SEAM(ph + 1);
            if (PH(ph + 2) && KIND(11)) { const Args A = load_args(); const int lane = lane_now(), tid = wave * 64 + lane; (void)tid; (void)lane; unsigned char* const ws = A.ws; (void)ws;
                int r = G, wl4 = 4;
                if (hf == 0) { const int nun = __builtin_amdgcn_readfirstlane(((const LAS int*)(lds + BBL_OFF))[1 * 68 + 65]) * 2; r = nun % G; wl4 = LN2_WL4; }
                ln2_pass(A, lds, l, hf, vcu, G, wave, r, wl4, lane);
            }
            if (hf == 1) SEAM(ph + 2);
        }
    }
#undef PH
#undef SEAM
}

extern "C" void kernel_launch(void* const* d_in, const int* in_sizes, int n_in, void* d_out, int out_size, void* d_ws, size_t ws_size, hipStream_t stream) {
    static int grid = 0;
    if (grid == 0) {
        if (n_in != 21 || in_sizes[0] != NTOK * DM || out_size != NTOK * DM || ws_size < WS_END) {
            fprintf(stderr, "kernel_launch: unexpected shapes (n_in %d, in0 %d, out %d, ws %zu < %zu); nothing launched\n", n_in, n_in > 0 ? in_sizes[0] : -1, out_size, ws_size, (size_t)WS_END); grid = -1; return; }
        int dev = 0, cus = 0;
        if (hipGetDevice(&dev) != hipSuccess || hipDeviceGetAttribute(&cus, hipDeviceAttributeMultiprocessorCount, dev) != hipSuccess) { grid = -1; return; }
        if (hipFuncSetAttribute((const void*)mk_fwd, hipFuncAttributeMaxDynamicSharedMemorySize, LDS_BYTES) != hipSuccess) { fprintf(stderr, "kernel_launch: hipFuncSetAttribute failed\n"); grid = -1; return; }
        int per_cu = 0;
        if (hipOccupancyMaxActiveBlocksPerMultiprocessor(&per_cu, (const void*)mk_fwd, NWAVES * 64, LDS_BYTES) != hipSuccess || per_cu < 1) { fprintf(stderr, "kernel_launch: occupancy query reports %d\n", per_cu); }
        (void)hipGetLastError();
        grid = cus;
        if (grid < 128) { fprintf(stderr, "kernel_launch: needs >= 128 CUs\n"); grid = -1; return; }
    }
    if (grid < 0) return;
    if (hipMemsetAsync((char*)d_ws + WS_CTL, 0, CTL_ZERO_BYTES, stream) != hipSuccess) return;
    Args a{};
    for (int i = 0; i < 21; ++i) a.in[i] = (const float*)d_in[i];
    a.out = (float*)d_out; a.ws = (unsigned char*)d_ws;
#if MK_PER_PHASE
    for (int p = 0; p < NPH; ++p) { a.ph_lo = p; a.ph_hi = p + 1; hipLaunchKernelGGL(mk_fwd, dim3(grid), dim3(NWAVES * 64), LDS_BYTES, stream, a); }
#else
    a.ph_lo = 0; a.ph_hi = NPH;
    hipLaunchKernelGGL(mk_fwd, dim3(grid), dim3(NWAVES * 64), LDS_BYTES, stream, a);
#endif
}
```

```cpp
#include <hip/hip_runtime.h>
#include <cstdio>
#include <cstdint>
#include <cmath>
__device__ __forceinline__ int lane_now() { int l; asm volatile("v_mbcnt_lo_u32_b32 %0, -1, 0\n\tv_mbcnt_hi_u32_b32 %0, -1, %0" : "=v"(l)); return l; }
namespace pg8 {
#define PG8_LAS __attribute__((address_space(3)))
typedef unsigned short bf16_t;
typedef short bf16x8 __attribute__((ext_vector_type(8)));
typedef float f32x4 __attribute__((ext_vector_type(4)));
typedef unsigned u32x4 __attribute__((ext_vector_type(4)));
constexpr int RTL_OFF = 131072 + 8192;
constexpr int BM = 256, BK = 64, HALF = 128, HTB = HALF * BK * 2  , STAGE_BYTES = 8 * HTB, NXCD = 8, WGM = 8;

__host__ __device__ __forceinline__ int lds_byte(int r, int c) { const int st = (r >> 4) * 2 + (c >> 5), rr = r & 15, cc = c & 31, ob = rr * 64 + cc * 2; return st * 1024 + (ob ^ (((ob >> 9) & 1) << 5)); }
__host__ __device__ __forceinline__ void stage_rc(int b, int& R, int& C) { const int st = b / 1024, sb = b % 1024, swz = sb ^ (((sb >> 9) & 1) << 5); R = (st >> 1) * 16 + swz / 64; C = (st & 1) * 32 + (swz % 64) / 2; }
__host__ __device__ __forceinline__ int perm32(int rho) { const int n = rho >> 4, i = rho & 15; return 8 * (i >> 2) + 4 * n + (i & 3); }

struct Unit { int pm, pn, aux; };
struct Gemm { const bf16_t* A; const bf16_t* Bt; int M, N, K; };

template <int NM, int NN> struct StaticOrder {
    int G, c;
    __host__ __device__ void init(int G_, int c_) { G = G_; c = c_; }
    __host__ __device__ bool next(int i, Unit& u) const {
        constexpr int nwg = NM * NN;
        const int L = i * G + c; if (L >= nwg) return false;
        int wgid = L; { constexpr int q = nwg / NXCD, r = nwg % NXCD; const int xcd = wgid % NXCD, off = wgid / NXCD; wgid = (xcd < r ? xcd * (q + 1) : r * (q + 1) + (xcd - r) * q) + off; }
        constexpr int nig = WGM * NN; const int gid = wgid / nig, fm = gid * WGM, gsz = (NM - fm) < WGM ? (NM - fm) : WGM;
        u.pm = fm + ((wgid % nig) % gsz); u.pn = (wgid % nig) / gsz; u.aux = 0; return true;
    }
};
struct MoeOrder {
    int nunits, sh, G, c; const PG8_LAS int* bt;
    __device__ __forceinline__ bool next(int i, Unit& u) const {
        const long L = (long)i * G + c; if (L >= nunits) return false;
        const int blk = (int)(L >> sh), pnl = (int)L & ((1 << sh) - 1);
        const int v = __builtin_amdgcn_readfirstlane(bt[blk]);
        u.pm = blk; u.pn = ((v & 255) << sh) + pnl; u.aux = v; return true;
    }
};

__device__ __forceinline__ unsigned cvt_pk_bf16(float lo, float hi) { unsigned r; asm volatile("v_cvt_pk_bf16_f32 %0, %1, %2" : "=v"(r) : "v"(lo), "v"(hi)); return r; }


struct EpiBf16 {
    static constexpr int PERMW = 1; static constexpr bool AFTER_DRAIN = false;
    bf16_t* O; int ldc; int pn_mask;
    __device__ __forceinline__ void operator()(const f32x4 (&acc)[2][2][4][2], const Unit& u, int wr, int wc, int fr, int fq) const {
        { const int tz = lane_now(); fr = tz & 15; fq = (tz >> 4) & 3; }
        char* base = (char*)(O + (size_t)(u.pm * BM + wr * 64) * ldc + (u.pn & pn_mask) * BM + wc * 32);
        const unsigned lo = (unsigned)(fr * ldc + 8 * fq) * 2u;
#pragma unroll
        for (int ai = 0; ai < 2; ++ai)
#pragma unroll
            for (int m = 0; m < 4; ++m)
#pragma unroll
                for (int bj = 0; bj < 2; ++bj) { const f32x4 v0 = acc[ai][bj][m][0], v1 = acc[ai][bj][m][1];
                    u32x4 w; w.x = cvt_pk_bf16(v0[0], v0[1]); w.y = cvt_pk_bf16(v0[2], v0[3]); w.z = cvt_pk_bf16(v1[0], v1[1]); w.w = cvt_pk_bf16(v1[2], v1[3]);
                    *(u32x4*)(base + (size_t)(lo + (unsigned)(((ai * HALF + m * 16) * ldc + bj * HALF) * 2))) = w; }
    }
};
struct EpiQKV {
    static constexpr int PERMW = 1; static constexpr bool AFTER_DRAIN = false;
    bf16_t* Q; size_t qkv_stride;
    unsigned* nrm; PG8_LAS float* rs;
    __device__ __forceinline__ void operator()(const f32x4 (&acc)[2][2][4][2], const Unit& u, int wr, int wc, int fr, int fq) const {
        const int lz = lane_now(); fr = lz & 15; fq = (lz >> 4) & 3;
        const int which = u.pn >> 2; bf16_t* base = Q + (size_t)which * qkv_stride;
        const int r0 = u.pm * BM + wr * 64 + fr, b = r0 >> 14, s0 = r0 & 16383;
        const bool norms = nrm != nullptr && which == 1;
        if (norms) { rs[wr * 256 + wc * 64 + lz] = 0.f; asm volatile("s_waitcnt lgkmcnt(0)" ::: "memory"); __builtin_amdgcn_s_barrier(); }
#pragma unroll
        for (int ai = 0; ai < 2; ++ai)
#pragma unroll
            for (int m = 0; m < 4; ++m) { const int s = s0 + ai * HALF + m * 16;
#pragma unroll
                for (int bj = 0; bj < 2; ++bj) { const int head = 2 * (u.pn & 3) + bj;
                    bf16_t* p = base + ((size_t)(b * 8 + head) * 16384 + s) * 128 + wc * 32 + 8 * fq;
                    const f32x4 v0 = acc[ai][bj][m][0], v1 = acc[ai][bj][m][1];
                    u32x4 w; w.x = cvt_pk_bf16(v0[0], v0[1]); w.y = cvt_pk_bf16(v0[2], v0[3]); w.z = cvt_pk_bf16(v1[0], v1[1]); w.w = cvt_pk_bf16(v1[2], v1[3]);
                    *(u32x4*)p = w;
                    if (norms) { float ss = 0.f;
#pragma unroll
                        for (int q = 0; q < 4; ++q) { const unsigned d = q == 0 ? w.x : q == 1 ? w.y : q == 2 ? w.z : w.w; const float lo = __builtin_bit_cast(float, d << 16), hi = __builtin_bit_cast(float, d & 0xffff0000u); ss += lo * lo + hi * hi; }
                        ss += __builtin_bit_cast(float, __builtin_amdgcn_ds_bpermute((lz ^ 16) << 2, __builtin_bit_cast(int, ss)));
                        ss += __builtin_bit_cast(float, __builtin_amdgcn_ds_bpermute((lz ^ 32) << 2, __builtin_bit_cast(int, ss)));
                        if (fq == 0) (void)__hip_atomic_fetch_add(rs + (ai * HALF + wr * 64 + m * 16 + fr) * 2 + bj, ss, __ATOMIC_RELAXED, __HIP_MEMORY_SCOPE_WORKGROUP); } } }
        if (norms) { asm volatile("s_waitcnt lgkmcnt(0)" ::: "memory"); __builtin_amdgcn_s_barrier();
            float mx = rs[wr * 256 + wc * 64 + lz];
#pragma unroll
            for (int o = 2; o < 64; o <<= 1) mx = fmaxf(mx, __builtin_bit_cast(float, __builtin_amdgcn_ds_bpermute((lz ^ o) << 2, __builtin_bit_cast(int, mx))));
            if (lz < 2) { const int bh = b * 8 + 2 * (u.pn & 3) + lz;
                atomicMax(nrm + bh, __builtin_bit_cast(unsigned, mx * 1.001f)); }
            asm volatile("s_waitcnt lgkmcnt(0)" ::: "memory"); __builtin_amdgcn_s_barrier(); }
    }
};
__device__ __forceinline__ float silu_f(float g) { return g * __builtin_amdgcn_rcpf(1.0f + __builtin_amdgcn_exp2f(-1.4426950408889634f * g)); }
struct EpiSwiglu {
    static constexpr int PERMW = 1; static constexpr bool AFTER_DRAIN = false;
    bf16_t* ACT;
    __device__ __forceinline__ void operator()(const f32x4 (&acc)[2][2][4][2], const Unit& u, int wr, int wc, int fr, int fq) const {
        { const int tz = lane_now(); fr = tz & 15; fq = (tz >> 4) & 3; }
        const int row0 = u.pm * BM + wr * 64 + fr; const int col0 = (u.pn & 1) * 128 + wc * 32 + 8 * fq;
#pragma unroll
        for (int ai = 0; ai < 2; ++ai)
#pragma unroll
            for (int m = 0; m < 4; ++m) { bf16_t* rowp = ACT + (size_t)(row0 + ai * HALF + m * 16) * 256 + col0;
                const f32x4 g0 = acc[ai][0][m][0], g1 = acc[ai][0][m][1], u0 = acc[ai][1][m][0], u1 = acc[ai][1][m][1];
                float a[8];
#pragma unroll
                for (int j = 0; j < 4; ++j) { a[j] = silu_f(g0[j]) * u0[j]; a[4 + j] = silu_f(g1[j]) * u1[j]; }
                u32x4 w; w.x = cvt_pk_bf16(a[0], a[1]); w.y = cvt_pk_bf16(a[2], a[3]); w.z = cvt_pk_bf16(a[4], a[5]); w.w = cvt_pk_bf16(a[6], a[7]);
                *(u32x4*)rowp = w; }
    }
};
struct EpiF8 {
    static constexpr int PERMW = 2; static constexpr bool AFTER_DRAIN = false;
    unsigned char* O; int ldc; int pn_mask;
    __device__ __forceinline__ void operator()(const f32x4 (&acc)[2][2][4][2], const Unit& u, int wr, int wc, int fr, int fq) const {
        { const int tz = lane_now(); fr = tz & 15; fq = (tz >> 4) & 3; }
        char* base = (char*)(O + (size_t)(u.pm * BM + wr * 64) * ldc + (u.pn & pn_mask) * BM + wc * 64);
        const unsigned lo = (unsigned)(fr * ldc + 16 * fq);
#pragma unroll
        for (int ai = 0; ai < 2; ++ai)
#pragma unroll
            for (int m = 0; m < 4; ++m) { u32x4 w;
                { const f32x4 a = acc[ai][0][m][0] * 16.f, b = acc[ai][0][m][1] * 16.f; int t = 0; t = __builtin_amdgcn_cvt_pk_fp8_f32(a[0], a[1], t, false); t = __builtin_amdgcn_cvt_pk_fp8_f32(a[2], a[3], t, true); w.x = (unsigned)t;
                  int t2 = 0; t2 = __builtin_amdgcn_cvt_pk_fp8_f32(b[0], b[1], t2, false); t2 = __builtin_amdgcn_cvt_pk_fp8_f32(b[2], b[3], t2, true); w.y = (unsigned)t2; }
                { const f32x4 a = acc[ai][1][m][0] * 16.f, b = acc[ai][1][m][1] * 16.f; int t = 0; t = __builtin_amdgcn_cvt_pk_fp8_f32(a[0], a[1], t, false); t = __builtin_amdgcn_cvt_pk_fp8_f32(a[2], a[3], t, true); w.z = (unsigned)t;
                  int t2 = 0; t2 = __builtin_amdgcn_cvt_pk_fp8_f32(b[0], b[1], t2, false); t2 = __builtin_amdgcn_cvt_pk_fp8_f32(b[2], b[3], t2, true); w.w = (unsigned)t2; }
                __builtin_nontemporal_store(w, (u32x4*)(base + (size_t)(lo + (unsigned)((ai * HALF + m * 16) * ldc)))); }
    }
};
struct EpiRouter {
    static constexpr int PERMW = 0; static constexpr bool AFTER_DRAIN = true;
    const float* rbias; float* gate; unsigned* cnt; int* slotof; unsigned short* rowtok2;
    __device__ __forceinline__ void fused(const f32x4 (&acc)[2][2][4][2], const Unit& u, int wr, int wc, int fr, int fq, PG8_LAS unsigned char* lds, int wid, int lane) const {
        PG8_LAS float* L = (PG8_LAS float*)lds;
        PG8_LAS float* Bs = (PG8_LAS float*)(lds + 256 * 65 * 4);
        PG8_LAS unsigned* H = (PG8_LAS unsigned*)(lds + 256 * 65 * 4 + 256);
        PG8_LAS unsigned* GB = H + 64;
        { const int tz = lane_now(); lane = tz; fr = tz & 15; fq = (tz >> 4) & 3; }
        const int tid = wid * 64 + lane;
        if (tid < 64) { Bs[tid] = rbias[tid]; H[tid] = 0u; }
        if (wc < 2) {
#pragma unroll
            for (int ai = 0; ai < 2; ++ai)
#pragma unroll
                for (int m = 0; m < 4; ++m)
#pragma unroll
                    for (int n = 0; n < 2; ++n) { const int row = 128 * ai + 64 * wr + 16 * m + fr, col = 32 * wc + 16 * n + 4 * fq;
                        const f32x4 v = acc[ai][0][m][n] + acc[ai][1][m][n];
                        L[row * 65 + col + 0] = v[0]; L[row * 65 + col + 1] = v[1]; L[row * 65 + col + 2] = v[2]; L[row * 65 + col + 3] = v[3]; }
        }
        __syncthreads();
        const int half = (u.pm * BM) >> 14;
        int si[8]; unsigned lr[8];
        if (tid < 256) {
            const int t = u.pm * BM + tid; PG8_LAS float* Lr = L + tid * 65;
            for (int e = 0; e < 64; ++e) { const float x = Lr[e]; Lr[e] = 1.0f / (1.0f + expf(-x)) + Bs[e]; }
            float sv[8]; float sum = 0.f;
#pragma unroll
            for (int p = 0; p < 8; ++p) { float bv = -3.0e38f; int bi = 0;
                for (int e = 0; e < 64; ++e) { const float x = Lr[e]; if (x > bv) { bv = x; bi = e; } }
                si[p] = bi; sv[p] = bv - Bs[bi]; sum += sv[p]; Lr[bi] = -3.0e38f; }
            const float inv = 2.5f / sum;
#pragma unroll
            for (int p = 0; p < 8; ++p) { gate[(size_t)t * 8 + p] = sv[p] * inv; lr[p] = atomicAdd((unsigned*)&H[si[p]], 1u); }
        }
        __syncthreads();
        if (tid < 64) { const unsigned h = H[tid]; GB[tid] = h ? atomicAdd(cnt + half * 64 + tid, h) : 0u; }
        __syncthreads();
        if (tid < 256) {
            const int t = u.pm * BM + tid, tl = t - half * 16384;
#pragma unroll
            for (int p = 0; p < 8; ++p) { const unsigned pos = GB[si[p]] + lr[p];
                slotof[(size_t)t * 8 + p] = (int)(((unsigned)si[p] << 16) | pos);
                rowtok2[((size_t)(half * 65 + si[p]) << 14) + pos] = (unsigned short)tl; }
            rowtok2[((size_t)(half * 65 + 64) << 14) + tl] = (unsigned short)tl;
        }
    }
};

template <class Epi, class Sched, bool ALIGN_EPI, bool GATHER>
__device__ __forceinline__ void gemm_phase(PG8_LAS unsigned char* lds, const Gemm g, const Sched& S, const Epi& E, const unsigned short* __restrict__ rowtok, int wave) {
    const int wid = wave, lane = lane_now(), tid = wid * 64 + lane;
    const int wr = wid >> 2, wc = wid & 3, fr = lane & 15, fq = lane >> 4;
    const int K = g.K, nt = K / BK;
    unsigned voffB[2];
#pragma unroll
    for (int i = 0; i < 2; ++i) { int R, C; stage_rc(tid * 16 + i * 8192, R, C); const int Rb = Epi::PERMW == 1 ? ((R & ~31) + perm32(R & 31)) : Epi::PERMW == 2 ? (64 * (R >> 5) + 16 * ((R & 15) >> 2) + 4 * ((R >> 4) & 1) + (R & 3)) : R;
        voffB[i] = (unsigned)(Rb * K + C) * 2u; }
    const size_t kstep = (size_t)(BK * 2);
    const size_t hstep = (size_t)HALF * K * 2;
    const size_t tstep = 2 * hstep;
    const size_t bstep = Epi::PERMW == 2 ? (size_t)8 * K * 2 : hstep;
    const unsigned ldsw = (unsigned)wid * 1024u;
    const int aoff = lds_byte(wr * 64 + fr, fq * 8), boff = lds_byte(wc * 32 + fr, fq * 8);
#define PG8_SA(b, h) (((b) * 2 + (h)) * HTB)
#define PG8_SB(b, h) ((4 + (b) * 2 + (h)) * HTB)
#define PG8_STAGE_B(bufoff, gbase) do { _Pragma("unroll") for (int _i = 0; _i < 2; ++_i) \
        __builtin_amdgcn_global_load_lds((const unsigned*)((const char*)(gbase) + voffB[_i]), (PG8_LAS unsigned*)(lds + (bufoff) + ldsw + _i * 8192), 16, 0, 0); } while (0)
#define PG8_STAGE_A(bufoff, gbase, h, OFFS) do { const char* _gb = (const char*)(gbase) + (GATHER ? (size_t)0 : (size_t)(h) * hstep); \
        __builtin_amdgcn_global_load_lds((const unsigned*)(_gb + (GATHER ? OFFS[h][0] : OFFS[0][0])), (PG8_LAS unsigned*)(lds + (bufoff) + ldsw), 16, 0, 0); \
        __builtin_amdgcn_global_load_lds((const unsigned*)(_gb + (GATHER ? OFFS[h][1] : OFFS[0][1])), (PG8_LAS unsigned*)(lds + (bufoff) + ldsw + 8192), 16, 0, 0); } while (0)
#define PG8_LDA(dst, b, h) do { _Pragma("unroll") for (int m = 0; m < 4; ++m) _Pragma("unroll") for (int k = 0; k < 2; ++k) dst[m][k] = *(const PG8_LAS bf16x8*)(lds + PG8_SA(b, h) + aoff + m * 2048 + k * 1024); } while (0)
#define PG8_LDB(dst, b, h) do { _Pragma("unroll") for (int n = 0; n < 2; ++n) _Pragma("unroll") for (int k = 0; k < 2; ++k) dst[n][k] = *(const PG8_LAS bf16x8*)(lds + PG8_SB(b, h) + boff + n * 2048 + k * 1024); } while (0)
#define PG8_MMA(ai, bj, At, Bt) do { __builtin_amdgcn_s_setprio(1); _Pragma("unroll") for (int m = 0; m < 4; ++m) _Pragma("unroll") for (int n = 0; n < 2; ++n) _Pragma("unroll") for (int k = 0; k < 2; ++k) \
        acc[ai][bj][m][n] = __builtin_amdgcn_mfma_f32_16x16x32_bf16(Bt[n][k], At[m][k], acc[ai][bj][m][n], 0, 0, 0); __builtin_amdgcn_s_setprio(0); } while (0)
#define PG8_WAIT_V(n) asm volatile("s_waitcnt vmcnt(" #n ")" ::: "memory")
#define PG8_WAIT_L(n) asm volatile("s_waitcnt lgkmcnt(" #n ")" ::: "memory")
#define PG8_BAR __builtin_amdgcn_s_barrier()
#define PG8_SCHED __builtin_amdgcn_sched_barrier(0)
#define PG8_VA(dst, U) do { const int _tz = wid * 64 + lane_now(); _Pragma("unroll") for (int _i = 0; _i < 2; ++_i) { int _R, _C; stage_rc(_tz * 16 + _i * 8192, _R, _C); \
        _Pragma("unroll") for (int _h = 0; _h < 2; ++_h) { \
        if constexpr (GATHER) dst[_h][_i] = (unsigned)rowtok[(((U).aux & 255) << 14) + ((U).aux >> 8) * BM + _h * HALF + _R] * (unsigned)(K * 2) + (unsigned)(_C * 2); \
        else dst[_h][_i] = (unsigned)(_R * K + _C) * 2u; } } } while (0)
#define PG8_VA_LDS(dst) do { int _R, _C; stage_rc((wid * 64 + lane_now()) * 16, _R, _C); const PG8_LAS unsigned short* _rp = (const PG8_LAS unsigned short*)(lds + RTL_OFF) + _R;     \
        const unsigned _cb = (unsigned)(_C * 2), _ks = (unsigned)(K * 2); dst[0][0] = _rp[0] * _ks + _cb; dst[0][1] = _rp[64] * _ks + _cb; dst[1][0] = _rp[128] * _ks + _cb; dst[1][1] = _rp[192] * _ks + _cb; } while (0)
    Unit cur, nxt; int ui = 0;
    if (!S.next(0, cur)) return;
    f32x4 acc[2][2][4][2];
#pragma unroll
    for (int a = 0; a < 2; ++a)
#pragma unroll
        for (int b = 0; b < 2; ++b)
#pragma unroll
            for (int m = 0; m < 4; ++m)
#pragma unroll
                for (int n = 0; n < 2; ++n) acc[a][b][m][n] = (f32x4){0.f, 0.f, 0.f, 0.f};
    bf16x8 At[4][2], B0[2][2], B1[2][2];
    unsigned vaC[2][2], vaN[2][2];
    PG8_VA(vaC, cur);
    const char* cA = GATHER ? (const char*)g.A : (const char*)g.A + (size_t)cur.pm * tstep; const char* cB = (const char*)g.Bt + (size_t)cur.pn * tstep;
    PG8_STAGE_B(PG8_SB(0, 0), cB); PG8_STAGE_B(PG8_SB(0, 1), cB + bstep); PG8_STAGE_A(PG8_SA(0, 0), cA, 0, vaC); PG8_STAGE_A(PG8_SA(0, 1), cA, 1, vaC);
    if (wr == 1) PG8_BAR;
    PG8_WAIT_V(2); PG8_BAR;
    PG8_STAGE_B(PG8_SB(1, 0), cB + kstep); PG8_STAGE_A(PG8_SA(1, 0), cA + kstep, 0, vaC); PG8_STAGE_B(PG8_SB(1, 1), cB + bstep + kstep);
    PG8_WAIT_V(6); PG8_BAR;
    for (;;) {
        const bool has_next = S.next(ui + 1, nxt);
        const char* nA = GATHER ? (const char*)g.A : (has_next ? (const char*)g.A + (size_t)nxt.pm * tstep : cA); const char* nB = has_next ? (const char*)g.Bt + (size_t)nxt.pn * tstep : cB;
        if constexpr (GATHER) {
            if (has_next && wid < 2) __builtin_amdgcn_global_load_lds((const unsigned*)(rowtok + ((nxt.aux & 255) << 14) + (nxt.aux >> 8) * BM) + wid * 64 + lane_now(), (PG8_LAS unsigned*)(lds + RTL_OFF + wid * 256), 4, 0, 0); }
#pragma unroll
        for (int h = 0; h < 2; ++h)
#pragma unroll
            for (int i = 0; i < 2; ++i) vaN[h][i] = vaC[h][i];
#pragma nounroll
        for (int t = 0; t < nt; t += 2) {
            const bool last = (t == nt - 2);
            const char* a1 = cA + (size_t)(t + 1) * kstep;
            const char* a2 = last ? nA : cA + (size_t)(t + 2) * kstep; const char* b2 = last ? nB : cB + (size_t)(t + 2) * kstep;
            const char* a3 = a2 + kstep; const char* b3 = b2 + kstep;
            if constexpr (GATHER) { if (last && has_next) { PG8_VA_LDS(vaN); } }
            unsigned o2[2][2];
#pragma unroll
            for (int h = 0; h < 2; ++h)
#pragma unroll
                for (int i = 0; i < 2; ++i) o2[h][i] = (GATHER && last) ? vaN[h][i] : vaC[h][i];
            PG8_LDB(B0, 0, 0); PG8_LDB(B1, 0, 1); PG8_SCHED; PG8_LDA(At, 0, 0); PG8_STAGE_A(PG8_SA(1, 1), a1, 1, vaC);
            PG8_WAIT_V(8); PG8_WAIT_L(0); PG8_BAR; PG8_MMA(0, 0, At, B0); PG8_MMA(0, 1, At, B1); PG8_BAR; PG8_SCHED;
            PG8_LDA(At, 0, 1); PG8_STAGE_B(PG8_SB(0, 0), b2); PG8_STAGE_B(PG8_SB(0, 1), b2 + bstep); PG8_STAGE_A(PG8_SA(0, 0), a2, 0, o2);
            PG8_WAIT_V(8); PG8_WAIT_L(0); PG8_BAR; PG8_MMA(1, 0, At, B0); PG8_MMA(1, 1, At, B1); PG8_BAR; PG8_SCHED;
            PG8_LDB(B0, 1, 0); PG8_LDB(B1, 1, 1); PG8_SCHED; PG8_LDA(At, 1, 0); PG8_STAGE_A(PG8_SA(0, 1), a2, 1, o2);
            PG8_WAIT_V(8); PG8_WAIT_L(0); PG8_BAR; PG8_MMA(0, 0, At, B0); PG8_MMA(0, 1, At, B1); PG8_BAR; PG8_SCHED;
            PG8_LDA(At, 1, 1); PG8_STAGE_B(PG8_SB(1, 0), b3); PG8_STAGE_B(PG8_SB(1, 1), b3 + bstep); PG8_STAGE_A(PG8_SA(1, 0), a3, 0, o2);
            PG8_WAIT_V(8); PG8_WAIT_L(0); PG8_BAR; PG8_MMA(1, 0, At, B0); PG8_MMA(1, 1, At, B1); PG8_BAR; PG8_SCHED;
        }
        if constexpr (ALIGN_EPI) { if (wr == 0) PG8_BAR; }
        if constexpr (!Epi::AFTER_DRAIN) { E(acc, cur, wr, wc, fr, fq); }
        if (!has_next) break;
#pragma unroll
        for (int a = 0; a < 2; ++a)
#pragma unroll
            for (int b = 0; b < 2; ++b)
#pragma unroll
                for (int m = 0; m < 4; ++m)
#pragma unroll
                    for (int n = 0; n < 2; ++n) acc[a][b][m][n] = (f32x4){0.f, 0.f, 0.f, 0.f};
        cur = nxt; cA = nA; cB = nB; ++ui;
#pragma unroll
        for (int h = 0; h < 2; ++h)
#pragma unroll
            for (int i = 0; i < 2; ++i) vaC[h][i] = vaN[h][i];
        if constexpr (ALIGN_EPI) { if (wr == 1) PG8_BAR; }
    }
    PG8_WAIT_V(0);
    if constexpr (!ALIGN_EPI) { if (wr == 0) PG8_BAR; }
    PG8_BAR;
    if constexpr (Epi::AFTER_DRAIN) { E.fused(acc, cur, wr, wc, fr, fq, lds, wid, lane); }
#undef PG8_SA
#undef PG8_SB
#undef PG8_STAGE_A
#undef PG8_STAGE_B
#undef PG8_LDA
#undef PG8_LDB
#undef PG8_MMA
#undef PG8_WAIT_V
#undef PG8_WAIT_L
#undef PG8_BAR
#undef PG8_SCHED
#undef PG8_VA
#undef PG8_VA_LDS
}
}
constexpr int NWAVES = 8;
constexpr int NB = 2, SEQ = 16384, DM = 1024, NH = 8, HD = 128, NE = 64, TOPK = 8, FE = 256, DEPTH = 2;
constexpr int NTOK = NB * SEQ;
constexpr int HTOK = NTOK / 2;
constexpr int NSLOT = 9;
constexpr float LN_EPS = 1e-5f, ALPHA = 1.4142135623730951f, ATTN_SCALE = 0.08838834764831845f;
constexpr int MAXBLK = 640;

constexpr size_t MiB = 1u << 20;
constexpr size_t WS_CTL = 0, CTL_ZERO_BYTES = 1 * MiB;
constexpr size_t WS_MOD = 1 * MiB;
constexpr size_t WS_BSUM = WS_MOD + 128 * 1024;
constexpr size_t WS_ROUTE = 3 * MiB;
constexpr size_t WS_IDX = WS_ROUTE, WS_GATE = WS_ROUTE + 1 * MiB;
constexpr size_t ROWS_HALF = (size_t)MAXBLK * 256;
constexpr size_t WS_ROWTOK = WS_ROUTE + 2 * MiB, WS_SLOTOF = WS_ROWTOK + 2 * ROWS_HALF * 4  , WS_BLKEXP = WS_SLOTOF + 1 * MiB + 512 * 1024;
constexpr size_t WS_ROWTOK2 = 10 * MiB;
constexpr size_t WS_AUX = 10 * MiB;
constexpr size_t WS_LOGF = WS_AUX, WS_F = WS_AUX + 1 * MiB, WS_KAUG = WS_AUX + 2 * MiB;
constexpr size_t WS_WATT = 16 * MiB, WATT_STRIDE = 9 * MiB;
constexpr size_t WATT_O = 6 * MiB, WATT_R = 8 * MiB;
constexpr size_t WS_WMOE0 = 34 * MiB, WS_WMOE1 = 500 * MiB, WMOE_D = 65 * MiB;
constexpr size_t WS_H = 132 * MiB;
constexpr size_t WS_BIG = 196 * MiB;
constexpr size_t WS_Q = WS_BIG, WS_K = WS_BIG + 64 * MiB, WS_V = WS_BIG + 128 * MiB, WS_O = WS_H, WS_Y = WS_Q;
constexpr size_t WS_ACT = WS_BIG, WS_YR = WS_BIG + 80 * MiB;
constexpr size_t WS_XB = 436 * MiB;
static_assert(WS_YR + (size_t)MAXBLK * 256 * 1024 <= WS_XB && WS_V + 64 * MiB <= WS_XB && WS_XB + 64 * MiB <= WS_WMOE1 && WS_WMOE0 + 98 * MiB <= WS_H && WS_WATT + 2 * WATT_STRIDE <= WS_WMOE0, "d_ws map (1)");
constexpr size_t WS_END = WS_WMOE1 + WMOE_D + (size_t)65 * 1024 * 256 * 2;
static_assert(WS_ROWTOK2 + (size_t)2 * 65 * 16384 * 2 <= WS_WATT && WS_V - WS_K == WS_K - WS_Q && WS_BLKEXP + 4 * MAXBLK * 4 + 64 <= WS_AUX && WS_SLOTOF + (size_t)NTOK * 8 * 4 <= WS_BLKEXP && WS_END <= (size_t)598 * MiB, "d_ws map");
constexpr int CW_BAR = 4096;
constexpr int CW_CNT = 8192;
constexpr int CW_CUR = 8192 + 256;
constexpr int CW_CONVQ = 12288;
constexpr int CW_FOXQ = 16384;

constexpr int RING_OFF = 0, RING_BYTES = 131072;
constexpr int LDSCTL_OFF = RING_BYTES, MISC_OFF = LDSCTL_OFF + 320;
static_assert(pg8::RTL_OFF == LDSCTL_OFF + 8192, "LDS map");
constexpr int BT_OFF = LDSCTL_OFF + 9216;
constexpr int BBL_OFF = BT_OFF + 2 * MAXBLK * 4;
static_assert(BBL_OFF + 2 * 68 * 4 <= 147456, "LDS map (2)");
constexpr int LDS_BYTES = 147456;

#define GAS __attribute__((address_space(1)))
#define LAS __attribute__((address_space(3)))
typedef unsigned short bf16;
typedef unsigned v4u __attribute__((ext_vector_type(4)));
typedef float f32x4 __attribute__((ext_vector_type(4)));
#define LDS_WAIT() asm volatile("s_waitcnt lgkmcnt(0)" ::: "memory")
#define VM_WAIT() asm volatile("s_waitcnt vmcnt(0)" ::: "memory")
__device__ __forceinline__ unsigned f2bf(float f) { unsigned u = __builtin_bit_cast(unsigned, f); return (u + 0x7fffu + ((u >> 16) & 1u)) >> 16; }
__device__ __forceinline__ unsigned pk2(float lo, float hi) { return f2bf(lo) | (f2bf(hi) << 16); }
__device__ __forceinline__ float bflo(unsigned w) { return __builtin_bit_cast(float, w << 16); }
__device__ __forceinline__ float bfhi(unsigned w) { return __builtin_bit_cast(float, w & 0xffff0000u); }

#define XB_TMO      128
#define XB_XCNT(j)  (256  + 64 * (j))
#define XB_XSUB(j)  (1280 + 64 * (j))
#define XB_XGEN(j)  (2304 + 64 * (j))
#define XB_TOP      3328
#define XB_TOPGEN   3392
#define XCD_BAR_WORDS 3456
#define XB_SPIN_CAP (1u << 26)

__device__ __forceinline__ unsigned xb_ld(unsigned* p)              { return __hip_atomic_load(p, __ATOMIC_RELAXED, __HIP_MEMORY_SCOPE_AGENT); }
__device__ __forceinline__ unsigned xb_add(unsigned* p, unsigned v) { return __hip_atomic_fetch_add(p, v, __ATOMIC_RELAXED, __HIP_MEMORY_SCOPE_AGENT); }
__device__ __forceinline__ unsigned xb_xcc_id() { return (unsigned)__builtin_amdgcn_s_getreg((3 << 11) | 20) & 0xFu; }
#define XB_SPIN(cond, bar) do { unsigned _sp = 0; while (cond) { __builtin_amdgcn_s_sleep(1); \
    if ((++_sp & 255u) == 0u) { if (xb_ld(&(bar)[XB_TMO])) break; if (_sp > XB_SPIN_CAP) { atomicAdd(&(bar)[XB_TMO], 1u); break; } } } } while (0)

struct XcdBarrier {
    unsigned* bar; unsigned x; int wave;
    volatile LAS unsigned* st;
};
__device__ __forceinline__ XcdBarrier xcd_barrier_post(unsigned* bar, volatile LAS unsigned* st, int wave) {
    XcdBarrier b; b.bar = bar; b.x = xb_xcc_id(); b.st = st; b.wave = wave;
    if (wave == 0 && lane_now() == 0) (void)xb_add(&bar[XB_XCNT(b.x)], 1u);
    return b;
}
__device__ __forceinline__ void xcd_barrier_complete(unsigned* bar, unsigned x, unsigned& nloc, unsigned& nx) {
    const unsigned G = gridDim.x * gridDim.y * gridDim.z;
    unsigned sum, cnt, mine, sp = 0u;
    for (;;) {
        sum = 0u; cnt = 0u; mine = 0u;
#pragma unroll
        for (unsigned j = 0; j < 16; ++j) { const unsigned c = xb_ld(&bar[XB_XCNT(j)]); sum += c; cnt += (c > 0u) ? 1u : 0u; mine = (j == x) ? c : mine; }
        if (sum == G) break;
        __builtin_amdgcn_s_sleep(1);
        if ((++sp & 255u) == 0u) { if (xb_ld(&bar[XB_TMO])) break; if (sp > XB_SPIN_CAP) { atomicAdd(&bar[XB_TMO], 1u); break; } }
    }
    nloc = mine > 0u ? mine : 1u; nx = cnt > 0u ? cnt : 1u;
}
__device__ __forceinline__ void xcd_barrier(const XcdBarrier& b) {
    asm volatile("s_waitcnt vmcnt(0)" ::: "memory");
    __syncthreads();
    if (b.wave == 0 && lane_now() == 0) {
        unsigned* bar = b.bar;
        __builtin_amdgcn_s_waitcnt(0);
        unsigned nloc = b.st[0], nx = b.st[1];
        if (nloc == 0u) { xcd_barrier_complete(bar, b.x, nloc, nx); b.st[0] = nloc; b.st[1] = nx; }
        const unsigned old = xb_add(&bar[XB_XSUB(b.x)], 1u);
        const unsigned gen = old / nloc;
        if (old == gen * nloc) asm volatile("buffer_wbl2 sc1" ::: "memory");
        if (old + 1u == (gen + 1u) * nloc) {
            __builtin_amdgcn_fence(__ATOMIC_RELEASE, "agent");
            asm volatile("s_waitcnt vmcnt(0)" ::: "memory");
            const unsigned og = xb_add(&bar[XB_TOP], 1u);
            const unsigned tg = og / nx;
            if (og + 1u == (tg + 1u) * nx) xb_add(&bar[XB_TOPGEN], 1u);
            else XB_SPIN(xb_ld(&bar[XB_TOPGEN]) == tg, bar);
            __builtin_amdgcn_fence(__ATOMIC_ACQUIRE, "agent");
            xb_add(&bar[XB_XGEN(b.x)], 1u);
            asm volatile("s_waitcnt vmcnt(0)" ::: "memory");
        } else {
            XB_SPIN(xb_ld(&bar[XB_XGEN(b.x)]) == gen, bar);
            __builtin_amdgcn_fence(__ATOMIC_ACQUIRE, "agent");
            asm volatile("s_waitcnt vmcnt(0)" ::: "memory");
        }
    }
    __syncthreads();
}

__device__ __forceinline__ float wave_sum(float v, int lane) {
#pragma unroll
    for (int o = 1; o < 64; o <<= 1) v += __builtin_bit_cast(float, __builtin_amdgcn_ds_bpermute((lane ^ o) << 2, __builtin_bit_cast(int, v)));
    return v;
}
__device__ __forceinline__ float logsig(float z) { return fminf(z, 0.f) - log1pf(__expf(-fabsf(z))); }
__device__ __forceinline__ void ld8f_nt(const float* p, float (&v)[8]) { const f32x4 a = __builtin_nontemporal_load((const f32x4*)p), b = __builtin_nontemporal_load((const f32x4*)(p + 4)); v[0] = a.x; v[1] = a.y; v[2] = a.z; v[3] = a.w; v[4] = b.x; v[5] = b.y; v[6] = b.z; v[7] = b.w; }
__device__ __forceinline__ void ld8f(const float* p, float (&v)[8]) { const f32x4 a = *(const f32x4*)p, b = *(const f32x4*)(p + 4); v[0] = a.x; v[1] = a.y; v[2] = a.z; v[3] = a.w; v[4] = b.x; v[5] = b.y; v[6] = b.z; v[7] = b.w; }
__device__ __forceinline__ void st8f(float* p, const float (&v)[8]) { *(f32x4*)p = (f32x4){v[0], v[1], v[2], v[3]}; *(f32x4*)(p + 4) = (f32x4){v[4], v[5], v[6], v[7]}; }
__device__ __forceinline__ void ld8bf(const bf16* p, float (&v)[8]) { const v4u w = *(const v4u*)p; v[0] = bflo(w.x); v[1] = bfhi(w.x); v[2] = bflo(w.y); v[3] = bfhi(w.y); v[4] = bflo(w.z); v[5] = bfhi(w.z); v[6] = bflo(w.w); v[7] = bfhi(w.w); }
__device__ __forceinline__ void st8bf(bf16* p, const float (&v)[8]) { v4u w; w.x = pk2(v[0], v[1]); w.y = pk2(v[2], v[3]); w.z = pk2(v[4], v[5]); w.w = pk2(v[6], v[7]); *(v4u*)p = w; }

__device__ __forceinline__ void transpose_item(const float* W, int ldw, int k0, int n0, bf16* WT, int Kd, int drow, int lo, LAS unsigned short* scr, int lane) {
    constexpr int KP = 72;
    const int nq = (lane & 15) * 4, kr = lane >> 4;
    f32x4 vv[16];
#pragma unroll
    for (int i = 0; i < 16; ++i) vv[i] = __builtin_nontemporal_load((const f32x4*)(W + (size_t)(k0 + 4 * i + kr) * ldw + n0 + nq));
#pragma unroll
    for (int i = 0; i < 16; ++i) { const int k = 4 * i + kr; f32x4 v = vv[i];
        if (lo) { v.x -= __builtin_bit_cast(float, f2bf(v.x) << 16); v.y -= __builtin_bit_cast(float, f2bf(v.y) << 16); v.z -= __builtin_bit_cast(float, f2bf(v.z) << 16); v.w -= __builtin_bit_cast(float, f2bf(v.w) << 16); }
        scr[(nq + 0) * KP + k] = (unsigned short)f2bf(v.x); scr[(nq + 1) * KP + k] = (unsigned short)f2bf(v.y); scr[(nq + 2) * KP + k] = (unsigned short)f2bf(v.z); scr[(nq + 3) * KP + k] = (unsigned short)f2bf(v.w); }
    LDS_WAIT(); asm volatile("" ::: "memory");
    const int c = lane & 7;
#pragma unroll
    for (int j = 0; j < 8; ++j) { const int n = (lane >> 3) + 8 * j; const v4u o = *(const LAS v4u*)(scr + n * KP + 8 * c);
        __builtin_nontemporal_store(o, (v4u*)(WT + (size_t)(drow + n) * Kd + k0 + 8 * c)); }
    LDS_WAIT(); asm volatile("" ::: "memory");
}
namespace fox {
constexpr int D = 128;
constexpr float THR = 8.f;
constexpr bool WSKIP = false;
constexpr float SCALE = 0.08838834764831845f;
constexpr int NW = 8, QBLK = 32, KVBLK = 64, QB = NW * QBLK;
constexpr int SHM_V = KVBLK * D * 2, SHM_K = KVBLK * D * 2;
constexpr int SHM_KA = KVBLK * 16;
constexpr int KA_OFF = 2 * SHM_V + 2 * SHM_K + NW * 64 * 4;
constexpr int LDS_BYTES = KA_OFF + 2 * SHM_KA;
constexpr int OSTR = 1024;
typedef unsigned short bf16;
typedef short bf16x8 __attribute__((ext_vector_type(8)));
typedef short s16x4 __attribute__((ext_vector_type(4)));
typedef float f32x16 __attribute__((ext_vector_type(16)));
typedef float f32x4 __attribute__((ext_vector_type(4)));
typedef unsigned u32x4 __attribute__((ext_vector_type(4)));
template <class A, class Bt> struct same_t { static constexpr bool v = false; };
template <class A> struct same_t<A, A> { static constexpr bool v = true; };
#define KSWZ(row, colB) ((row) * 256 + ((colB) ^ (((row) & 7) << 4)))
#define SBAR() __builtin_amdgcn_sched_barrier(0)
__device__ __forceinline__ int v_st(int k, int c) { const int kk = (k & ~0xC) | ((k & 4) << 1) | ((k & 8) >> 1); return ((kk >> 3) * 4 + (c >> 5)) * 512 + ((kk & 7) * 32 + (c & 31)) * 2; }
__device__ __forceinline__ int v_rd_base(int lane) { return ((lane & 3) << 3) | (((lane >> 2) & 3) << 6) | (((lane >> 4) & 1) << 5) | (((lane >> 5) & 1) << 8); }
constexpr int v_rd_off(int d0, int ks, int half) { return d0 * 512 + ks * 4096 + half * 2048; }
__device__ __forceinline__ int crow(int r, int hi) { return (r & 3) + 8 * (r >> 2) + 4 * hi; }
__device__ __forceinline__ unsigned cvtpk(float lo, float hi) {
    unsigned r; asm volatile("v_cvt_pk_bf16_f32 %0, %1, %2" : "=v"(r) : "v"(lo), "v"(hi)); return r;
}
__device__ __forceinline__ bf16x8 pack8(f32x4 a, f32x4 b) {
    u32x4 w = {cvtpk(a[0], a[1]), cvtpk(a[2], a[3]), cvtpk(b[0], b[1]), cvtpk(b[2], b[3])};
    return *reinterpret_cast<bf16x8*>(&w);
}
template <class T> __device__ __forceinline__ bf16x8 load8(const T* p) {
    if constexpr (same_t<T, float>::v) { return pack8(*(const f32x4*)p, *(const f32x4*)(p + 4)); }
    else { return *reinterpret_cast<const bf16x8*>(p); }
}
__device__ __forceinline__ void mask_tile(f32x16& p0, f32x16& p1, int dq, unsigned W) {
    const float NEG = -__builtin_inff();
#pragma unroll
    for (int r = 0; r < 16; ++r) {
        const int c = (r & 3) + 8 * (r >> 2);
        if ((unsigned)(dq - c) >= W) p0[r] = NEG;
        if ((unsigned)(dq - c - 32) >= W) p1[r] = NEG;
    }
}
__device__ __forceinline__ void partialSM(f32x16& p0, f32x16& p1, float& m_reg, float& mn, float& alpha) {
    float pmax = p0[0]; for (int r = 1; r < 16; ++r) pmax = fmaxf(pmax, p0[r]); for (int r = 0; r < 16; ++r) pmax = fmaxf(pmax, p1[r]);
    { unsigned pb_ = __float_as_uint(pmax); asm volatile("" : "+v"(pb_));
      auto rr = __builtin_amdgcn_permlane32_swap(__float_as_uint(pmax), pb_, false, false);
      pmax = fmaxf(__uint_as_float(rr[0]), __uint_as_float(rr[1])); }
    constexpr float C2 = 1.4426950408889634f * SCALE;
    if (__builtin_expect(__all((pmax - m_reg) * SCALE <= THR), 1)) { mn = m_reg; alpha = 1.f; }
    else { mn = fmaxf(m_reg, pmax); alpha = __builtin_amdgcn_exp2f((m_reg - mn) * C2); m_reg = mn; }
    const float mnL = -mn * C2;
    for (int r = 0; r < 16; ++r) p0[r] = fmaf(p0[r], C2, mnL); for (int r = 0; r < 16; ++r) p1[r] = fmaf(p1[r], C2, mnL);
    for (int r = 0; r < 16; ++r) p0[r] = __builtin_amdgcn_exp2f(p0[r]);
}
__device__ __forceinline__ void finishSM(f32x16& p0, f32x16& p1, float alpha, float& l_reg, bf16x8& pa0, bf16x8& pa1, bf16x8& pa2, bf16x8& pa3) {
    for (int r = 0; r < 16; ++r) p1[r] = __builtin_amdgcn_exp2f(p1[r]);
    float ps = 0; for (int r = 0; r < 16; ++r) ps += p0[r]; for (int r = 0; r < 16; ++r) ps += p1[r];
    { unsigned pb_ = __float_as_uint(ps); asm volatile("" : "+v"(pb_));
      auto rr = __builtin_amdgcn_permlane32_swap(__float_as_uint(ps), pb_, false, false);
      ps = __uint_as_float(rr[0]) + __uint_as_float(rr[1]); }
    l_reg = l_reg * alpha + ps;
#define PK4(P, B_, OUT) do { unsigned a0 = cvtpk(P[B_+0], P[B_+1]), a1 = cvtpk(P[B_+2], P[B_+3]);                          \
        unsigned b0 = cvtpk(P[B_+4], P[B_+5]), b1 = cvtpk(P[B_+6], P[B_+7]);                                             \
        auto r0 = __builtin_amdgcn_permlane32_swap(a0, b0, false, false); auto r1 = __builtin_amdgcn_permlane32_swap(a1, b1, false, false); \
        u32x4 w = {r0[0], r1[0], r0[1], r1[1]}; OUT = *reinterpret_cast<bf16x8*>(&w); } while (0)
    PK4(p0, 0, pa0); PK4(p0, 8, pa1); PK4(p1, 0, pa2); PK4(p1, 8, pa3);
#undef PK4
}
template <int KB, bool SK, bool BIAS = true>
__device__ __forceinline__ void qkt(f32x16& p0, f32x16& p1, const char* K_lds, int r32, int hi, const bf16x8* qr, bool act) {
    if (SK && !act) { const float NEG = -__builtin_inff();
#pragma unroll
        for (int r = 0; r < 16; ++r) { p0[r] = NEG; p1[r] = NEG; } return; }
    if constexpr (!BIAS) { p0 = f32x16{}; p1 = f32x16{}; } else
    {
        const char* ka = K_lds + (KA_OFF - 2 * SHM_V) + KB * SHM_KA; int hz = hi; asm volatile("" : "+v"(hz));
        const short one = hz ? (short)0 : (short)0x3F80;
        const bf16x8 qa = {one, one, one, 0, 0, 0, 0, 0};
        p0 = __builtin_amdgcn_mfma_f32_32x32x16_bf16(*reinterpret_cast<const bf16x8*>(ka + r32 * 16), qa, f32x16{}, 0, 0, 0);
        p1 = __builtin_amdgcn_mfma_f32_32x32x16_bf16(*reinterpret_cast<const bf16x8*>(ka + (32 + r32) * 16), qa, f32x16{}, 0, 0, 0); }
    const char* kb[4];
#pragma unroll
    for (int dd = 0; dd < 4; ++dd) kb[dd] = K_lds + KB * SHM_K + KSWZ(r32, (dd * 16 + hi * 8) * 2);
#pragma unroll
    for (int d0 = 0; d0 < 8; ++d0) { const char* a = kb[d0 & 3] + (d0 >> 2) * 128;
        bf16x8 b0 = *reinterpret_cast<const bf16x8*>(a);
        bf16x8 b1 = *reinterpret_cast<const bf16x8*>(a + 32 * 256);
        p0 = __builtin_amdgcn_mfma_f32_32x32x16_bf16(b0, qr[d0], p0, 0, 0, 0);
        p1 = __builtin_amdgcn_mfma_f32_32x32x16_bf16(b1, qr[d0], p1, 0, 0, 0); }

}
template <int VB, bool SK>
__device__ __forceinline__ void pv_tile(f32x16* o, int vb0, bf16x8 pa0, bf16x8 pa1, bf16x8 pa2, bf16x8 pa3, bool act) {
    if (SK && !act) return;
#define TRRD(dst, off) asm volatile("ds_read_b64_tr_b16 %0, %1 offset:%2" : "=&v"(dst) : "v"(vb0), "i"(off) : "memory")
#define PV_D0(d0) do { s16x4 l0, l1, l2, l3, h0, h1, h2, h3; constexpr int b_ = VB * SHM_V + v_rd_off(d0, 0, 0);     \
        TRRD(l0, b_); TRRD(h0, b_ + 2048); TRRD(l1, b_ + 4096); TRRD(h1, b_ + 6144); TRRD(l2, b_ + 8192); TRRD(h2, b_ + 10240); TRRD(l3, b_ + 12288); TRRD(h3, b_ + 14336); \
        asm volatile("s_waitcnt lgkmcnt(0)" ::: "memory"); SBAR();                 \
        o[d0] = __builtin_amdgcn_mfma_f32_32x32x16_bf16(pa0, (bf16x8){l0[0], l0[1], l0[2], l0[3], h0[0], h0[1], h0[2], h0[3]}, o[d0], 0, 0, 0);   \
        o[d0] = __builtin_amdgcn_mfma_f32_32x32x16_bf16(pa1, (bf16x8){l1[0], l1[1], l1[2], l1[3], h1[0], h1[1], h1[2], h1[3]}, o[d0], 0, 0, 0);   \
        o[d0] = __builtin_amdgcn_mfma_f32_32x32x16_bf16(pa2, (bf16x8){l2[0], l2[1], l2[2], l2[3], h2[0], h2[1], h2[2], h2[3]}, o[d0], 0, 0, 0);   \
        o[d0] = __builtin_amdgcn_mfma_f32_32x32x16_bf16(pa3, (bf16x8){l3[0], l3[1], l3[2], l3[3], h3[0], h3[1], h3[2], h3[3]}, o[d0], 0, 0, 0); } while (0)
    PV_D0(0); PV_D0(1); PV_D0(2); PV_D0(3);
#undef PV_D0
#undef TRRD
}

template <class TIn, class TOut> struct BlockRef { const TIn* Q; const TIn* K; const TIn* V; const TIn* KA; TOut* O; int P0; int JLO; };
template <class TIn> struct Seam {
    bf16x8 qr[8];
    bf16x8 st_v0, st_v1, st_k0, st_k1; f32x4 sf0, sf1, sf2, sf3;
    f32x4 tq[16];
};
__device__ __forceinline__ int swa_jlo(int P0, int W) { const int lowk = P0 - W + 1; return lowk > 0 ? lowk / KVBLK : 0; }
#define ROW(p, k0, rr) ((p) + (size_t)((k0) + (rr)) * D + sc)
#define VMW() asm volatile("s_waitcnt vmcnt(0)" ::: "memory")
#define VMWN(n) asm volatile("s_waitcnt vmcnt(%0)" :: "i"(n) : "memory")
#define SLOAD_H(Kp, Vp, KAp, k0, KABUF) do { S.st_v0 = load8<TIn>(ROW(Vp, k0, sr)); S.st_v1 = load8<TIn>(ROW(Vp, k0, 32 + sr));              \
                         S.st_k0 = load8<TIn>(ROW(Kp, k0, sr)); S.st_k1 = load8<TIn>(ROW(Kp, k0, 32 + sr));              \
                         if (wid == 0) __builtin_amdgcn_global_load_lds((const unsigned*)((KAp) + (size_t)((k0) + lane) * 8), (__attribute__((address_space(3))) unsigned*)(K_lds + (KA_OFF - 2 * SHM_V) + (KABUF) * SHM_KA), 16, 0, 0); } while (0)
#define SWRITE_HK(bf) do { *(bf16x8*)(K_lds + (bf) * SHM_K + kws) = S.st_k0; *(bf16x8*)(K_lds + (bf) * SHM_K + kws + 32 * 256) = S.st_k1; \
                        } while (0)
#define SWRITE_HV(bf) do { *(bf16x8*)(V_lds + (bf) * SHM_V + vst0) = S.st_v0; *(bf16x8*)(V_lds + (bf) * SHM_V + vst0 + 8192) = S.st_v1; } while (0)
#define SWRITE_H(bf) do { SWRITE_HV(bf); SWRITE_HK(bf); } while (0)
#define SLOAD_F(p, k0) do { S.sf0 = *(const f32x4*)ROW(p, k0, sr); S.sf1 = *(const f32x4*)(ROW(p, k0, sr) + 4);                \
                            S.sf2 = *(const f32x4*)ROW(p, k0, 32 + sr); S.sf3 = *(const f32x4*)(ROW(p, k0, 32 + sr) + 4); } while (0)
#define SWRITE_KF(bf) do { *(bf16x8*)(K_lds + (bf) * SHM_K + kws) = pack8(S.sf0, S.sf1); *(bf16x8*)(K_lds + (bf) * SHM_K + kws + 32 * 256) = pack8(S.sf2, S.sf3); } while (0)
#define SWRITE_VF(bf) do { *(bf16x8*)(V_lds + (bf) * SHM_V + vst0) = pack8(S.sf0, S.sf1); *(bf16x8*)(V_lds + (bf) * SHM_V + vst0 + 8192) = pack8(S.sf2, S.sf3); } while (0)
template <class TIn, class TOut>
__device__ __forceinline__ void causal_swa_prime(const BlockRef<TIn, TOut>& cur, int W, char* lds, Seam<TIn>& S, int wv) {
    constexpr bool F32 = same_t<TIn, float>::v;
    const int wid = wv, lane = lane_now(), tid = wid * 64 + lane, r32 = lane & 31, hi = lane >> 5;
    const int sr = tid >> 4, sc = (tid & 15) * 8, kws = KSWZ(sr, sc * 2); char* K_lds = lds + 2 * SHM_V;
    const int kb0 = cur.JLO * KVBLK; (void)W;
    for (int d0 = 0; d0 < 8; ++d0) S.qr[d0] = load8<TIn>(cur.Q + (size_t)(wid * QBLK + r32) * D + d0 * 16 + hi * 8);
    if constexpr (F32) { SLOAD_F((const float*)cur.K, kb0); VMW(); SWRITE_KF(0); SBAR(); SLOAD_F((const float*)cur.V, kb0); }
    else { SLOAD_H(cur.K, cur.V, cur.KA, kb0, 0); VMW(); SWRITE_HK(0); }
    __syncthreads();
}
template <class TIn, class TOut>
__device__ __forceinline__ void causal_swa_block(const BlockRef<TIn, TOut>& cur, const BlockRef<TIn, TOut>& nxt, int skv, int W, char* lds, Seam<TIn>& S, int wv) {
    constexpr bool F32 = same_t<TIn, float>::v;
    const int wid = wv, lane = lane_now(), tid = wid * 64 + lane, r32 = lane & 31, hi = lane >> 5;
    const int j_lo = cur.JLO;
    int j_hi = (cur.P0 + QB - 1) / KVBLK + 1; if (j_hi > skv / KVBLK) j_hi = skv / KVBLK;
    const int NT = j_hi - j_lo;
    const int kbn = nxt.JLO * KVBLK;
    const int qlo = cur.P0 + wid * QBLK, qm = qlo + r32 - 4 * hi;
    char* V_lds = lds; char* K_lds = lds + 2 * SHM_V;
    float* ws = (float*)(lds + 2 * SHM_V + 2 * SHM_K) + wid * 64; float* li_l = ws, * al_l = ws + 32;
    float m_reg = -1e30f, l_reg = 0; f32x16 o[4] = {};
    const int sr = tid >> 4, sc = (tid & 15) * 8, vst0 = v_st(sr, sc)  , kws = KSWZ(sr, sc * 2);
    const int vb0 = (int)(uintptr_t)V_lds + v_rd_base(lane);
    const TIn* Kh = cur.K; const TIn* Vh = cur.V; const TIn* KAh = cur.KA;
#define RESC(a) do { if (__any((a) < 1.f)) { if (hi == 0) al_l[r32] = (a); asm volatile("s_waitcnt lgkmcnt(0)" ::: "memory");              \
                     for (int d_ = 0; d_ < 4; ++d_) for (int r = 0; r < 16; ++r) o[d_][r] *= al_l[crow(r, hi)]; } } while (0)
#define KBASE(t) ((j_lo + (t)) * KVBLK)
#define ACT(t) (KBASE(t) <= qlo + QBLK - 1 && KBASE(t) + KVBLK - 1 >= qlo - W + 1)
#define MASKT(P0_, P1_, t) do { const int kb_ = KBASE(t); if ((!SK || ACT(t)) && (kb_ + KVBLK - 1 > qlo || kb_ <= qlo + QBLK - 1 - W)) mask_tile(P0_, P1_, qm - kb_, (unsigned)W); } while (0)
    constexpr int NQL = F32 ? 16 : 8;
    constexpr bool SK = WSKIP && !F32;
#define SEAM_K0() do { VMWN(NQL); if constexpr (F32) { SWRITE_KF(0); SBAR(); SLOAD_F((const float*)nxt.V, kbn); } else { SWRITE_HK(0); } SBAR(); } while (0)
    f32x16 pA0, pA1, pB0, pB1; float mnA, mnB, alA, alB; bf16x8 pa0, pa1, pa2, pa3;
    if constexpr (F32) { VMW(); SWRITE_VF(0); SBAR(); } else { SWRITE_HV(0); SBAR(); }
    if (NT > 1) { if constexpr (F32) SLOAD_F((const float*)Kh, KBASE(1)); else SLOAD_H(Kh, Vh, KAh, KBASE(1), 1); }
    SBAR(); qkt<0, SK>(pA0, pA1, K_lds, r32, hi, S.qr, ACT(0));
    if constexpr (F32) { if (NT > 1) { VMW(); SWRITE_KF(1); SBAR(); SLOAD_F((const float*)Vh, KBASE(1)); } }
    MASKT(pA0, pA1, 0); partialSM(pA0, pA1, m_reg, mnA, alA);
    if (NT > 1) { VMW(); if constexpr (F32) { SWRITE_VF(1); SBAR(); if (NT > 2) SLOAD_F((const float*)Kh, KBASE(2)); } else SWRITE_H(1); }
    __syncthreads();
#define HALF_STEP(PX0, PX1, mnX, alX, PY0, PY1, alY, t, KB, VB, SB) do {                                                      \
        SBAR(); qkt<KB, SK>(PX0, PX1, K_lds, r32, hi, S.qr, ACT(t));                                             \
        finishSM(PY0, PY1, alY, l_reg, pa0, pa1, pa2, pa3); SBAR();                                                           \
        if ((t) + 1 < NT) { if constexpr (F32) { VMW(); SWRITE_KF(SB); SBAR(); SLOAD_F((const float*)Vh, KBASE((t) + 1)); }  \
                            else { SLOAD_H(Kh, Vh, KAh, KBASE((t) + 1), SB); } SBAR(); }                                               \
        pv_tile<VB, SK>(o, vb0, pa0, pa1, pa2, pa3, ACT((t) - 1)); MASKT(PX0, PX1, (t)); partialSM(PX0, PX1, m_reg, mnX, alX);                                        \
        __syncthreads();                                                                                                      \
        if ((t) + 1 < NT) { VMW(); if constexpr (F32) { SWRITE_VF(SB); SBAR(); if ((t) + 2 < NT) SLOAD_F((const float*)Kh, KBASE((t) + 2)); } \
                            else { SWRITE_H(SB); } }                                                                          \
        RESC(alX); __syncthreads(); } while (0)
    for (int t = 1; t + 1 < NT; t += 2) {
        HALF_STEP(pB0, pB1, mnB, alB, pA0, pA1, alA, t, 1, 0, 0);
        HALF_STEP(pA0, pA1, mnA, alA, pB0, pB1, alB, t + 1, 0, 1, 1);
    }
    const bool even = (NT & 1) == 0;
    if (even) { SBAR(); qkt<1, SK>(pB0, pB1, K_lds, r32, hi, S.qr, ACT(NT - 1)); SBAR(); }
#define QROW(e) (nxt.Q + (size_t)(wid * QBLK + r32) * D + ((e) >> 1) * 16 + hi * 8 + ((e) & 1) * 4)
    if constexpr (F32) { SLOAD_F((const float*)nxt.K, kbn); SBAR();
#pragma unroll
        for (int e = 0; e < 8; ++e) S.tq[e] = *(const f32x4*)QROW(e); }
    else { SLOAD_H(nxt.K, nxt.V, nxt.KA, kbn, 0); SBAR();
#pragma unroll
        for (int d0 = 0; d0 < 8; ++d0) S.qr[d0] = load8<TIn>(nxt.Q + (size_t)(wid * QBLK + r32) * D + d0 * 16 + hi * 8); }
    SBAR();
    finishSM(pA0, pA1, alA, l_reg, pa0, pa1, pa2, pa3); SBAR();
    if constexpr (F32) {
#pragma unroll
        for (int e = 8; e < 16; ++e) S.tq[e] = *(const f32x4*)QROW(e); SBAR(); }
#undef QROW
    pv_tile<0, SK>(o, vb0, pa0, pa1, pa2, pa3, ACT(even ? NT - 2 : NT - 1));
    if (even) { MASKT(pB0, pB1, NT - 1); partialSM(pB0, pB1, m_reg, mnB, alB); __syncthreads(); RESC(alB);
        finishSM(pB0, pB1, alB, l_reg, pa0, pa1, pa2, pa3); SBAR(); pv_tile<1, SK>(o, vb0, pa0, pa1, pa2, pa3, ACT(NT - 1)); }
    SBAR(); SEAM_K0();
    if (hi == 0) li_l[r32] = l_reg; asm volatile("s_waitcnt lgkmcnt(0)" ::: "memory");
    float rli[16];
#pragma unroll
    for (int r = 0; r < 16; ++r) rli[r] = __builtin_amdgcn_rcpf(li_l[crow(r, hi)]);
    TOut* Ow = cur.O + (size_t)(wid * QBLK) * OSTR;
#pragma unroll
    for (int r = 0; r < 16; ++r) { const int orow = crow(r, hi);
#pragma unroll
        for (int d0 = 0; d0 < 4; ++d0) { const float v = o[d0][r] * rli[r];
            if constexpr (same_t<TOut, float>::v) { Ow[(size_t)orow * OSTR + d0 * 32 + r32] = v; }
            else { const float vn = __builtin_bit_cast(float, __builtin_amdgcn_ds_bpermute((lane ^ 1) << 2, __builtin_bit_cast(int, v)));
                   if ((r32 & 1) == 0) *(unsigned*)(Ow + (size_t)orow * OSTR + d0 * 32 + r32) = cvtpk(v, vn); } } }
    if constexpr (F32) {
#pragma unroll
        for (int d0 = 0; d0 < 8; ++d0) S.qr[d0] = pack8(S.tq[2 * d0], S.tq[2 * d0 + 1]); }
    __syncthreads();
#undef RESC
#undef KBASE
#undef ACT
#undef MASKT
#undef SEAM_K0
#undef HALF_STEP
}
#undef ROW
#undef VMW
#undef VMWN
#undef SLOAD_H
#undef SWRITE_HK
#undef SWRITE_HV
#undef SWRITE_H
#undef SLOAD_F
#undef SWRITE_KF
#undef SWRITE_VF

typedef BlockRef<bf16, bf16> BR;
__device__ __forceinline__ float fox_gmax(const bf16* Q, const bf16* K, const float* F, const unsigned* nrm, int item, char* lds, int wv) {
    const int qb = 63 - (item >> 4), bh = item & 15; const size_t hb = (size_t)bh * 16384; const int P0 = qb * QB;
    const int lane = lane_now(), row = wv * 32 + (lane & 31), hi = lane >> 5;
    const bf16* qp = Q + (hb + P0 + row) * D + hi * 64; const bf16* kp = K + (hb + P0 + row) * D + hi * 64;
    float acc = 0.f, qq = 0.f;
#pragma unroll
    for (int c = 0; c < 8; ++c) { const u32x4 a = *(const u32x4*)(qp + 8 * c), b = *(const u32x4*)(kp + 8 * c);
#pragma unroll
        for (int q = 0; q < 4; ++q) { const unsigned x = q == 0 ? a.x : q == 1 ? a.y : q == 2 ? a.z : a.w, y = q == 0 ? b.x : q == 1 ? b.y : q == 2 ? b.z : b.w;
            const float xl = __builtin_bit_cast(float, x << 16), xh = __builtin_bit_cast(float, x & 0xffff0000u);
            acc += xl * __builtin_bit_cast(float, y << 16) + xh * __builtin_bit_cast(float, y & 0xffff0000u); qq += xl * xl + xh * xh; } }
    acc += __builtin_bit_cast(float, __builtin_amdgcn_ds_bpermute((lane ^ 32) << 2, __builtin_bit_cast(int, acc)));
    qq += __builtin_bit_cast(float, __builtin_amdgcn_ds_bpermute((lane ^ 32) << 2, __builtin_bit_cast(int, qq)));
    const float km = sqrtf(__builtin_bit_cast(float, nrm[bh]));
    float g = F[hb + P0 + row] + (1.001f * sqrtf(qq) * km - acc) * SCALE;
#pragma unroll
    for (int o = 1; o < 32; o <<= 1) g = fmaxf(g, __builtin_bit_cast(float, __builtin_amdgcn_ds_bpermute((lane ^ o) << 2, __builtin_bit_cast(int, g))));
    volatile float* gm = (volatile float*)(lds + KA_OFF + 2 * SHM_KA + 16);
    if (lane == 0) gm[wv] = g;
    __syncthreads();
    float r = gm[0];
#pragma unroll
    for (int w = 1; w < NW; ++w) r = fmaxf(r, gm[w]);
    __syncthreads();
    return r;
}
__device__ __forceinline__ BR fox_ref(const bf16* Q, const bf16* K, const bf16* V, const bf16* KA, bf16* O, const float* F, const unsigned* nrm, int item, int lane, float gmax) {
    const int qb = 63 - (item >> 4), bh = item & 15;
    BR r; const size_t hb = (size_t)bh * 16384;
    r.Q = Q + (hb + (size_t)qb * QB) * D; r.K = K + hb * D; r.V = V + hb * D; r.KA = KA + hb * 8;
    r.O = O + ((size_t)(bh >> 3) * 16384 + (size_t)qb * QB) * OSTR + (bh & 7) * D; r.P0 = qb * QB;
    const float* Fh = F + hb;
    const int jmax = 4 * qb; float fe[4];
#pragma unroll
    for (int i = 0; i < 4; ++i) { const int j = 4 * lane + i; fe[i] = Fh[(j < jmax ? j : jmax) * KVBLK + 63]; }
    const float thr = gmax + 88.05f;
    int first = 4;
#pragma unroll
    for (int i = 3; i >= 0; --i) if (4 * lane + i <= jmax && fe[i] <= thr) first = i;
    const unsigned long long bal = __ballot(first < 4); const int l1 = __builtin_amdgcn_readfirstlane((int)__builtin_ctzll(bal));
    r.JLO = 4 * l1 + __builtin_amdgcn_readlane(first, l1);
    return r;
}
__device__ __forceinline__ void fox_phase(const bf16* Q, const bf16* K, const bf16* V, const bf16* KA, bf16* O, const float* F, unsigned* ctlq  , char* lds, int wv) {
    constexpr int TOTAL = 1024, SKV = 16384, W = 16384;
    volatile int* slot = (volatile int*)(lds + KA_OFF + 2 * SHM_KA);
    const unsigned* nrm = ctlq + 16;
    int lane = lane_now();
    if (wv == 0 && lane == 0) { slot[0] = (int)atomicAdd(ctlq, 1u); slot[1] = (int)atomicAdd(ctlq, 1u); }
    __syncthreads();
    int icur = __builtin_amdgcn_readfirstlane(slot[0]), inxt = __builtin_amdgcn_readfirstlane(slot[1]);
    __syncthreads();
    if (icur >= TOTAL) return;
    BR cur = fox_ref(Q, K, V, KA, O, F, nrm, icur, lane, fox_gmax(Q, K, F, nrm, icur, lds, wv));
    BR nxt = cur; if (inxt < TOTAL) nxt = fox_ref(Q, K, V, KA, O, F, nrm, inxt, lane, fox_gmax(Q, K, F, nrm, inxt, lds, wv));
    Seam<bf16> S;
    causal_swa_prime<bf16, bf16>(cur, W, lds, S, wv);
    for (;;) {
        const bool last = inxt >= TOTAL;
        if (!last && wv == 0 && lane_now() == 0) slot[2] = (int)atomicAdd(ctlq, 1u);
        causal_swa_block<bf16, bf16>(cur, nxt, SKV, W, lds, S, wv);
        if (last) break;
        const int inn = __builtin_amdgcn_readfirstlane(slot[2]);
        cur = nxt; icur = inxt; inxt = inn; lane = lane_now();
        if (inxt < TOTAL) nxt = fox_ref(Q, K, V, KA, O, F, nrm, inxt, lane, fox_gmax(Q, K, F, nrm, inxt, lds, wv)); else nxt = cur;
        __syncthreads();
    }
}
template <bool MASK>
__device__ __forceinline__ float sb_half(f32x16& p, int kb, int trow, int hi, int pidx, float cin) {
    constexpr float C = SCALE * 1.4426950408889634f;
    float m[16];
#pragma unroll
    for (int r = 0; r < 16; ++r) { const int key = kb + crow(r, hi);
        const float e = __builtin_amdgcn_exp2f(fminf(p[r] * C, 115.f)); const float om = __builtin_amdgcn_rcpf(1.f + e); const bool v = !MASK || key < trow; m[r] = v ? om : 1.f; p[r] = v ? e * om : 0.f; }
    float later[4]; float sp = 1.f;
#pragma unroll
    for (int q = 3; q >= 0; --q) { const float gs = (m[4 * q] * m[4 * q + 1]) * (m[4 * q + 2] * m[4 * q + 3]);
        const float gp = __builtin_bit_cast(float, __builtin_amdgcn_ds_bpermute(pidx, __builtin_bit_cast(int, gs)));
        const float g_lo = hi ? gp : gs, g_hi = hi ? gs : gp;
        later[q] = hi ? sp : sp * g_hi; sp *= g_lo * g_hi; }
#pragma unroll
    for (int q = 0; q < 4; ++q) { float gx = cin * later[q];
#pragma unroll
        for (int i = 3; i >= 0; --i) { const int r = 4 * q + i; p[r] *= gx; gx *= m[r]; } }
    return sp;
}
template <bool MASK>
__device__ __forceinline__ void sb_weights(f32x16& p0, f32x16& p1, int kb, int trow, int hi, int pidx, float& carry) {
    const float s1 = sb_half<MASK>(p1, kb + 32, trow, hi, pidx, carry);
    const float c1 = carry * s1;
    const float s0 = sb_half<MASK>(p0, kb, trow, hi, pidx, c1);
    carry = c1 * s0;
}
__device__ __forceinline__ void sb_pack(const f32x16& p0, const f32x16& p1, bf16x8& pa0, bf16x8& pa1, bf16x8& pa2, bf16x8& pa3) {
#define PK4(P, B_, OUT) do { unsigned a0 = cvtpk(P[B_+0], P[B_+1]), a1 = cvtpk(P[B_+2], P[B_+3]);                          \
        unsigned b0 = cvtpk(P[B_+4], P[B_+5]), b1 = cvtpk(P[B_+6], P[B_+7]);                                             \
        auto r0 = __builtin_amdgcn_permlane32_swap(a0, b0, false, false); auto r1 = __builtin_amdgcn_permlane32_swap(a1, b1, false, false); \
        u32x4 w = {r0[0], r1[0], r0[1], r1[1]}; OUT = *reinterpret_cast<bf16x8*>(&w); } while (0)
    PK4(p0, 0, pa0); PK4(p0, 8, pa1); PK4(p1, 0, pa2); PK4(p1, 8, pa3);
#undef PK4
}
__device__ __forceinline__ void sb_phase(const bf16* Q, const bf16* K, const bf16* V, bf16* O, char* lds, int G, int c, int wv) {
    const int wid = wv;
    char* V_lds = lds; char* K_lds = lds + 2 * SHM_V;
    volatile int* flags = (volatile int*)(lds + 2 * SHM_V + 2 * SHM_K);
    for (int it = c; it < 1024; it += G) {
        const int lane = lane_now(), tid = wid * 64 + lane, r32 = lane & 31, hi = lane >> 5;
        const int sr = tid >> 4, sc = (tid & 15) * 8, vst0 = v_st(sr, sc), kws = KSWZ(sr, sc * 2);
        const int vb0 = (int)(uintptr_t)V_lds + v_rd_base(lane);
        const int bh = it >> 6, qb = it & 63; const size_t hb = (size_t)bh * 16384;
        const bf16* Kh = K + hb * D; const bf16* Vh = V + hb * D; const bf16* Qb = Q + (hb + (size_t)qb * QB) * D;
        const int P0 = qb * QB, qlo = P0 + wid * QBLK, trow = qlo + r32;
        bf16x8 qr[8];
#pragma unroll
        for (int d0 = 0; d0 < 8; ++d0) qr[d0] = *reinterpret_cast<const bf16x8*>(Qb + (size_t)(wid * QBLK + r32) * D + d0 * 16 + hi * 8);
        f32x16 o[4] = {}; float carry = 1.f; int wdone = 0;
        int j = P0 / KVBLK + 3;
        bf16x8 ak0, ak1, av0, av1, bk0, bk1, bv0, bv1;
#define SB_LOAD(K0_, K1_, V0_, V1_, jj) do { const int jc_ = (jj) > 0 ? (jj) : 0; const size_t k0_ = (size_t)jc_ * KVBLK; V0_ = *reinterpret_cast<const bf16x8*>(Vh + (k0_ + sr) * D + sc); V1_ = *reinterpret_cast<const bf16x8*>(Vh + (k0_ + 32 + sr) * D + sc); \
                         K0_ = *reinterpret_cast<const bf16x8*>(Kh + (k0_ + sr) * D + sc); K1_ = *reinterpret_cast<const bf16x8*>(Kh + (k0_ + 32 + sr) * D + sc); } while (0)
#define SB_STAGE(K0_, K1_, V0_, V1_) { \
            *(bf16x8*)(V_lds + vst0) = V0_; *(bf16x8*)(V_lds + vst0 + 8192) = V1_; *(bf16x8*)(K_lds + kws) = K0_; *(bf16x8*)(K_lds + kws + 32 * 256) = K1_; \
            __syncthreads(); \
            SB_LOAD(K0_, K1_, V0_, V1_, j - 2);                                  \
            const int kb = j * KVBLK; \
            if (!wdone && kb < qlo + QBLK - 1) { \
                f32x16 p0, p1; bf16x8 pa0, pa1, pa2, pa3; \
                qkt<0, false, false>(p0, p1, K_lds, r32, hi, qr, true); \
                if (kb + KVBLK - 1 >= qlo) sb_weights<true>(p0, p1, kb, trow, hi, (lane ^ 32) << 2, carry); \
                else sb_weights<false>(p0, p1, kb, trow, hi, (lane ^ 32) << 2, carry); \
                sb_pack(p0, p1, pa0, pa1, pa2, pa3); \
                pv_tile<0, false>(o, vb0, pa0, pa1, pa2, pa3, true); \
                wdone = __all(carry < 1.17549435e-38f) ? 1 : 0; \
            } \
            if (lane == 0) flags[wid] = wdone; \
            __syncthreads(); \
            int all = 1; \
            _Pragma("unroll") for (int w = 0; w < NW; ++w) all &= flags[w]; \
            if (all || j == 0) break; \
            --j; }
        SB_LOAD(ak0, ak1, av0, av1, j); SB_LOAD(bk0, bk1, bv0, bv1, j - 1);
        for (;;) {
            SB_STAGE(ak0, ak1, av0, av1)
            SB_STAGE(bk0, bk1, bv0, bv1)
        }
#undef SB_STAGE
#undef SB_LOAD
        bf16* Ow = O + ((size_t)(bh >> 3) * 16384 + (size_t)qb * QB + wid * QBLK) * OSTR + (bh & 7) * D;
        const int lz = lane_now(), hz = lz >> 5;
#pragma unroll
        for (int r = 0; r < 16; ++r) { const int orow = crow(r, hz);
#pragma unroll
            for (int d0 = 0; d0 < 4; ++d0) { const float v = o[d0][r];
                const float vn = __builtin_bit_cast(float, __builtin_amdgcn_ds_bpermute((lz ^ 1) << 2, __builtin_bit_cast(int, v)));
                if ((lz & 1) == 0) *(unsigned*)(Ow + (size_t)orow * OSTR + d0 * 32 + (lz & 31)) = cvtpk(v, vn); } }
        __syncthreads();
    }
}
}
struct Args { const float* in[21]; float* out; unsigned char* ws; int ph_lo, ph_hi; };
enum { I_X = 0, I_C, I_FOX_WIN, I_FOX_BF, I_FOX_WO, I_SB_WIN, I_SB_WO, I_ADA_W, I_ADA_B, I_LNA_G, I_LNA_B, I_RW, I_RB, I_EG, I_EU, I_ED, I_SG, I_SU, I_SD, I_LNF_G, I_LNF_B };

__device__ __forceinline__ void convert_attn_weights(const Args& A, LAS unsigned char* lds, int gw, int NGW, int wave, int lane) {
    asm volatile("" : "+v"(lane));
    LAS unsigned short* scr = (LAS unsigned short*)(lds + RING_OFF + wave * 16384);
    constexpr int nQ = 16 * 48, nO = 16 * 16, nR = 32, nZ = 128, PER = nQ + nO + nR + nZ;
    for (int it = gw; it < 2 * PER; it += NGW) {
        const int l = it / PER; int r = it % PER;
        bf16* WQKV = (bf16*)(A.ws + WS_WATT + (size_t)l * WATT_STRIDE); bf16* WO = (bf16*)(A.ws + WS_WATT + (size_t)l * WATT_STRIDE + WATT_O); bf16* WR = (bf16*)(A.ws + WS_WATT + (size_t)l * WATT_STRIDE + WATT_R);
        if (r < nQ) { const int kb = r / 48, nb = r % 48; transpose_item(l == 0 ? A.in[I_FOX_WIN] : A.in[I_SB_WIN], l == 0 ? 3080 : 3072, 64 * kb, 64 * nb, WQKV, 1024, 64 * nb, 0, scr, lane); continue; } r -= nQ;
        if (r < nO) { const int kb = r / 16, nb = r % 16; transpose_item(l == 0 ? A.in[I_FOX_WO] : A.in[I_SB_WO], 1024, 64 * kb, 64 * nb, WO, 1024, 64 * nb, 0, scr, lane); continue; } r -= nO;
        if (r < nR) { const int kb = r >> 1, lo = r & 1; transpose_item(A.in[I_RW] + (size_t)l * 1024 * 64, 64, 64 * kb, 0, WR, 1024, lo ? 128 : 0, lo, scr, lane); continue; } r -= nR;
        { const int row = r < 64 ? 64 + r : 192 + (r - 64); unsigned zz = 0u; asm volatile("" : "+v"(zz)); v4u z = {zz, zz, zz, zz}; v4u* p = (v4u*)(WR + (size_t)row * 1024) + lane; p[0] = z; p[64] = z; }
    }
}
constexpr int CONV_PER_LAYER = 65 * 128 + 65 * 64, CONV_TOTAL = 2 * CONV_PER_LAYER;
__device__ __forceinline__ void convert_moe_item(const float* eg, const float* eu, const float* ed, const float* sg, const float* su, const float* sd, unsigned char* ws, int item, LAS unsigned short* scr, int lane) {
    const int l = item / CONV_PER_LAYER; int r = item % CONV_PER_LAYER;
    bf16* WGU = (bf16*)(ws + (l == 0 ? WS_WMOE0 : WS_WMOE1)); bf16* WD = (bf16*)(ws + (l == 0 ? WS_WMOE0 : WS_WMOE1) + WMOE_D);
    if (r < 65 * 128) { const int e = r / 128, r2 = r % 128, which = r2 / 64, r3 = r2 % 64, kb = r3 / 4, nb = r3 % 4, n0 = 64 * nb;
        const float* src;
        if (e < 64) { src = which ? eu : eg; src += (size_t)(l * 64 + e) * 1024 * 256; } else { src = which ? su : sg; src += (size_t)l * 1024 * 256; }
        transpose_item(src, 256, 64 * kb, n0, WGU, 1024, e * 512 + (n0 >> 7) * 256 + which * 128 + (n0 & 127), 0, scr, lane); return; }
    r -= 65 * 128;
    { const int e = r / 64, r2 = r % 64, kb = r2 / 16, nb = r2 % 16;
      const float* src;
      if (e < 64) src = ed + (size_t)(l * 64 + e) * 256 * 1024; else src = sd + (size_t)l * 256 * 1024;
      transpose_item(src, 1024, 64 * kb, 64 * nb, WD, 256, e * 1024 + 64 * nb, 0, scr, lane); }
}
__device__ __forceinline__ void convert_moe_drain(const float* eg, const float* eu, const float* ed, const float* sg, const float* su, const float* sd, unsigned char* ws, LAS unsigned char* lds, int wave) {
    asm volatile("" : "+s"(eg), "+s"(eu), "+s"(ed), "+s"(sg), "+s"(su), "+s"(sd));
    unsigned* q = (unsigned*)(ws + WS_CTL) + CW_CONVQ;
    LAS unsigned short* scr = (LAS unsigned short*)(lds + RING_OFF + wave * 16384);
    for (;;) {
        const int lane = lane_now(); int base = 0;
        if (lane == 0) base = (int)atomicAdd(q, 2u);
        base = __builtin_amdgcn_readfirstlane(base);
        if (base >= CONV_TOTAL) break;
        for (int i = 0; i < 2; ++i) if (base + i < CONV_TOTAL) convert_moe_item(eg, eu, ed, sg, su, sd, ws, base + i, scr, lane);
    }
}

__device__ __forceinline__ void input_pass(const Args& A, LAS unsigned char* lds, int gw, int NGW, int tid, int lane) {
    asm volatile("" : "+v"(tid), "+v"(lane));
    LAS float* Wf = (LAS float*)lds;
    const float* win = A.in[I_FOX_WIN];
    for (int i = tid; i < 8192; i += 512) { const int k = i >> 3, q = i & 7; Wf[q * 1024 + k] = win[(size_t)k * 3080 + 3072 + q]; }
    __syncthreads();
    const float* x = A.in[I_X]; const float* MOD = (const float*)(A.ws + WS_MOD); bf16* H = (bf16*)(A.ws + WS_H); float* LOGF = (float*)(A.ws + WS_LOGF);
    const float bfv = A.in[I_FOX_BF][(lane >> 3) & 7];
    double* BSUM = (double*)(A.ws + WS_BSUM);
    for (int rb = gw; rb < NTOK / 16; rb += NGW) {
        const int b = (rb * 16) >> 14; const float* modb = MOD + (size_t)(0 * 2 + b) * 6144;
        float sc[16], sh[16];
        double bs = 0.0;
#pragma unroll
        for (int j = 0; j < 2; ++j) { float a[8], c[8]; ld8f(modb + 1024 + 512 * j + 8 * lane, a); ld8f(modb + 512 * j + 8 * lane, c);
#pragma unroll
            for (int e = 0; e < 8; ++e) { sc[8 * j + e] = 1.f + a[e]; sh[8 * j + e] = c[e]; } }
        f32x4 xc[4], xn[4];
#pragma unroll
        for (int q = 0; q < 4; ++q) xc[q] = *(const f32x4*)(x + (size_t)(rb * 16) * 1024 + 512 * (q >> 1) + 8 * lane + 4 * (q & 1));
        for (int r = 0; r < 16; ++r) {
            const int t = rb * 16 + r; float h[16];
            { const int tn = rb * 16 + (r < 15 ? r + 1 : r);
#pragma unroll
              for (int q = 0; q < 4; ++q) xn[q] = *(const f32x4*)(x + (size_t)tn * 1024 + 512 * (q >> 1) + 8 * lane + 4 * (q & 1)); }
            __builtin_amdgcn_sched_barrier(0);
#pragma unroll
            for (int j = 0; j < 2; ++j) { float a[8]; a[0] = xc[2 * j].x; a[1] = xc[2 * j].y; a[2] = xc[2 * j].z; a[3] = xc[2 * j].w; a[4] = xc[2 * j + 1].x; a[5] = xc[2 * j + 1].y; a[6] = xc[2 * j + 1].z; a[7] = xc[2 * j + 1].w; float o[8];
#pragma unroll
                for (int e = 0; e < 8; ++e) { h[8 * j + e] = a[e] * sc[8 * j + e] + sh[8 * j + e]; o[e] = h[8 * j + e]; }
                st8bf(H + (size_t)t * 1024 + 512 * j + 8 * lane, o); }
            float fl[8];
#pragma unroll
            for (int q = 0; q < 8; ++q) { float s = 0.f;
#pragma unroll
                for (int j = 0; j < 2; ++j) { const LAS float* wp = Wf + q * 1024 + 512 * j + 8 * lane; const f32x4 w0 = *(const LAS f32x4*)wp, w1 = *(const LAS f32x4*)(wp + 4);
                    s += h[8 * j + 0] * w0.x + h[8 * j + 1] * w0.y + h[8 * j + 2] * w0.z + h[8 * j + 3] * w0.w + h[8 * j + 4] * w1.x + h[8 * j + 5] * w1.y + h[8 * j + 6] * w1.z + h[8 * j + 7] * w1.w; }
                fl[q] = s; }
            float mine;
            { const bool b5 = (lane & 32) != 0, b4 = (lane & 16) != 0, b3 = (lane & 8) != 0; float t4[4], t2[2];
#pragma unroll
              for (int i = 0; i < 4; ++i) { const float keep = b5 ? fl[4 + i] : fl[i], give = b5 ? fl[i] : fl[4 + i]; t4[i] = keep + __builtin_bit_cast(float, __builtin_amdgcn_ds_bpermute((lane ^ 32) << 2, __builtin_bit_cast(int, give))); }
#pragma unroll
              for (int i = 0; i < 2; ++i) { const float keep = b4 ? t4[2 + i] : t4[i], give = b4 ? t4[i] : t4[2 + i]; t2[i] = keep + __builtin_bit_cast(float, __builtin_amdgcn_ds_bpermute((lane ^ 16) << 2, __builtin_bit_cast(int, give))); }
              { const float keep = b3 ? t2[1] : t2[0], give = b3 ? t2[0] : t2[1]; mine = keep + __builtin_bit_cast(float, __builtin_amdgcn_ds_bpermute((lane ^ 8) << 2, __builtin_bit_cast(int, give))); }
#pragma unroll
              for (int o = 4; o > 0; o >>= 1) mine += __builtin_bit_cast(float, __builtin_amdgcn_ds_bpermute((lane ^ o) << 2, __builtin_bit_cast(int, mine))); }
            { const float lf = logsig(mine + bfv); bs += (double)lf; if ((lane & 7) == 0) LOGF[(size_t)t * 8 + (lane >> 3)] = lf; }
#pragma unroll
            for (int q = 0; q < 4; ++q) xc[q] = xn[q];
        }
        if ((lane & 7) == 0) BSUM[(size_t)rb * 8 + (lane >> 3)] = bs;
    }
    __syncthreads();
}

__device__ __forceinline__ double shfl_d(double v, int idx4) { const unsigned long long u = __builtin_bit_cast(unsigned long long, v);
    const unsigned lo = (unsigned)__builtin_amdgcn_ds_bpermute(idx4, (int)(unsigned)u), hi = (unsigned)__builtin_amdgcn_ds_bpermute(idx4, (int)(unsigned)(u >> 32));
    return __builtin_bit_cast(double, ((unsigned long long)hi << 32) | lo); }
__device__ __forceinline__ void fox_scan_seg(const Args& A, LAS unsigned char* lds, int task, int tid, int lane, int wave) {
    asm volatile("" : "+v"(tid), "+v"(lane));
    const float* LOGF = (const float*)(A.ws + WS_LOGF); float* F = (float*)(A.ws + WS_F); bf16* KAUG = (bf16*)(A.ws + WS_KAUG); const double* BSUM = (const double*)(A.ws + WS_BSUM);
    LAS double* red = (LAS double*)lds;
    const int bh = task >> 4, seg = task & 15, b = bh >> 3, h = bh & 7;
    double p = 0.0;
    for (int blk = tid; blk < seg * 64; blk += 512) p += BSUM[((size_t)b * 1024 + blk) * 8 + h];
#pragma unroll
    for (int o = 1; o < 64; o <<= 1) p += shfl_d(p, (lane ^ o) << 2);
    const int s0 = seg * 1024 + 2 * tid;
    const float a0 = LOGF[((size_t)b * SEQ + s0) * 8 + h], a1 = LOGF[((size_t)b * SEQ + s0 + 1) * 8 + h];
    const double loc = (double)a0 + (double)a1; double inc = loc;
#pragma unroll
    for (int o = 1; o < 64; o <<= 1) { const double up = shfl_d(inc, ((lane - o) & 63) << 2); if (lane >= o) inc += up; }
    if (lane == 63) red[8 + wave] = inc;
    if (lane == 0) red[wave] = p;
    __syncthreads();
    double run = 0.0;
#pragma unroll
    for (int w = 0; w < 8; ++w) run += red[w];
    for (int w = 0; w < wave; ++w) run += red[8 + w];
    run += inc - loc;
#pragma unroll
    for (int i = 0; i < 2; ++i) { run += (double)(i == 0 ? a0 : a1); const int s = s0 + i;
        const float f = (float)run; F[(size_t)bh * SEQ + s] = f;
        const float xv = -f / ATTN_SCALE; const unsigned hi = f2bf(xv); const float r1 = xv - __builtin_bit_cast(float, hi << 16); const unsigned mid = f2bf(r1);
        const float r2 = r1 - __builtin_bit_cast(float, mid << 16); const unsigned lo = f2bf(r2);
        v4u w; w.x = hi | (mid << 16); w.y = lo; w.z = 0u; w.w = 0u; *(v4u*)(KAUG + ((size_t)bh * SEQ + s) * 8) = w; }
    __syncthreads();
}

__device__ __forceinline__ void f8x16(const v4u w, float (&y)[16]) {
#pragma unroll
    for (int q = 0; q < 4; ++q) { const int d = (int)(q == 0 ? w.x : q == 1 ? w.y : q == 2 ? w.z : w.w);
        const auto lo = __builtin_amdgcn_cvt_pk_f32_fp8(d, false), hi = __builtin_amdgcn_cvt_pk_f32_fp8(d, true);
        y[4 * q + 0] = lo[0]; y[4 * q + 1] = lo[1]; y[4 * q + 2] = hi[0]; y[4 * q + 3] = hi[1]; }
}
__device__ __forceinline__ v4u ldnt(const void* p) { return __builtin_nontemporal_load((const v4u*)p); }
__device__ __forceinline__ void ld16f_nt(const float* p, float (&v)[16]) {
#pragma unroll
    for (int q = 0; q < 4; ++q) { const f32x4 a = __builtin_nontemporal_load((const f32x4*)(p + 4 * q)); v[4 * q] = a.x; v[4 * q + 1] = a.y; v[4 * q + 2] = a.z; v[4 * q + 3] = a.w; }
}
__device__ __forceinline__ void ld16bf_nt(const bf16* p, float (&v)[16]) {
#pragma unroll
    for (int q = 0; q < 2; ++q) { const v4u w = ldnt(p + 8 * q); v[8 * q + 0] = bflo(w.x); v[8 * q + 1] = bfhi(w.x); v[8 * q + 2] = bflo(w.y); v[8 * q + 3] = bfhi(w.y); v[8 * q + 4] = bflo(w.z); v[8 * q + 5] = bfhi(w.z); v[8 * q + 6] = bflo(w.w); v[8 * q + 7] = bfhi(w.w); }
}
__device__ __forceinline__ void ld16f(const float* p, float (&v)[16]) {
#pragma unroll
    for (int q = 0; q < 4; ++q) { const f32x4 a = *(const f32x4*)(p + 4 * q); v[4 * q] = a.x; v[4 * q + 1] = a.y; v[4 * q + 2] = a.z; v[4 * q + 3] = a.w; }
}
__device__ __forceinline__ void ld16bf(const bf16* p, float (&v)[16]) { float a[8], b[8]; ld8bf(p, a); ld8bf(p + 8, b);
#pragma unroll
    for (int e = 0; e < 8; ++e) { v[e] = a[e]; v[8 + e] = b[e]; } }
__device__ __forceinline__ void st16bf(bf16* p, const float (&v)[16]) { float a[8], b[8];
#pragma unroll
    for (int e = 0; e < 8; ++e) { a[e] = v[e]; b[e] = v[8 + e]; }
    st8bf(p, a); st8bf(p + 8, b); }
__device__ __forceinline__ void st16bf_nt(bf16* p, const float (&v)[16]) {
#pragma unroll
    for (int q = 0; q < 2; ++q) { v4u w; w.x = pg8::cvt_pk_bf16(v[8 * q], v[8 * q + 1]); w.y = pg8::cvt_pk_bf16(v[8 * q + 2], v[8 * q + 3]); w.z = pg8::cvt_pk_bf16(v[8 * q + 4], v[8 * q + 5]); w.w = pg8::cvt_pk_bf16(v[8 * q + 6], v[8 * q + 7]);
        __builtin_nontemporal_store(w, (v4u*)(p + 8 * q)); } }
__device__ __forceinline__ void ln1_pass(const Args& A, int l, int gw, int NGW, int lane) {
    asm volatile("" : "+v"(lane));
    const float* xin = A.in[I_X]; bf16* XB = (bf16*)(A.ws + WS_XB);
    const unsigned char* Y = (const unsigned char*)(A.ws + WS_Y); bf16* H = (bf16*)(A.ws + WS_H); const float* MOD = (const float*)(A.ws + WS_MOD);
    const float* gam_p = A.in[I_LNA_G] + l * 1024; const float* bet_p = A.in[I_LNA_B] + l * 1024;
    const int c0 = 16 * lane;
    for (int rb = gw; rb < NTOK / 16; rb += NGW) {
        const int b = (rb * 16) >> 14; const float* modb = MOD + (size_t)(l * 2 + b) * 6144;
        float gA[16], gam[16], bet[16], scm[16], shm[16];
        ld16f(modb + 2048 + c0, gA); ld16f(gam_p + c0, gam); ld16f(bet_p + c0, bet); ld16f(modb + 4096 + c0, scm); ld16f(modb + 3072 + c0, shm);
#pragma unroll
        for (int e = 0; e < 16; ++e) { gA[e] = (1.f + gA[e]) * (1.f / 16.f); scm[e] += 1.f; }
#define LN1_ISSUE(X0, X1, X2, X3, R0, R1, RY, t_) do { if (l == 0) { X0 = *(const f32x4*)(xin + (t_) * 1024 + c0); X1 = *(const f32x4*)(xin + (t_) * 1024 + c0 + 4); X2 = *(const f32x4*)(xin + (t_) * 1024 + c0 + 8); X3 = *(const f32x4*)(xin + (t_) * 1024 + c0 + 12); } \
            else { R0 = ldnt(XB + (t_) * 1024 + c0); R1 = ldnt(XB + (t_) * 1024 + c0 + 8); } RY = ldnt(Y + (t_) * 1024 + c0); } while (0)
        f32x4 cx0, cx1, cx2, cx3, nx0, nx1, nx2, nx3; v4u c0r, c1r, cyr, n0r, n1r, nyr;
        { float zf = 0.f; unsigned zz = 0u; asm volatile("" : "+v"(zf), "+v"(zz)); cx0 = (f32x4){zf, zf, zf, zf}; cx1 = cx0; cx2 = cx0; cx3 = cx0; nx0 = cx0; nx1 = cx0; nx2 = cx0; nx3 = cx0; c0r = (v4u){zz, zz, zz, zz}; c1r = c0r; n0r = c0r; n1r = c0r; }
        LN1_ISSUE(cx0, cx1, cx2, cx3, c0r, c1r, cyr, (size_t)rb * 16);
        for (int r = 0; r < 16; ++r) {
            const size_t t = (size_t)rb * 16 + r; float v[16], y[16];
            { const size_t tn = (size_t)rb * 16 + (r < 15 ? r + 1 : r); LN1_ISSUE(nx0, nx1, nx2, nx3, n0r, n1r, nyr, tn); }
            __builtin_amdgcn_sched_barrier(0);
            if (l == 0) {
#define F4(R, q) v[4 * q] = R.x; v[4 * q + 1] = R.y; v[4 * q + 2] = R.z; v[4 * q + 3] = R.w
                F4(cx0, 0); F4(cx1, 1); F4(cx2, 2); F4(cx3, 3);
#undef F4
            } else {
#define B8(R, q) v[8 * q] = bflo(R.x); v[8 * q + 1] = bfhi(R.x); v[8 * q + 2] = bflo(R.y); v[8 * q + 3] = bfhi(R.y); v[8 * q + 4] = bflo(R.z); v[8 * q + 5] = bfhi(R.z); v[8 * q + 6] = bflo(R.w); v[8 * q + 7] = bfhi(R.w)
                B8(c0r, 0); B8(c1r, 1);
#undef B8
            }
            f8x16(cyr, y);
            cx0 = nx0; cx1 = nx1; cx2 = nx2; cx3 = nx3; c0r = n0r; c1r = n1r; cyr = nyr;
            float s = 0.f;
#pragma unroll
            for (int e = 0; e < 16; ++e) { v[e] = ALPHA * v[e] + gA[e] * y[e]; s += v[e]; }
            const float mean = wave_sum(s, lane) * (1.f / 1024.f); float s2 = 0.f;
#pragma unroll
            for (int e = 0; e < 16; ++e) { v[e] -= mean; s2 += v[e] * v[e]; }
            const float rstd = 1.f / sqrtf(wave_sum(s2, lane) * (1.f / 1024.f) + LN_EPS);
            float o[16], hh[16];
#pragma unroll
            for (int e = 0; e < 16; ++e) { o[e] = v[e] * rstd * gam[e] + bet[e]; hh[e] = o[e] * scm[e] + shm[e]; }
            st16bf(XB + t * 1024 + c0, o); st16bf(H + t * 1024 + c0, hh);
        }
#undef LN1_ISSUE
    }
}

__device__ __forceinline__ void ln2_pass(const Args& A, LAS unsigned char* lds, int l, int hf, int c, int G, int wave, int r, int WL4, int lane) {
    asm volatile("" : "+v"(lane));
    float* xout = A.out; bf16* XB = (bf16*)(A.ws + WS_XB); const unsigned char* YR = (const unsigned char*)(A.ws + WS_YR); bf16* H = (bf16*)(A.ws + WS_H); const float* MOD = (const float*)(A.ws + WS_MOD);
    const int* SLOTOF = (const int*)(A.ws + WS_SLOTOF); const float* GATE = (const float*)(A.ws + WS_GATE);
    const LAS int* BBL = (const LAS int*)(lds + BBL_OFF) + hf * 68;
    const int shbase = __builtin_amdgcn_readfirstlane(BBL[64]) * 256;
    const float* gam_p = A.in[I_LNF_G] + l * 1024; const float* bet_p = A.in[I_LNF_B] + l * 1024;
    const float* modb = MOD + (size_t)(l * 2 + hf) * 6144; const float* modn = MOD + (size_t)(1 * 2 + hf) * 6144;
    const int c0 = 16 * lane;
    float gM[16], gam[16], bet[16];
    ld16f(modb + 5120 + c0, gM); ld16f(gam_p + c0, gam); ld16f(bet_p + c0, bet);
#pragma unroll
    for (int e = 0; e < 16; ++e) gM[e] = (1.f + gM[e]) * (1.f / 16.f);
    int sln[8]; float gwn[8];
    const int tw = r * 4 + (G - r) * WL4, cum0 = c < r ? c * 4 : r * 4 + (c - r) * WL4, cum1 = cum0 + (c < r ? 4 : WL4);
    const int row0 = __builtin_amdgcn_readfirstlane((int)((unsigned)(HTOK * cum0) / (unsigned)tw)), row1 = __builtin_amdgcn_readfirstlane((int)((unsigned)(HTOK * cum1) / (unsigned)tw));
    { const size_t t0 = (size_t)hf * HTOK + (row0 + wave < HTOK ? row0 + wave : 0);
      const int sv_ = SLOTOF[t0 * 8 + (lane & 7)], ss_ = BBL[sv_ >> 16] * 256 + (sv_ & 0xffff);
#pragma unroll
      for (int k = 0; k < 8; ++k) { sln[k] = __builtin_amdgcn_readlane(ss_, k); gwn[k] = __builtin_bit_cast(float, __builtin_amdgcn_readfirstlane(__builtin_bit_cast(int, GATE[t0 * 8 + k]))); } }
    for (int tl = row0 + wave; tl < row1; tl += NWAVES) {
        const size_t t = (size_t)hf * HTOK + tl;
        int sl[8]; float gw8[8];
#pragma unroll
        for (int k = 0; k < 8; ++k) { sl[k] = sln[k]; gw8[k] = gwn[k]; }
        { const int tn = tl + NWAVES < row1 ? tl + NWAVES : tl; const size_t t1 = (size_t)hf * HTOK + tn;
          const int sv_ = SLOTOF[t1 * 8 + (lane & 7)], ss_ = BBL[sv_ >> 16] * 256 + (sv_ & 0xffff);
#pragma unroll
          for (int k = 0; k < 8; ++k) { sln[k] = __builtin_amdgcn_readlane(ss_, k); gwn[k] = __builtin_bit_cast(float, __builtin_amdgcn_readfirstlane(__builtin_bit_cast(int, GATE[t1 * 8 + k]))); } }
        float v[16], ys[16], y[16];
        ld16bf_nt(XB + t * 1024 + c0, v);
        f8x16(ldnt(YR + ((size_t)shbase + tl) * 1024 + c0), ys);
#pragma unroll
        for (int k = 0; k < 8; ++k) { f8x16(ldnt(YR + (size_t)sl[k] * 1024 + c0), y);
#pragma unroll
            for (int e = 0; e < 16; ++e) ys[e] += gw8[k] * y[e]; }
        float s = 0.f;
#pragma unroll
        for (int e = 0; e < 16; ++e) { v[e] = ALPHA * v[e] + gM[e] * ys[e]; s += v[e]; }
        const float mean = wave_sum(s, lane) * (1.f / 1024.f); float s2 = 0.f;
#pragma unroll
        for (int e = 0; e < 16; ++e) { v[e] -= mean; s2 += v[e] * v[e]; }
        const float rstd = 1.f / sqrtf(wave_sum(s2, lane) * (1.f / 1024.f) + LN_EPS);
        float o[16];
#pragma unroll
        for (int e = 0; e < 16; ++e) o[e] = v[e] * rstd * gam[e] + bet[e];
        if (l == 1) {
#pragma unroll
            for (int q = 0; q < 4; ++q) *(f32x4*)(xout + t * 1024 + c0 + 4 * q) = (f32x4){o[4 * q], o[4 * q + 1], o[4 * q + 2], o[4 * q + 3]}; }
        else st16bf(XB + t * 1024 + c0, o);
        if (l == 0) { float h0[8], h1[8], scn[16], shn[16];
            { const float* mq = modn; asm volatile("" : "+s"(mq)); ld16f(mq + 1024 + c0, scn); ld16f(mq + c0, shn); }
#pragma unroll
            for (int e = 0; e < 8; ++e) { h0[e] = o[e] * (1.f + scn[e]) + shn[e]; h1[e] = o[8 + e] * (1.f + scn[8 + e]) + shn[8 + e]; }
            st8bf(H + t * 1024 + c0, h0); st8bf(H + t * 1024 + c0 + 8, h1); }
    }
}

__device__ __forceinline__ void build_block_tables(const unsigned* cnt, LAS unsigned char* lds, int wave, int lane) {
    asm volatile("" : "+v"(lane));
    LAS int* BT = (LAS int*)(lds + BT_OFF); LAS int* BBL = (LAS int*)(lds + BBL_OFF);
    if (wave < 2) { const int h = wave;
        const int n = (int)__hip_atomic_load(cnt + h * 64 + lane, __ATOMIC_RELAXED, __HIP_MEMORY_SCOPE_AGENT), nb = (n + 255) >> 8;
        int inc = nb;
#pragma unroll
        for (int o = 1; o < 64; o <<= 1) { const int up = __builtin_amdgcn_ds_bpermute(((lane - o) & 63) << 2, inc); if (lane >= o) inc += up; }
        const int excl = inc - nb, tot = __builtin_amdgcn_readlane(inc, 63);
        BBL[h * 68 + lane] = excl; if (lane == 0) { BBL[h * 68 + 64] = tot; BBL[h * 68 + 65] = tot + 64; }
        for (int j = 0; j < nb; ++j) BT[h * MAXBLK + excl + j] = lane | (j << 8);
        BT[h * MAXBLK + tot + lane] = 64 | (lane << 8);
    }
    __syncthreads();
}
constexpr int PH_PER_LAYER = 12, PH_BASE = 3, NPH = PH_BASE + DEPTH * PH_PER_LAYER;
#ifndef MK_PER_PHASE
#define MK_PER_PHASE 0
#endif

typedef const __attribute__((address_space(4))) Args* KArgsPtr;
__device__ __forceinline__ Args load_args() {
#if defined(__HIP_DEVICE_COMPILE__)
    KArgsPtr p = (KArgsPtr)__builtin_amdgcn_kernarg_segment_ptr(); asm volatile("" : "+s"(p));
    Args a;
#pragma unroll
    for (int i = 0; i < 21; ++i) a.in[i] = p->in[i];
    a.out = p->out; a.ws = p->ws; a.ph_lo = p->ph_lo; a.ph_hi = p->ph_hi; return a;
#else
    return Args{};
#endif
}
__global__ void __launch_bounds__(NWAVES * 64, 2) mk_fwd(Args args) {
    extern __shared__ __attribute__((aligned(16))) unsigned char lds_raw[];
    LAS unsigned char* lds = (LAS unsigned char*)lds_raw;
    volatile LAS unsigned* MISC = (volatile LAS unsigned*)(lds + MISC_OFF);
    const int wave = __builtin_amdgcn_readfirstlane((int)threadIdx.x >> 6);
    const int G = gridDim.x, bx = blockIdx.x; const int vcu = (G % 8 == 0) ? (bx % 8) * (G / 8) + bx / 8 : bx;
    const int gw = vcu * NWAVES + wave, NGW = G * NWAVES;
    unsigned* ctl = (unsigned*)(args.ws + WS_CTL);
    for (int u = wave * 64 + lane_now(); u < (LDS_BYTES - LDSCTL_OFF) / 4; u += NWAVES * 64) ((LAS unsigned*)(lds + LDSCTL_OFF))[u] = 0u;
    __syncthreads();
    const int lo = args.ph_lo, hi = args.ph_hi;
    XcdBarrier bar; bar.bar = ctl + CW_BAR; bar.x = 0; bar.st = MISC + 8; bar.wave = wave;
    if (hi - lo > 1) bar = xcd_barrier_post(ctl + CW_BAR, MISC + 8, wave);
#ifndef LN2_WL4
#define LN2_WL4 8
#endif
#ifndef PHMASK
#define PHMASK 0xFFFF
#endif
#define KIND(i) ((PHMASK >> (i)) & 1)
#define PH(k) (lo <= (k) && (k) < hi)
#define SEAM(k) do { if (PH(k) && PH((k) + 1)) { XcdBarrier _b = bar; asm volatile("" : "+s"(_b.bar)); xcd_barrier(_b); } } while (0)

    if (PH(0) && KIND(0)) { const Args A = load_args(); const int lane = lane_now(), tid = wave * 64 + lane; (void)tid; (void)lane; unsigned char* const ws = A.ws; (void)ws;
        convert_attn_weights(A, lds, gw, NGW, wave, lane);
        {
            const float* adaw = A.in[I_ADA_W]; const float* cv = A.in[I_C]; const float* adab = A.in[I_ADA_B]; float* MOD = (float*)(ws + WS_MOD);
            LAS float* sl = (LAS float*)(lds + 65536); LAS float* part = sl + 2048;
            __syncthreads();
            for (int i = tid; i < 2048; i += 512) { const float c0 = cv[i]; sl[i] = c0 / (1.f + expf(-c0)); }
            __syncthreads();
            for (int pb2 = bx; pb2 < 12288 / 48; pb2 += G) {
                const int jq = tid % 12, ks = tid / 12;
                const int pair = pb2 * 48 + 4 * jq, l = pair / 6144, j = pair % 6144;
                if (ks < 32) { f32x4 a0 = {0.f, 0.f, 0.f, 0.f}, a1 = a0;
#pragma unroll 1
                    for (int k0 = ks * 32; k0 < ks * 32 + 32; k0 += 16) { f32x4 w[16];
#pragma unroll
                        for (int i = 0; i < 16; ++i) w[i] = *(const f32x4*)(adaw + ((size_t)l * 1024 + k0 + i) * 6144 + j);
#pragma unroll
                        for (int i = 0; i < 16; ++i) { a0 += sl[k0 + i] * w[i]; a1 += sl[1024 + k0 + i] * w[i]; } }
#pragma unroll
                    for (int q = 0; q < 4; ++q) { part[(ks * 48 + 4 * jq + q) * 2] = a0[q]; part[(ks * 48 + 4 * jq + q) * 2 + 1] = a1[q]; } }
                __syncthreads();
                if (tid < 96) { const int jj = tid >> 1, b = tid & 1; const int pr = pb2 * 48 + jj, l2 = pr / 6144, j2 = pr % 6144; float s = adab[l2 * 6144 + j2];
                    for (int q = 0; q < 32; ++q) s += part[(q * 48 + jj) * 2 + b];
                    MOD[(size_t)(l2 * 2 + b) * 6144 + j2] = s; }
                __syncthreads();
            }
        }
    }
    SEAM(0);
    if (PH(2) && KIND(2)) { const Args A = load_args(); const int lane = lane_now(), tid = wave * 64 + lane; (void)tid; (void)lane; input_pass(A, lds, gw, NGW, tid, lane); }
    SEAM(2);

    for (int l = 0; l < DEPTH; ++l) {
        const int pb = PH_BASE + l * PH_PER_LAYER;
        if (PH(pb + 0) && KIND(3)) { const Args A = load_args(); const int lane = lane_now(), tid = wave * 64 + lane; (void)tid; (void)lane; unsigned char* const ws = A.ws; (void)ws;
            if (l == 0) { for (int task = bx; task < 256; task += G) fox_scan_seg(A, lds, task, tid, lane, wave); }
            pg8::Gemm g{(const bf16*)(ws + WS_H), (const bf16*)(ws + WS_WATT + (size_t)l * WATT_STRIDE), NTOK, 3 * DM, DM}; pg8::StaticOrder<NTOK / 256, 12> S; S.init(G, bx);
            pg8::EpiQKV E{(bf16*)(ws + WS_Q), (size_t)(WS_K - WS_Q) / 2, l == 0 ? ctl + CW_FOXQ + 16 : nullptr, (LAS float*)(lds + LDSCTL_OFF + 4096)};
            pg8::gemm_phase<pg8::EpiQKV, pg8::StaticOrder<NTOK / 256, 12>, true, false>(lds + RING_OFF, g, S, E, nullptr, wave);
        }
        SEAM(pb + 0);
        if (PH(pb + 1) && KIND(4)) { const Args A = load_args(); const int lane = lane_now(), tid = wave * 64 + lane; (void)tid; (void)lane; unsigned char* const ws = A.ws; (void)ws;
            if (l == 0) {
                const bool conv_first = ((bx >> 3) & 7) == 0;
                if (conv_first) { convert_moe_drain(A.in[I_EG], A.in[I_EU], A.in[I_ED], A.in[I_SG], A.in[I_SU], A.in[I_SD], ws, lds, wave); __syncthreads(); }
                fox::fox_phase((const bf16*)(ws + WS_Q), (const bf16*)(ws + WS_K), (const bf16*)(ws + WS_V), (const bf16*)(ws + WS_KAUG), (bf16*)(ws + WS_O), (const float*)(ws + WS_F), ctl + CW_FOXQ, (char*)lds_raw, wave); __syncthreads();
                convert_moe_drain(A.in[I_EG], A.in[I_EU], A.in[I_ED], A.in[I_SG], A.in[I_SU], A.in[I_SD], ws, lds, wave); __syncthreads(); }
            else { fox::sb_phase((const bf16*)(ws + WS_Q), (const bf16*)(ws + WS_K), (const bf16*)(ws + WS_V), (bf16*)(ws + WS_O), (char*)lds_raw, G, vcu, wave); __syncthreads(); }
        }
        SEAM(pb + 1);
        if (PH(pb + 2) && KIND(5)) { const Args A = load_args(); const int lane = lane_now(), tid = wave * 64 + lane; (void)tid; (void)lane; unsigned char* const ws = A.ws; (void)ws;
            pg8::Gemm g{(const bf16*)(ws + WS_O), (const bf16*)(ws + WS_WATT + (size_t)l * WATT_STRIDE + WATT_O), NTOK, DM, DM}; pg8::StaticOrder<NTOK / 256, 4> S; S.init(G, bx);
            pg8::EpiF8 E{(unsigned char*)(ws + WS_Y), DM, 0xffff};
            pg8::gemm_phase<pg8::EpiF8, pg8::StaticOrder<NTOK / 256, 4>, true, false>(lds + RING_OFF, g, S, E, nullptr, wave);
        }
        SEAM(pb + 2);
        if (PH(pb + 3) && KIND(6)) { const Args A = load_args(); const int lane = lane_now(), tid = wave * 64 + lane; (void)tid; (void)lane; ln1_pass(A, l, gw, NGW, lane); }
        SEAM(pb + 3);
        if (PH(pb + 4) && KIND(7)) { const Args A = load_args(); const int lane = lane_now(), tid = wave * 64 + lane; (void)tid; (void)lane; unsigned char* const ws = A.ws; (void)ws;
            pg8::Gemm g{(const bf16*)(ws + WS_H), (const bf16*)(ws + WS_WATT + (size_t)l * WATT_STRIDE + WATT_R), NTOK, 256, DM}; pg8::StaticOrder<NTOK / 256, 1> S; S.init(G, bx);
            pg8::EpiRouter E{A.in[I_RB] + l * 64, (float*)(ws + WS_GATE), ctl + CW_CNT + l * 128, (int*)(ws + WS_SLOTOF), (unsigned short*)(ws + WS_ROWTOK2)};
            pg8::gemm_phase<pg8::EpiRouter, pg8::StaticOrder<NTOK / 256, 1>, false, false>(lds + RING_OFF, g, S, E, nullptr, wave);
            __syncthreads();
        }
        SEAM(pb + 4);
        for (int hf = 0; hf < 2; ++hf) {
            const int ph = pb + 6 + 3 * hf;
            if (PH(ph) && KIND(9)) { const Args A = load_args(); const int lane = lane_now(), tid = wave * 64 + lane; (void)tid; (void)lane; unsigned char* const ws = A.ws; (void)ws;
                if (hf == 0) build_block_tables(ctl + CW_CNT + l * 128, lds, wave, lane);
                const int nblk = __builtin_amdgcn_readfirstlane(((const LAS int*)(lds + BBL_OFF))[hf * 68 + 65]);
                pg8::Gemm g{(const bf16*)(ws + WS_H) + (size_t)hf * HTOK * DM, (const bf16*)(ws + (l == 0 ? WS_WMOE0 : WS_WMOE1)), 0, 512, DM};
                pg8::MoeOrder S{nblk * 2, 1, G, vcu, (const LAS int*)(lds + BT_OFF) + hf * MAXBLK};
                pg8::EpiSwiglu E{(bf16*)(ws + WS_ACT)};
                pg8::gemm_phase<pg8::EpiSwiglu, pg8::MoeOrder, true, true>(lds + RING_OFF, g, S, E, (const unsigned short*)(ws + WS_ROWTOK2) + (size_t)hf * 65 * 16384, wave);
            }
            SEAM(ph);
            if (PH(ph + 1) && KIND(10)) { const Args A = load_args(); const int lane = lane_now(), tid = wave * 64 + lane; (void)tid; (void)lane; unsigned char* const ws = A.ws; (void)ws;
                const int nblk = __builtin_amdgcn_readfirstlane(((const LAS int*)(lds + BBL_OFF))[hf * 68 + 65]);
                pg8::Gemm g{(const bf16*)(ws + WS_ACT), (const bf16*)(ws + (l == 0 ? WS_WMOE0 : WS_WMOE1) + WMOE_D), 0, 1024, FE};
                pg8::MoeOrder S{nblk * 4, 2, G, vcu, (const LAS int*)(lds + BT_OFF) + hf * MAXBLK};
                pg8::EpiF8 E{(unsigned char*)(ws + WS_YR), DM, 3};
                pg8::gemm_phase<pg8::EpiF8, pg8::MoeOrder, true, false>(lds + RING_OFF, g, S, E, nullptr, wave);
            }
            SEAM(ph + 1);
            if (PH(ph + 2) && KIND(11)) { const Args A = load_args(); const int lane = lane_now(), tid = wave * 64 + lane; (void)tid; (void)lane; unsigned char* const ws = A.ws; (void)ws;
                int r = G, wl4 = 4;
                if (hf == 0) { const int nun = __builtin_amdgcn_readfirstlane(((const LAS int*)(lds + BBL_OFF))[1 * 68 + 65]) * 2; r = nun % G; wl4 = LN2_WL4; }
                ln2_pass(A, lds, l, hf, vcu, G, wave, r, wl4, lane);
            }
            if (hf == 1) SEAM(ph + 2);
        }
    }
#undef PH
#undef SEAM
}

extern "C" void kernel_launch(void* const* d_in, const int* in_sizes, int n_in, void* d_out, int out_size, void* d_ws, size_t ws_size, hipStream_t stream) {
    static int grid = 0;
    if (grid == 0) {
        if (n_in != 21 || in_sizes[0] != NTOK * DM || out_size != NTOK * DM || ws_size < WS_END) {
            fprintf(stderr, "kernel_launch: unexpected shapes (n_in %d, in0 %d, out %d, ws %zu < %zu); nothing launched\n", n_in, n_in > 0 ? in_sizes[0] : -1, out_size, ws_size, (size_t)WS_END); grid = -1; return; }
        int dev = 0, cus = 0;
        if (hipGetDevice(&dev) != hipSuccess || hipDeviceGetAttribute(&cus, hipDeviceAttributeMultiprocessorCount, dev) != hipSuccess) { grid = -1; return; }
        if (hipFuncSetAttribute((const void*)mk_fwd, hipFuncAttributeMaxDynamicSharedMemorySize, LDS_BYTES) != hipSuccess) { fprintf(stderr, "kernel_launch: hipFuncSetAttribute failed\n"); grid = -1; return; }
        int per_cu = 0;
        if (hipOccupancyMaxActiveBlocksPerMultiprocessor(&per_cu, (const void*)mk_fwd, NWAVES * 64, LDS_BYTES) != hipSuccess || per_cu < 1) { fprintf(stderr, "kernel_launch: occupancy query reports %d\n", per_cu); }
        (void)hipGetLastError();
        grid = cus;
        if (grid < 128) { fprintf(stderr, "kernel_launch: needs >= 128 CUs\n"); grid = -1; return; }
    }
    if (grid < 0) return;
    if (hipMemsetAsync((char*)d_ws + WS_CTL, 0, CTL_ZERO_BYTES, stream) != hipSuccess) return;
    Args a{};
    for (int i = 0; i < 21; ++i) a.in[i] = (const float*)d_in[i];
    a.out = (float*)d_out; a.ws = (unsigned char*)d_ws;
#if MK_PER_PHASE
    for (int p = 0; p < NPH; ++p) { a.ph_lo = p; a.ph_hi = p + 1; hipLaunchKernelGGL(mk_fwd, dim3(grid), dim3(NWAVES * 64), LDS_BYTES, stream, a); }
#else
    a.ph_lo = 0; a.ph_hi = NPH;
    hipLaunchKernelGGL(mk_fwd, dim3(grid), dim3(NWAVES * 64), LDS_BYTES, stream, a);
#endif
}
```

```cpp
#include <hip/hip_runtime.h>
#include <cstdio>
#include <cstdint>
#include <cmath>
__device__ __forceinline__ int lane_now() { int l; asm volatile("v_mbcnt_lo_u32_b32 %0, -1, 0\n\tv_mbcnt_hi_u32_b32 %0, -1, %0" : "=v"(l)); return l; }
namespace pg8 {
#define PG8_LAS __attribute__((address_space(3)))
typedef unsigned short bf16_t;
typedef short bf16x8 __attribute__((ext_vector_type(8)));
typedef float f32x4 __attribute__((ext_vector_type(4)));
typedef unsigned u32x4 __attribute__((ext_vector_type(4)));
constexpr int RTL_OFF = 131072 + 8192;
constexpr int BM = 256, BK = 64, HALF = 128, HTB = HALF * BK * 2  , STAGE_BYTES = 8 * HTB, NXCD = 8, WGM = 8;

__host__ __device__ __forceinline__ int lds_byte(int r, int c) { const int st = (r >> 4) * 2 + (c >> 5), rr = r & 15, cc = c & 31, ob = rr * 64 + cc * 2; return st * 1024 + (ob ^ (((ob >> 9) & 1) << 5)); }
__host__ __device__ __forceinline__ void stage_rc(int b, int& R, int& C) { const int st = b / 1024, sb = b % 1024, swz = sb ^ (((sb >> 9) & 1) << 5); R = (st >> 1) * 16 + swz / 64; C = (st & 1) * 32 + (swz % 64) / 2; }
__host__ __device__ __forceinline__ int perm32(int rho) { const int n = rho >> 4, i = rho & 15; return 8 * (i >> 2) + 4 * n + (i & 3); }

struct Unit { int pm, pn, aux; };
struct Gemm { const bf16_t* A; const bf16_t* Bt; int M, N, K; };

template <int NM, int NN> struct StaticOrder {
    int G, c;
    __host__ __device__ void init(int G_, int c_) { G = G_; c = c_; }
    __host__ __device__ bool next(int i, Unit& u) const {
        constexpr int nwg = NM * NN;
        const int L = i * G + c; if (L >= nwg) return false;
        int wgid = L; { constexpr int q = nwg / NXCD, r = nwg % NXCD; const int xcd = wgid % NXCD, off = wgid / NXCD; wgid = (xcd < r ? xcd * (q + 1) : r * (q + 1) + (xcd - r) * q) + off; }
        constexpr int nig = WGM * NN; const int gid = wgid / nig, fm = gid * WGM, gsz = (NM - fm) < WGM ? (NM - fm) : WGM;
        u.pm = fm + ((wgid % nig) % gsz); u.pn = (wgid % nig) / gsz; u.aux = 0; return true;
    }
};
struct MoeOrder {
    int nunits, sh, G, c; const PG8_LAS int* bt;
    __device__ __forceinline__ bool next(int i, Unit& u) const {
        const long L = (long)i * G + c; if (L >= nunits) return false;
        const int blk = (int)(L >> sh), pnl = (int)L & ((1 << sh) - 1);
        const int v = __builtin_amdgcn_readfirstlane(bt[blk]);
        u.pm = blk; u.pn = ((v & 255) << sh) + pnl; u.aux = v; return true;
    }
};

__device__ __forceinline__ unsigned cvt_pk_bf16(float lo, float hi) { unsigned r; asm volatile("v_cvt_pk_bf16_f32 %0, %1, %2" : "=v"(r) : "v"(lo), "v"(hi)); return r; }


struct EpiBf16 {
    static constexpr int PERMW = 1; static constexpr bool AFTER_DRAIN = false;
    bf16_t* O; int ldc; int pn_mask;
    __device__ __forceinline__ void operator()(const f32x4 (&acc)[2][2][4][2], const Unit& u, int wr, int wc, int fr, int fq) const {
        { const int tz = lane_now(); fr = tz & 15; fq = (tz >> 4) & 3; }
        char* base = (char*)(O + (size_t)(u.pm * BM + wr * 64) * ldc + (u.pn & pn_mask) * BM + wc * 32);
        const unsigned lo = (unsigned)(fr * ldc + 8 * fq) * 2u;
#pragma unroll
        for (int ai = 0; ai < 2; ++ai)
#pragma unroll
            for (int m = 0; m < 4; ++m)
#pragma unroll
                for (int bj = 0; bj < 2; ++bj) { const f32x4 v0 = acc[ai][bj][m][0], v1 = acc[ai][bj][m][1];
                    u32x4 w; w.x = cvt_pk_bf16(v0[0], v0[1]); w.y = cvt_pk_bf16(v0[2], v0[3]); w.z = cvt_pk_bf16(v1[0], v1[1]); w.w = cvt_pk_bf16(v1[2], v1[3]);
                    *(u32x4*)(base + (size_t)(lo + (unsigned)(((ai * HALF + m * 16) * ldc + bj * HALF) * 2))) = w; }
    }
};
struct EpiQKV {
    static constexpr int PERMW = 1; static constexpr bool AFTER_DRAIN = false;
    bf16_t* Q; size_t qkv_stride;
    unsigned* nrm; PG8_LAS float* rs;
    __device__ __forceinline__ void operator()(const f32x4 (&acc)[2][2][4][2], const Unit& u, int wr, int wc, int fr, int fq) const {
        const int lz = lane_now(); fr = lz & 15; fq = (lz >> 4) & 3;
        const int which = u.pn >> 2; bf16_t* base = Q + (size_t)which * qkv_stride;
        const int r0 = u.pm * BM + wr * 64 + fr, b = r0 >> 14, s0 = r0 & 16383;
        const bool norms = nrm != nullptr && which == 1;
        if (norms) { rs[wr * 256 + wc * 64 + lz] = 0.f; asm volatile("s_waitcnt lgkmcnt(0)" ::: "memory"); __builtin_amdgcn_s_barrier(); }
#pragma unroll
        for (int ai = 0; ai < 2; ++ai)
#pragma unroll
            for (int m = 0; m < 4; ++m) { const int s = s0 + ai * HALF + m * 16;
#pragma unroll
                for (int bj = 0; bj < 2; ++bj) { const int head = 2 * (u.pn & 3) + bj;
                    bf16_t* p = base + ((size_t)(b * 8 + head) * 16384 + s) * 128 + wc * 32 + 8 * fq;
                    const f32x4 v0 = acc[ai][bj][m][0], v1 = acc[ai][bj][m][1];
                    u32x4 w; w.x = cvt_pk_bf16(v0[0], v0[1]); w.y = cvt_pk_bf16(v0[2], v0[3]); w.z = cvt_pk_bf16(v1[0], v1[1]); w.w = cvt_pk_bf16(v1[2], v1[3]);
                    *(u32x4*)p = w;
                    if (norms) { float ss = 0.f;
#pragma unroll
                        for (int q = 0; q < 4; ++q) { const unsigned d = q == 0 ? w.x : q == 1 ? w.y : q == 2 ? w.z : w.w; const float lo = __builtin_bit_cast(float, d << 16), hi = __builtin_bit_cast(float, d & 0xffff0000u); ss += lo * lo + hi * hi; }
                        ss += __builtin_bit_cast(float, __builtin_amdgcn_ds_bpermute((lz ^ 16) << 2, __builtin_bit_cast(int, ss)));
                        ss += __builtin_bit_cast(float, __builtin_amdgcn_ds_bpermute((lz ^ 32) << 2, __builtin_bit_cast(int, ss)));
                        if (fq == 0) (void)__hip_atomic_fetch_add(rs + (ai * HALF + wr * 64 + m * 16 + fr) * 2 + bj, ss, __ATOMIC_RELAXED, __HIP_MEMORY_SCOPE_WORKGROUP); } } }
        if (norms) { asm volatile("s_waitcnt lgkmcnt(0)" ::: "memory"); __builtin_amdgcn_s_barrier();
            float mx = rs[wr * 256 + wc * 64 + lz];
#pragma unroll
            for (int o = 2; o < 64; o <<= 1) mx = fmaxf(mx, __builtin_bit_cast(float, __builtin_amdgcn_ds_bpermute((lz ^ o) << 2, __builtin_bit_cast(int, mx))));
            if (lz < 2) { const int bh = b * 8 + 2 * (u.pn & 3) + lz;
                atomicMax(nrm + bh, __builtin_bit_cast(unsigned, mx * 1.001f)); }
            asm volatile("s_waitcnt lgkmcnt(0)" ::: "memory"); __builtin_amdgcn_s_barrier(); }
    }
};
__device__ __forceinline__ float silu_f(float g) { return g * __builtin_amdgcn_rcpf(1.0f + __builtin_amdgcn_exp2f(-1.4426950408889634f * g)); }
struct EpiSwiglu {
    static constexpr int PERMW = 1; static constexpr bool AFTER_DRAIN = false;
    bf16_t* ACT;
    __device__ __forceinline__ void operator()(const f32x4 (&acc)[2][2][4][2], const Unit& u, int wr, int wc, int fr, int fq) const {
        { const int tz = lane_now(); fr = tz & 15; fq = (tz >> 4) & 3; }
        const int row0 = u.pm * BM + wr * 64 + fr; const int col0 = (u.pn & 1) * 128 + wc * 32 + 8 * fq;
#pragma unroll
        for (int ai = 0; ai < 2; ++ai)
#pragma unroll
            for (int m = 0; m < 4; ++m) { bf16_t* rowp = ACT + (size_t)(row0 + ai * HALF + m * 16) * 256 + col0;
                const f32x4 g0 = acc[ai][0][m][0], g1 = acc[ai][0][m][1], u0 = acc[ai][1][m][0], u1 = acc[ai][1][m][1];
                float a[8];
#pragma unroll
                for (int j = 0; j < 4; ++j) { a[j] = silu_f(g0[j]) * u0[j]; a[4 + j] = silu_f(g1[j]) * u1[j]; }
                u32x4 w; w.x = cvt_pk_bf16(a[0], a[1]); w.y = cvt_pk_bf16(a[2], a[3]); w.z = cvt_pk_bf16(a[4], a[5]); w.w = cvt_pk_bf16(a[6], a[7]);
                *(u32x4*)rowp = w; }
    }
};
struct EpiF8 {
    static constexpr int PERMW = 2; static constexpr bool AFTER_DRAIN = false;
    unsigned char* O; int ldc; int pn_mask;
    __device__ __forceinline__ void operator()(const f32x4 (&acc)[2][2][4][2], const Unit& u, int wr, int wc, int fr, int fq) const {
        { const int tz = lane_now(); fr = tz & 15; fq = (tz >> 4) & 3; }
        char* base = (char*)(O + (size_t)(u.pm * BM + wr * 64) * ldc + (u.pn & pn_mask) * BM + wc * 64);
        const unsigned lo = (unsigned)(fr * ldc + 16 * fq);
#pragma unroll
        for (int ai = 0; ai < 2; ++ai)
#pragma unroll
            for (int m = 0; m < 4; ++m) { u32x4 w;
                { const f32x4 a = acc[ai][0][m][0] * 16.f, b = acc[ai][0][m][1] * 16.f; int t = 0; t = __builtin_amdgcn_cvt_pk_fp8_f32(a[0], a[1], t, false); t = __builtin_amdgcn_cvt_pk_fp8_f32(a[2], a[3], t, true); w.x = (unsigned)t;
                  int t2 = 0; t2 = __builtin_amdgcn_cvt_pk_fp8_f32(b[0], b[1], t2, false); t2 = __builtin_amdgcn_cvt_pk_fp8_f32(b[2], b[3], t2, true); w.y = (unsigned)t2; }
                { const f32x4 a = acc[ai][1][m][0] * 16.f, b = acc[ai][1][m][1] * 16.f; int t = 0; t = __builtin_amdgcn_cvt_pk_fp8_f32(a[0], a[1], t, false); t = __builtin_amdgcn_cvt_pk_fp8_f32(a[2], a[3], t, true); w.z = (unsigned)t;
                  int t2 = 0; t2 = __builtin_amdgcn_cvt_pk_fp8_f32(b[0], b[1], t2, false); t2 = __builtin_amdgcn_cvt_pk_fp8_f32(b[2], b[3], t2, true); w.w = (unsigned)t2; }
                __builtin_nontemporal_store(w, (u32x4*)(base + (size_t)(lo + (unsigned)((ai * HALF + m * 16) * ldc)))); }
    }
};
struct EpiRouter {
    static constexpr int PERMW = 0; static constexpr bool AFTER_DRAIN = true;
    const float* rbias; float* gate; unsigned* cnt; int* slotof; unsigned short* rowtok2;
    __device__ __forceinline__ void fused(const f32x4 (&acc)[2][2][4][2], const Unit& u, int wr, int wc, int fr, int fq, PG8_LAS unsigned char* lds, int wid, int lane) const {
        PG8_LAS float* L = (PG8_LAS float*)lds;
        PG8_LAS float* Bs = (PG8_LAS float*)(lds + 256 * 65 * 4);
        PG8_LAS unsigned* H = (PG8_LAS unsigned*)(lds + 256 * 65 * 4 + 256);
        PG8_LAS unsigned* GB = H + 64;
        { const int tz = lane_now(); lane = tz; fr = tz & 15; fq = (tz >> 4) & 3; }
        const int tid = wid * 64 + lane;
        if (tid < 64) { Bs[tid] = rbias[tid]; H[tid] = 0u; }
        if (wc < 2) {
#pragma unroll
            for (int ai = 0; ai < 2; ++ai)
#pragma unroll
                for (int m = 0; m < 4; ++m)
#pragma unroll
                    for (int n = 0; n < 2; ++n) { const int row = 128 * ai + 64 * wr + 16 * m + fr, col = 32 * wc + 16 * n + 4 * fq;
                        const f32x4 v = acc[ai][0][m][n] + acc[ai][1][m][n];
                        L[row * 65 + col + 0] = v[0]; L[row * 65 + col + 1] = v[1]; L[row * 65 + col + 2] = v[2]; L[row * 65 + col + 3] = v[3]; }
        }
        __syncthreads();
        const int half = (u.pm * BM) >> 14;
        int si[8]; unsigned lr[8];
        if (tid < 256) {
            const int t = u.pm * BM + tid; PG8_LAS float* Lr = L + tid * 65;
            for (int e = 0; e < 64; ++e) { const float x = Lr[e]; Lr[e] = __builtin_amdgcn_rcpf(1.0f + __builtin_amdgcn_exp2f(-1.4426950408889634f * x)) + Bs[e]; }
            float sv[8]; float sum = 0.f;
#pragma unroll
            for (int p = 0; p < 8; ++p) { float bv = -3.0e38f; int bi = 0;
                for (int e = 0; e < 64; ++e) { const float x = Lr[e]; if (x > bv) { bv = x; bi = e; } }
                si[p] = bi; sv[p] = bv - Bs[bi]; sum += sv[p]; Lr[bi] = -3.0e38f; }
            const float inv = 2.5f / sum;
#pragma unroll
            for (int p = 0; p < 8; ++p) { gate[(size_t)t * 8 + p] = sv[p] * inv; lr[p] = atomicAdd((unsigned*)&H[si[p]], 1u); }
        }
        __syncthreads();
        if (tid < 64) { const unsigned h = H[tid]; GB[tid] = h ? atomicAdd(cnt + half * 64 + tid, h) : 0u; }
        __syncthreads();
        if (tid < 256) {
            const int t = u.pm * BM + tid, tl = t - half * 16384;
#pragma unroll
            for (int p = 0; p < 8; ++p) { const unsigned pos = GB[si[p]] + lr[p];
                slotof[(size_t)t * 8 + p] = (int)(((unsigned)si[p] << 16) | pos);
                rowtok2[((size_t)(half * 65 + si[p]) << 14) + pos] = (unsigned short)tl; }
            rowtok2[((size_t)(half * 65 + 64) << 14) + tl] = (unsigned short)tl;
        }
    }
};

template <class Epi, class Sched, bool ALIGN_EPI, bool GATHER>
__device__ __forceinline__ void gemm_phase(PG8_LAS unsigned char* lds, const Gemm g, const Sched& S, const Epi& E, const unsigned short* __restrict__ rowtok, int wave) {
    const int wid = wave, lane = lane_now(), tid = wid * 64 + lane;
    const int wr = wid >> 2, wc = wid & 3, fr = lane & 15, fq = lane >> 4;
    const int K = g.K, nt = K / BK;
    unsigned voffB[2];
#pragma unroll
    for (int i = 0; i < 2; ++i) { int R, C; stage_rc(tid * 16 + i * 8192, R, C); const int Rb = Epi::PERMW == 1 ? ((R & ~31) + perm32(R & 31)) : Epi::PERMW == 2 ? (64 * (R >> 5) + 16 * ((R & 15) >> 2) + 4 * ((R >> 4) & 1) + (R & 3)) : R;
        voffB[i] = (unsigned)(Rb * K + C) * 2u; }
    const size_t kstep = (size_t)(BK * 2);
    const size_t hstep = (size_t)HALF * K * 2;
    const size_t tstep = 2 * hstep;
    const size_t bstep = Epi::PERMW == 2 ? (size_t)8 * K * 2 : hstep;
    const unsigned ldsw = (unsigned)wid * 1024u;
    const int aoff = lds_byte(wr * 64 + fr, fq * 8), boff = lds_byte(wc * 32 + fr, fq * 8);
#define PG8_SA(b, h) (((b) * 2 + (h)) * HTB)
#define PG8_SB(b, h) ((4 + (b) * 2 + (h)) * HTB)
#define PG8_STAGE_B(bufoff, gbase) do { _Pragma("unroll") for (int _i = 0; _i < 2; ++_i) \
        __builtin_amdgcn_global_load_lds((const unsigned*)((const char*)(gbase) + voffB[_i]), (PG8_LAS unsigned*)(lds + (bufoff) + ldsw + _i * 8192), 16, 0, 0); } while (0)
#define PG8_STAGE_A(bufoff, gbase, h, OFFS) do { const char* _gb = (const char*)(gbase) + (GATHER ? (size_t)0 : (size_t)(h) * hstep); \
        __builtin_amdgcn_global_load_lds((const unsigned*)(_gb + (GATHER ? OFFS[h][0] : OFFS[0][0])), (PG8_LAS unsigned*)(lds + (bufoff) + ldsw), 16, 0, 0); \
        __builtin_amdgcn_global_load_lds((const unsigned*)(_gb + (GATHER ? OFFS[h][1] : OFFS[0][1])), (PG8_LAS unsigned*)(lds + (bufoff) + ldsw + 8192), 16, 0, 0); } while (0)
#define PG8_LDA(dst, b, h) do { _Pragma("unroll") for (int m = 0; m < 4; ++m) _Pragma("unroll") for (int k = 0; k < 2; ++k) dst[m][k] = *(const PG8_LAS bf16x8*)(lds + PG8_SA(b, h) + aoff + m * 2048 + k * 1024); } while (0)
#define PG8_LDB(dst, b, h) do { _Pragma("unroll") for (int n = 0; n < 2; ++n) _Pragma("unroll") for (int k = 0; k < 2; ++k) dst[n][k] = *(const PG8_LAS bf16x8*)(lds + PG8_SB(b, h) + boff + n * 2048 + k * 1024); } while (0)
#define PG8_MMA(ai, bj, At, Bt) do { __builtin_amdgcn_s_setprio(1); _Pragma("unroll") for (int m = 0; m < 4; ++m) _Pragma("unroll") for (int n = 0; n < 2; ++n) _Pragma("unroll") for (int k = 0; k < 2; ++k) \
        acc[ai][bj][m][n] = __builtin_amdgcn_mfma_f32_16x16x32_bf16(Bt[n][k], At[m][k], acc[ai][bj][m][n], 0, 0, 0); __builtin_amdgcn_s_setprio(0); } while (0)
#define PG8_WAIT_V(n) asm volatile("s_waitcnt vmcnt(" #n ")" ::: "memory")
#define PG8_WAIT_L(n) asm volatile("s_waitcnt lgkmcnt(" #n ")" ::: "memory")
#define PG8_BAR __builtin_amdgcn_s_barrier()
#define PG8_SCHED __builtin_amdgcn_sched_barrier(0)
#define PG8_VA(dst, U) do { const int _tz = wid * 64 + lane_now(); _Pragma("unroll") for (int _i = 0; _i < 2; ++_i) { int _R, _C; stage_rc(_tz * 16 + _i * 8192, _R, _C); \
        _Pragma("unroll") for (int _h = 0; _h < 2; ++_h) { \
        if constexpr (GATHER) dst[_h][_i] = (unsigned)rowtok[(((U).aux & 255) << 14) + ((U).aux >> 8) * BM + _h * HALF + _R] * (unsigned)(K * 2) + (unsigned)(_C * 2); \
        else dst[_h][_i] = (unsigned)(_R * K + _C) * 2u; } } } while (0)
#define PG8_VA_LDS(dst) do { int _R, _C; stage_rc((wid * 64 + lane_now()) * 16, _R, _C); const PG8_LAS unsigned short* _rp = (const PG8_LAS unsigned short*)(lds + RTL_OFF) + _R;     \
        const unsigned _cb = (unsigned)(_C * 2), _ks = (unsigned)(K * 2); dst[0][0] = _rp[0] * _ks + _cb; dst[0][1] = _rp[64] * _ks + _cb; dst[1][0] = _rp[128] * _ks + _cb; dst[1][1] = _rp[192] * _ks + _cb; } while (0)
    Unit cur, nxt; int ui = 0;
    if (!S.next(0, cur)) return;
    f32x4 acc[2][2][4][2];
#pragma unroll
    for (int a = 0; a < 2; ++a)
#pragma unroll
        for (int b = 0; b < 2; ++b)
#pragma unroll
            for (int m = 0; m < 4; ++m)
#pragma unroll
                for (int n = 0; n < 2; ++n) acc[a][b][m][n] = (f32x4){0.f, 0.f, 0.f, 0.f};
    bf16x8 At[4][2], B0[2][2], B1[2][2];
    unsigned vaC[2][2], vaN[2][2];
    PG8_VA(vaC, cur);
    const char* cA = GATHER ? (const char*)g.A : (const char*)g.A + (size_t)cur.pm * tstep; const char* cB = (const char*)g.Bt + (size_t)cur.pn * tstep;
    PG8_STAGE_B(PG8_SB(0, 0), cB); PG8_STAGE_B(PG8_SB(0, 1), cB + bstep); PG8_STAGE_A(PG8_SA(0, 0), cA, 0, vaC); PG8_STAGE_A(PG8_SA(0, 1), cA, 1, vaC);
    if (wr == 1) PG8_BAR;
    PG8_WAIT_V(2); PG8_BAR;
    PG8_STAGE_B(PG8_SB(1, 0), cB + kstep); PG8_STAGE_A(PG8_SA(1, 0), cA + kstep, 0, vaC); PG8_STAGE_B(PG8_SB(1, 1), cB + bstep + kstep);
    PG8_WAIT_V(6); PG8_BAR;
    for (;;) {
        const bool has_next = S.next(ui + 1, nxt);
        const char* nA = GATHER ? (const char*)g.A : (has_next ? (const char*)g.A + (size_t)nxt.pm * tstep : cA); const char* nB = has_next ? (const char*)g.Bt + (size_t)nxt.pn * tstep : cB;
        if constexpr (GATHER) {
            if (has_next && wid < 2) __builtin_amdgcn_global_load_lds((const unsigned*)(rowtok + ((nxt.aux & 255) << 14) + (nxt.aux >> 8) * BM) + wid * 64 + lane_now(), (PG8_LAS unsigned*)(lds + RTL_OFF + wid * 256), 4, 0, 0); }
#pragma unroll
        for (int h = 0; h < 2; ++h)
#pragma unroll
            for (int i = 0; i < 2; ++i) vaN[h][i] = vaC[h][i];
#pragma nounroll
        for (int t = 0; t < nt; t += 2) {
            const bool last = (t == nt - 2);
            const char* a1 = cA + (size_t)(t + 1) * kstep;
            const char* a2 = last ? nA : cA + (size_t)(t + 2) * kstep; const char* b2 = last ? nB : cB + (size_t)(t + 2) * kstep;
            const char* a3 = a2 + kstep; const char* b3 = b2 + kstep;
            if constexpr (GATHER) { if (last && has_next) { PG8_VA_LDS(vaN); } }
            unsigned o2[2][2];
#pragma unroll
            for (int h = 0; h < 2; ++h)
#pragma unroll
                for (int i = 0; i < 2; ++i) o2[h][i] = (GATHER && last) ? vaN[h][i] : vaC[h][i];
            PG8_LDB(B0, 0, 0); PG8_LDB(B1, 0, 1); PG8_SCHED; PG8_LDA(At, 0, 0); PG8_STAGE_A(PG8_SA(1, 1), a1, 1, vaC);
            PG8_WAIT_V(8); PG8_WAIT_L(0); PG8_BAR; PG8_MMA(0, 0, At, B0); PG8_MMA(0, 1, At, B1); PG8_BAR; PG8_SCHED;
            PG8_LDA(At, 0, 1); PG8_STAGE_B(PG8_SB(0, 0), b2); PG8_STAGE_B(PG8_SB(0, 1), b2 + bstep); PG8_STAGE_A(PG8_SA(0, 0), a2, 0, o2);
            PG8_WAIT_V(8); PG8_WAIT_L(0); PG8_BAR; PG8_MMA(1, 0, At, B0); PG8_MMA(1, 1, At, B1); PG8_BAR; PG8_SCHED;
            PG8_LDB(B0, 1, 0); PG8_LDB(B1, 1, 1); PG8_SCHED; PG8_LDA(At, 1, 0); PG8_STAGE_A(PG8_SA(0, 1), a2, 1, o2);
            PG8_WAIT_V(8); PG8_WAIT_L(0); PG8_BAR; PG8_MMA(0, 0, At, B0); PG8_MMA(0, 1, At, B1); PG8_BAR; PG8_SCHED;
            PG8_LDA(At, 1, 1); PG8_STAGE_B(PG8_SB(1, 0), b3); PG8_STAGE_B(PG8_SB(1, 1), b3 + bstep); PG8_STAGE_A(PG8_SA(1, 0), a3, 0, o2);
            PG8_WAIT_V(8); PG8_WAIT_L(0); PG8_BAR; PG8_MMA(1, 0, At, B0); PG8_MMA(1, 1, At, B1); PG8_BAR; PG8_SCHED;
        }
        if constexpr (ALIGN_EPI) { if (wr == 0) PG8_BAR; }
        if constexpr (!Epi::AFTER_DRAIN) { E(acc, cur, wr, wc, fr, fq); }
        if (!has_next) break;
#pragma unroll
        for (int a = 0; a < 2; ++a)
#pragma unroll
            for (int b = 0; b < 2; ++b)
#pragma unroll
                for (int m = 0; m < 4; ++m)
#pragma unroll
                    for (int n = 0; n < 2; ++n) acc[a][b][m][n] = (f32x4){0.f, 0.f, 0.f, 0.f};
        cur = nxt; cA = nA; cB = nB; ++ui;
#pragma unroll
        for (int h = 0; h < 2; ++h)
#pragma unroll
            for (int i = 0; i < 2; ++i) vaC[h][i] = vaN[h][i];
        if constexpr (ALIGN_EPI) { if (wr == 1) PG8_BAR; }
    }
    PG8_WAIT_V(0);
    if constexpr (!ALIGN_EPI) { if (wr == 0) PG8_BAR; }
    PG8_BAR;
    if constexpr (Epi::AFTER_DRAIN) { E.fused(acc, cur, wr, wc, fr, fq, lds, wid, lane); }
#undef PG8_SA
#undef PG8_SB
#undef PG8_STAGE_A
#undef PG8_STAGE_B
#undef PG8_LDA
#undef PG8_LDB
#undef PG8_MMA
#undef PG8_WAIT_V
#undef PG8_WAIT_L
#undef PG8_BAR
#undef PG8_SCHED
#undef PG8_VA
#undef PG8_VA_LDS
}
}
constexpr int NWAVES = 8;
constexpr int NB = 2, SEQ = 16384, DM = 1024, NH = 8, HD = 128, NE = 64, TOPK = 8, FE = 256, DEPTH = 2;
constexpr int NTOK = NB * SEQ;
constexpr int HTOK = NTOK / 2;
constexpr int NSLOT = 9;
constexpr float LN_EPS = 1e-5f, ALPHA = 1.4142135623730951f, ATTN_SCALE = 0.08838834764831845f;
constexpr int MAXBLK = 640;

constexpr size_t MiB = 1u << 20;
constexpr size_t WS_CTL = 0, CTL_ZERO_BYTES = 72 * 1024;
constexpr size_t WS_MOD = 1 * MiB;
constexpr size_t WS_BSUM = WS_MOD + 128 * 1024;
constexpr size_t WS_ROUTE = 3 * MiB;
constexpr size_t WS_IDX = WS_ROUTE, WS_GATE = WS_ROUTE + 1 * MiB;
constexpr size_t ROWS_HALF = (size_t)MAXBLK * 256;
constexpr size_t WS_ROWTOK = WS_ROUTE + 2 * MiB, WS_SLOTOF = WS_ROWTOK + 2 * ROWS_HALF * 4  , WS_BLKEXP = WS_SLOTOF + 1 * MiB + 512 * 1024;
constexpr size_t WS_ROWTOK2 = 10 * MiB;
constexpr size_t WS_AUX = 10 * MiB;
constexpr size_t WS_LOGF = WS_AUX, WS_F = WS_AUX + 1 * MiB, WS_KAUG = WS_AUX + 2 * MiB;
constexpr size_t WS_WATT = 16 * MiB, WATT_STRIDE = 9 * MiB;
constexpr size_t WATT_O = 6 * MiB, WATT_R = 8 * MiB;
constexpr size_t WS_WMOE0 = 34 * MiB, WS_WMOE1 = 500 * MiB, WMOE_D = 65 * MiB;
constexpr size_t WS_H = 132 * MiB;
constexpr size_t WS_BIG = 196 * MiB;
constexpr size_t WS_Q = WS_BIG, WS_K = WS_BIG + 64 * MiB, WS_V = WS_BIG + 128 * MiB, WS_O = WS_H, WS_Y = WS_Q;
constexpr size_t WS_ACT = WS_BIG, WS_YR = WS_BIG + 80 * MiB;
constexpr size_t WS_XB = 436 * MiB;
static_assert(WS_YR + (size_t)MAXBLK * 256 * 1024 <= WS_XB && WS_V + 64 * MiB <= WS_XB && WS_XB + 64 * MiB <= WS_WMOE1 && WS_WMOE0 + 98 * MiB <= WS_H && WS_WATT + 2 * WATT_STRIDE <= WS_WMOE0, "d_ws map (1)");
constexpr size_t WS_END = WS_WMOE1 + WMOE_D + (size_t)65 * 1024 * 256 * 2;
static_assert(WS_ROWTOK2 + (size_t)2 * 65 * 16384 * 2 <= WS_WATT && WS_V - WS_K == WS_K - WS_Q && WS_BLKEXP + 4 * MAXBLK * 4 + 64 <= WS_AUX && WS_SLOTOF + (size_t)NTOK * 8 * 4 <= WS_BLKEXP && WS_END <= (size_t)598 * MiB, "d_ws map");
constexpr int CW_BAR = 4096;
constexpr int CW_CNT = 8192;
constexpr int CW_CUR = 8192 + 256;
constexpr int CW_CONVQ = 12288;
static_assert((16384 + 64) * 4 <= 72 * 1024, "control words inside the zeroed range");
constexpr int CW_FOXQ = 16384;

constexpr int RING_OFF = 0, RING_BYTES = 131072;
constexpr int LDSCTL_OFF = RING_BYTES, MISC_OFF = LDSCTL_OFF + 320;
static_assert(pg8::RTL_OFF == LDSCTL_OFF + 8192, "LDS map");
constexpr int BT_OFF = LDSCTL_OFF + 9216;
constexpr int BBL_OFF = BT_OFF + 2 * MAXBLK * 4;
static_assert(BBL_OFF + 2 * 68 * 4 <= 147456, "LDS map (2)");
constexpr int LDS_BYTES = 147456;

#define GAS __attribute__((address_space(1)))
#define LAS __attribute__((address_space(3)))
typedef unsigned short bf16;
typedef unsigned v4u __attribute__((ext_vector_type(4)));
typedef float f32x4 __attribute__((ext_vector_type(4)));
#define LDS_WAIT() asm volatile("s_waitcnt lgkmcnt(0)" ::: "memory")
#define VM_WAIT() asm volatile("s_waitcnt vmcnt(0)" ::: "memory")
__device__ __forceinline__ unsigned f2bf(float f) { unsigned u = __builtin_bit_cast(unsigned, f); return (u + 0x7fffu + ((u >> 16) & 1u)) >> 16; }
__device__ __forceinline__ unsigned pk2(float lo, float hi) { return f2bf(lo) | (f2bf(hi) << 16); }
__device__ __forceinline__ float bflo(unsigned w) { return __builtin_bit_cast(float, w << 16); }
__device__ __forceinline__ float bfhi(unsigned w) { return __builtin_bit_cast(float, w & 0xffff0000u); }

#define XB_TMO      128
#define XB_XCNT(j)  (256  + 64 * (j))
#define XB_XSUB(j)  (1280 + 64 * (j))
#define XB_XGEN(j)  (2304 + 64 * (j))
#define XB_TOP      3328
#define XB_TOPGEN   3392
#define XCD_BAR_WORDS 3456
#define XB_SPIN_CAP (1u << 26)

__device__ __forceinline__ unsigned xb_ld(unsigned* p)              { return __hip_atomic_load(p, __ATOMIC_RELAXED, __HIP_MEMORY_SCOPE_AGENT); }
__device__ __forceinline__ unsigned xb_add(unsigned* p, unsigned v) { return __hip_atomic_fetch_add(p, v, __ATOMIC_RELAXED, __HIP_MEMORY_SCOPE_AGENT); }
__device__ __forceinline__ unsigned xb_xcc_id() { return (unsigned)__builtin_amdgcn_s_getreg((3 << 11) | 20) & 0xFu; }
#define XB_SPIN(cond, bar) do { unsigned _sp = 0; while (cond) { __builtin_amdgcn_s_sleep(1); \
    if ((++_sp & 255u) == 0u) { if (xb_ld(&(bar)[XB_TMO])) break; if (_sp > XB_SPIN_CAP) { atomicAdd(&(bar)[XB_TMO], 1u); break; } } } } while (0)

struct XcdBarrier {
    unsigned* bar; unsigned x; int wave;
    volatile LAS unsigned* st;
};
__device__ __forceinline__ XcdBarrier xcd_barrier_post(unsigned* bar, volatile LAS unsigned* st, int wave) {
    XcdBarrier b; b.bar = bar; b.x = xb_xcc_id(); b.st = st; b.wave = wave;
    if (wave == 0 && lane_now() == 0) (void)xb_add(&bar[XB_XCNT(b.x)], 1u);
    return b;
}
__device__ __forceinline__ void xcd_barrier_complete(unsigned* bar, unsigned x, unsigned& nloc, unsigned& nx) {
    const unsigned G = gridDim.x * gridDim.y * gridDim.z;
    unsigned sum, cnt, mine, sp = 0u;
    for (;;) {
        sum = 0u; cnt = 0u; mine = 0u;
#pragma unroll
        for (unsigned j = 0; j < 16; ++j) { const unsigned c = xb_ld(&bar[XB_XCNT(j)]); sum += c; cnt += (c > 0u) ? 1u : 0u; mine = (j == x) ? c : mine; }
        if (sum == G) break;
        __builtin_amdgcn_s_sleep(1);
        if ((++sp & 255u) == 0u) { if (xb_ld(&bar[XB_TMO])) break; if (sp > XB_SPIN_CAP) { atomicAdd(&bar[XB_TMO], 1u); break; } }
    }
    nloc = mine > 0u ? mine : 1u; nx = cnt > 0u ? cnt : 1u;
}
__device__ __forceinline__ void xcd_barrier(const XcdBarrier& b) {
    asm volatile("s_waitcnt vmcnt(0)" ::: "memory");
    __syncthreads();
    if (b.wave == 0 && lane_now() == 0) {
        unsigned* bar = b.bar;
        __builtin_amdgcn_s_waitcnt(0);
        unsigned nloc = b.st[0], nx = b.st[1];
        if (nloc == 0u) { xcd_barrier_complete(bar, b.x, nloc, nx); b.st[0] = nloc; b.st[1] = nx; }
        const unsigned old = xb_add(&bar[XB_XSUB(b.x)], 1u);
        const unsigned gen = old / nloc;
        if (old == gen * nloc) asm volatile("buffer_wbl2 sc1" ::: "memory");
        if (old + 1u == (gen + 1u) * nloc) {
            __builtin_amdgcn_fence(__ATOMIC_RELEASE, "agent");
            asm volatile("s_waitcnt vmcnt(0)" ::: "memory");
            const unsigned og = xb_add(&bar[XB_TOP], 1u);
            const unsigned tg = og / nx;
            if (og + 1u == (tg + 1u) * nx) xb_add(&bar[XB_TOPGEN], 1u);
            else XB_SPIN(xb_ld(&bar[XB_TOPGEN]) == tg, bar);
            __builtin_amdgcn_fence(__ATOMIC_ACQUIRE, "agent");
            xb_add(&bar[XB_XGEN(b.x)], 1u);
            asm volatile("s_waitcnt vmcnt(0)" ::: "memory");
        } else {
            XB_SPIN(xb_ld(&bar[XB_XGEN(b.x)]) == gen, bar);
            __builtin_amdgcn_fence(__ATOMIC_ACQUIRE, "agent");
            asm volatile("s_waitcnt vmcnt(0)" ::: "memory");
        }
    }
    __syncthreads();
}

__device__ __forceinline__ float wave_sum(float v, int lane) {
#pragma unroll
    for (int o = 1; o < 64; o <<= 1) v += __builtin_bit_cast(float, __builtin_amdgcn_ds_bpermute((lane ^ o) << 2, __builtin_bit_cast(int, v)));
    return v;
}
__device__ __forceinline__ float logsig(float z) { return fminf(z, 0.f) - log1pf(__expf(-fabsf(z))); }
__device__ __forceinline__ void ld8f_nt(const float* p, float (&v)[8]) { const f32x4 a = __builtin_nontemporal_load((const f32x4*)p), b = __builtin_nontemporal_load((const f32x4*)(p + 4)); v[0] = a.x; v[1] = a.y; v[2] = a.z; v[3] = a.w; v[4] = b.x; v[5] = b.y; v[6] = b.z; v[7] = b.w; }
__device__ __forceinline__ void ld8f(const float* p, float (&v)[8]) { const f32x4 a = *(const f32x4*)p, b = *(const f32x4*)(p + 4); v[0] = a.x; v[1] = a.y; v[2] = a.z; v[3] = a.w; v[4] = b.x; v[5] = b.y; v[6] = b.z; v[7] = b.w; }
__device__ __forceinline__ void st8f(float* p, const float (&v)[8]) { *(f32x4*)p = (f32x4){v[0], v[1], v[2], v[3]}; *(f32x4*)(p + 4) = (f32x4){v[4], v[5], v[6], v[7]}; }
__device__ __forceinline__ void ld8bf(const bf16* p, float (&v)[8]) { const v4u w = *(const v4u*)p; v[0] = bflo(w.x); v[1] = bfhi(w.x); v[2] = bflo(w.y); v[3] = bfhi(w.y); v[4] = bflo(w.z); v[5] = bfhi(w.z); v[6] = bflo(w.w); v[7] = bfhi(w.w); }
__device__ __forceinline__ void st8bf(bf16* p, const float (&v)[8]) { v4u w; w.x = pk2(v[0], v[1]); w.y = pk2(v[2], v[3]); w.z = pk2(v[4], v[5]); w.w = pk2(v[6], v[7]); *(v4u*)p = w; }

__device__ __forceinline__ void transpose_item(const float* W, int ldw, int k0, int n0, bf16* WT, int Kd, int drow, int lo, LAS unsigned short* scr, int lane) {
    constexpr int KP = 72;
    const int nq = (lane & 15) * 4, kr = lane >> 4;
    f32x4 vv[16];
#pragma unroll
    for (int i = 0; i < 16; ++i) vv[i] = __builtin_nontemporal_load((const f32x4*)(W + (size_t)(k0 + 4 * i + kr) * ldw + n0 + nq));
#pragma unroll
    for (int i = 0; i < 16; ++i) { const int k = 4 * i + kr; f32x4 v = vv[i];
        if (lo) { v.x -= __builtin_bit_cast(float, f2bf(v.x) << 16); v.y -= __builtin_bit_cast(float, f2bf(v.y) << 16); v.z -= __builtin_bit_cast(float, f2bf(v.z) << 16); v.w -= __builtin_bit_cast(float, f2bf(v.w) << 16); }
        scr[(nq + 0) * KP + k] = (unsigned short)f2bf(v.x); scr[(nq + 1) * KP + k] = (unsigned short)f2bf(v.y); scr[(nq + 2) * KP + k] = (unsigned short)f2bf(v.z); scr[(nq + 3) * KP + k] = (unsigned short)f2bf(v.w); }
    LDS_WAIT(); asm volatile("" ::: "memory");
    const int c = lane & 7;
#pragma unroll
    for (int j = 0; j < 8; ++j) { const int n = (lane >> 3) + 8 * j; const v4u o = *(const LAS v4u*)(scr + n * KP + 8 * c);
        __builtin_nontemporal_store(o, (v4u*)(WT + (size_t)(drow + n) * Kd + k0 + 8 * c)); }
    LDS_WAIT(); asm volatile("" ::: "memory");
}
namespace fox {
constexpr int D = 128;
constexpr float THR = 8.f;
constexpr bool WSKIP = false;
constexpr float SCALE = 0.08838834764831845f;
constexpr int NW = 8, QBLK = 32, KVBLK = 64, QB = NW * QBLK;
constexpr int SHM_V = KVBLK * D * 2, SHM_K = KVBLK * D * 2;
constexpr int SHM_KA = KVBLK * 16;
constexpr int KA_OFF = 2 * SHM_V + 2 * SHM_K + NW * 64 * 4;
constexpr int LDS_BYTES = KA_OFF + 2 * SHM_KA;
constexpr int OSTR = 1024;
typedef unsigned short bf16;
typedef short bf16x8 __attribute__((ext_vector_type(8)));
typedef short s16x4 __attribute__((ext_vector_type(4)));
typedef float f32x16 __attribute__((ext_vector_type(16)));
typedef float f32x4 __attribute__((ext_vector_type(4)));
typedef unsigned u32x4 __attribute__((ext_vector_type(4)));
template <class A, class Bt> struct same_t { static constexpr bool v = false; };
template <class A> struct same_t<A, A> { static constexpr bool v = true; };
#define KSWZ(row, colB) ((row) * 256 + ((colB) ^ (((row) & 7) << 4)))
#define SBAR() __builtin_amdgcn_sched_barrier(0)
__device__ __forceinline__ int v_st(int k, int c) { const int kk = (k & ~0xC) | ((k & 4) << 1) | ((k & 8) >> 1); return ((kk >> 3) * 4 + (c >> 5)) * 512 + ((kk & 7) * 32 + (c & 31)) * 2; }
__device__ __forceinline__ int v_rd_base(int lane) { return ((lane & 3) << 3) | (((lane >> 2) & 3) << 6) | (((lane >> 4) & 1) << 5) | (((lane >> 5) & 1) << 8); }
constexpr int v_rd_off(int d0, int ks, int half) { return d0 * 512 + ks * 4096 + half * 2048; }
__device__ __forceinline__ int crow(int r, int hi) { return (r & 3) + 8 * (r >> 2) + 4 * hi; }
__device__ __forceinline__ unsigned cvtpk(float lo, float hi) {
    unsigned r; asm volatile("v_cvt_pk_bf16_f32 %0, %1, %2" : "=v"(r) : "v"(lo), "v"(hi)); return r;
}
__device__ __forceinline__ bf16x8 pack8(f32x4 a, f32x4 b) {
    u32x4 w = {cvtpk(a[0], a[1]), cvtpk(a[2], a[3]), cvtpk(b[0], b[1]), cvtpk(b[2], b[3])};
    return *reinterpret_cast<bf16x8*>(&w);
}
template <class T> __device__ __forceinline__ bf16x8 load8(const T* p) {
    if constexpr (same_t<T, float>::v) { return pack8(*(const f32x4*)p, *(const f32x4*)(p + 4)); }
    else { return *reinterpret_cast<const bf16x8*>(p); }
}
__device__ __forceinline__ void mask_tile(f32x16& p0, f32x16& p1, int dq, unsigned W) {
    const float NEG = -__builtin_inff();
#pragma unroll
    for (int r = 0; r < 16; ++r) {
        const int c = (r & 3) + 8 * (r >> 2);
        if ((unsigned)(dq - c) >= W) p0[r] = NEG;
        if ((unsigned)(dq - c - 32) >= W) p1[r] = NEG;
    }
}
__device__ __forceinline__ void partialSM(f32x16& p0, f32x16& p1, float& m_reg, float& mn, float& alpha) {
    float pmax = p0[0]; for (int r = 1; r < 16; ++r) pmax = fmaxf(pmax, p0[r]); for (int r = 0; r < 16; ++r) pmax = fmaxf(pmax, p1[r]);
    { unsigned pb_ = __float_as_uint(pmax); asm volatile("" : "+v"(pb_));
      auto rr = __builtin_amdgcn_permlane32_swap(__float_as_uint(pmax), pb_, false, false);
      pmax = fmaxf(__uint_as_float(rr[0]), __uint_as_float(rr[1])); }
    constexpr float C2 = 1.4426950408889634f * SCALE;
    if (__builtin_expect(__all((pmax - m_reg) * SCALE <= THR), 1)) { mn = m_reg; alpha = 1.f; }
    else { mn = fmaxf(m_reg, pmax); alpha = __builtin_amdgcn_exp2f((m_reg - mn) * C2); m_reg = mn; }
    const float mnL = -mn * C2;
    for (int r = 0; r < 16; ++r) p0[r] = fmaf(p0[r], C2, mnL); for (int r = 0; r < 16; ++r) p1[r] = fmaf(p1[r], C2, mnL);
    for (int r = 0; r < 16; ++r) p0[r] = __builtin_amdgcn_exp2f(p0[r]);
}
__device__ __forceinline__ void finishSM(f32x16& p0, f32x16& p1, float alpha, float& l_reg, bf16x8& pa0, bf16x8& pa1, bf16x8& pa2, bf16x8& pa3) {
    for (int r = 0; r < 16; ++r) p1[r] = __builtin_amdgcn_exp2f(p1[r]);
    float ps = 0; for (int r = 0; r < 16; ++r) ps += p0[r]; for (int r = 0; r < 16; ++r) ps += p1[r];
    { unsigned pb_ = __float_as_uint(ps); asm volatile("" : "+v"(pb_));
      auto rr = __builtin_amdgcn_permlane32_swap(__float_as_uint(ps), pb_, false, false);
      ps = __uint_as_float(rr[0]) + __uint_as_float(rr[1]); }
    l_reg = l_reg * alpha + ps;
#define PK4(P, B_, OUT) do { unsigned a0 = cvtpk(P[B_+0], P[B_+1]), a1 = cvtpk(P[B_+2], P[B_+3]);                          \
        unsigned b0 = cvtpk(P[B_+4], P[B_+5]), b1 = cvtpk(P[B_+6], P[B_+7]);                                             \
        auto r0 = __builtin_amdgcn_permlane32_swap(a0, b0, false, false); auto r1 = __builtin_amdgcn_permlane32_swap(a1, b1, false, false); \
        u32x4 w = {r0[0], r1[0], r0[1], r1[1]}; OUT = *reinterpret_cast<bf16x8*>(&w); } while (0)
    PK4(p0, 0, pa0); PK4(p0, 8, pa1); PK4(p1, 0, pa2); PK4(p1, 8, pa3);
#undef PK4
}
template <int KB, bool SK, bool BIAS = true>
__device__ __forceinline__ void qkt(f32x16& p0, f32x16& p1, const char* K_lds, int r32, int hi, const bf16x8* qr, bool act) {
    if (SK && !act) { const float NEG = -__builtin_inff();
#pragma unroll
        for (int r = 0; r < 16; ++r) { p0[r] = NEG; p1[r] = NEG; } return; }
    if constexpr (!BIAS) { p0 = f32x16{}; p1 = f32x16{}; } else
    {
        const char* ka = K_lds + (KA_OFF - 2 * SHM_V) + KB * SHM_KA; int hz = hi; asm volatile("" : "+v"(hz));
        const short one = hz ? (short)0 : (short)0x3F80;
        const bf16x8 qa = {one, one, one, 0, 0, 0, 0, 0};
        p0 = __builtin_amdgcn_mfma_f32_32x32x16_bf16(*reinterpret_cast<const bf16x8*>(ka + r32 * 16), qa, f32x16{}, 0, 0, 0);
        p1 = __builtin_amdgcn_mfma_f32_32x32x16_bf16(*reinterpret_cast<const bf16x8*>(ka + (32 + r32) * 16), qa, f32x16{}, 0, 0, 0); }
    const char* kb[4];
#pragma unroll
    for (int dd = 0; dd < 4; ++dd) kb[dd] = K_lds + KB * SHM_K + KSWZ(r32, (dd * 16 + hi * 8) * 2);
#pragma unroll
    for (int d0 = 0; d0 < 8; ++d0) { const char* a = kb[d0 & 3] + (d0 >> 2) * 128;
        bf16x8 b0 = *reinterpret_cast<const bf16x8*>(a);
        bf16x8 b1 = *reinterpret_cast<const bf16x8*>(a + 32 * 256);
        p0 = __builtin_amdgcn_mfma_f32_32x32x16_bf16(b0, qr[d0], p0, 0, 0, 0);
        p1 = __builtin_amdgcn_mfma_f32_32x32x16_bf16(b1, qr[d0], p1, 0, 0, 0); }

}
template <int VB, bool SK>
__device__ __forceinline__ void pv_tile(f32x16* o, int vb0, bf16x8 pa0, bf16x8 pa1, bf16x8 pa2, bf16x8 pa3, bool act) {
    if (SK && !act) return;
#define TRRD(dst, off) asm volatile("ds_read_b64_tr_b16 %0, %1 offset:%2" : "=&v"(dst) : "v"(vb0), "i"(off) : "memory")
#define PV_D0(d0) do { s16x4 l0, l1, l2, l3, h0, h1, h2, h3; constexpr int b_ = VB * SHM_V + v_rd_off(d0, 0, 0);     \
        TRRD(l0, b_); TRRD(h0, b_ + 2048); TRRD(l1, b_ + 4096); TRRD(h1, b_ + 6144); TRRD(l2, b_ + 8192); TRRD(h2, b_ + 10240); TRRD(l3, b_ + 12288); TRRD(h3, b_ + 14336); \
        asm volatile("s_waitcnt lgkmcnt(0)" ::: "memory"); SBAR();                 \
        o[d0] = __builtin_amdgcn_mfma_f32_32x32x16_bf16(pa0, (bf16x8){l0[0], l0[1], l0[2], l0[3], h0[0], h0[1], h0[2], h0[3]}, o[d0], 0, 0, 0);   \
        o[d0] = __builtin_amdgcn_mfma_f32_32x32x16_bf16(pa1, (bf16x8){l1[0], l1[1], l1[2], l1[3], h1[0], h1[1], h1[2], h1[3]}, o[d0], 0, 0, 0);   \
        o[d0] = __builtin_amdgcn_mfma_f32_32x32x16_bf16(pa2, (bf16x8){l2[0], l2[1], l2[2], l2[3], h2[0], h2[1], h2[2], h2[3]}, o[d0], 0, 0, 0);   \
        o[d0] = __builtin_amdgcn_mfma_f32_32x32x16_bf16(pa3, (bf16x8){l3[0], l3[1], l3[2], l3[3], h3[0], h3[1], h3[2], h3[3]}, o[d0], 0, 0, 0); } while (0)
    PV_D0(0); PV_D0(1); PV_D0(2); PV_D0(3);
#undef PV_D0
#undef TRRD
}

template <class TIn, class TOut> struct BlockRef { const TIn* Q; const TIn* K; const TIn* V; const TIn* KA; TOut* O; int P0; int JLO; };
template <class TIn> struct Seam {
    bf16x8 qr[8];
    bf16x8 st_v0, st_v1, st_k0, st_k1; f32x4 sf0, sf1, sf2, sf3;
    f32x4 tq[16];
};
__device__ __forceinline__ int swa_jlo(int P0, int W) { const int lowk = P0 - W + 1; return lowk > 0 ? lowk / KVBLK : 0; }
#define ROW(p, k0, rr) ((p) + (size_t)((k0) + (rr)) * D + sc)
#define VMW() asm volatile("s_waitcnt vmcnt(0)" ::: "memory")
#define VMWN(n) asm volatile("s_waitcnt vmcnt(%0)" :: "i"(n) : "memory")
#define SLOAD_H(Kp, Vp, KAp, k0, KABUF) do { S.st_v0 = load8<TIn>(ROW(Vp, k0, sr)); S.st_v1 = load8<TIn>(ROW(Vp, k0, 32 + sr));              \
                         S.st_k0 = load8<TIn>(ROW(Kp, k0, sr)); S.st_k1 = load8<TIn>(ROW(Kp, k0, 32 + sr));              \
                         if (wid == 0) __builtin_amdgcn_global_load_lds((const unsigned*)((KAp) + (size_t)((k0) + lane) * 8), (__attribute__((address_space(3))) unsigned*)(K_lds + (KA_OFF - 2 * SHM_V) + (KABUF) * SHM_KA), 16, 0, 0); } while (0)
#define SWRITE_HK(bf) do { *(bf16x8*)(K_lds + (bf) * SHM_K + kws) = S.st_k0; *(bf16x8*)(K_lds + (bf) * SHM_K + kws + 32 * 256) = S.st_k1; \
                        } while (0)
#define SWRITE_HV(bf) do { *(bf16x8*)(V_lds + (bf) * SHM_V + vst0) = S.st_v0; *(bf16x8*)(V_lds + (bf) * SHM_V + vst0 + 8192) = S.st_v1; } while (0)
#define SWRITE_H(bf) do { SWRITE_HV(bf); SWRITE_HK(bf); } while (0)
#define SLOAD_F(p, k0) do { S.sf0 = *(const f32x4*)ROW(p, k0, sr); S.sf1 = *(const f32x4*)(ROW(p, k0, sr) + 4);                \
                            S.sf2 = *(const f32x4*)ROW(p, k0, 32 + sr); S.sf3 = *(const f32x4*)(ROW(p, k0, 32 + sr) + 4); } while (0)
#define SWRITE_KF(bf) do { *(bf16x8*)(K_lds + (bf) * SHM_K + kws) = pack8(S.sf0, S.sf1); *(bf16x8*)(K_lds + (bf) * SHM_K + kws + 32 * 256) = pack8(S.sf2, S.sf3); } while (0)
#define SWRITE_VF(bf) do { *(bf16x8*)(V_lds + (bf) * SHM_V + vst0) = pack8(S.sf0, S.sf1); *(bf16x8*)(V_lds + (bf) * SHM_V + vst0 + 8192) = pack8(S.sf2, S.sf3); } while (0)
template <class TIn, class TOut>
__device__ __forceinline__ void causal_swa_prime(const BlockRef<TIn, TOut>& cur, int W, char* lds, Seam<TIn>& S, int wv) {
    constexpr bool F32 = same_t<TIn, float>::v;
    const int wid = wv, lane = lane_now(), tid = wid * 64 + lane, r32 = lane & 31, hi = lane >> 5;
    const int sr = tid >> 4, sc = (tid & 15) * 8, kws = KSWZ(sr, sc * 2); char* K_lds = lds + 2 * SHM_V;
    const int kb0 = cur.JLO * KVBLK; (void)W;
    for (int d0 = 0; d0 < 8; ++d0) S.qr[d0] = load8<TIn>(cur.Q + (size_t)(wid * QBLK + r32) * D + d0 * 16 + hi * 8);
    if constexpr (F32) { SLOAD_F((const float*)cur.K, kb0); VMW(); SWRITE_KF(0); SBAR(); SLOAD_F((const float*)cur.V, kb0); }
    else { SLOAD_H(cur.K, cur.V, cur.KA, kb0, 0); VMW(); SWRITE_HK(0); }
    __syncthreads();
}
template <class TIn, class TOut>
__device__ __forceinline__ void causal_swa_block(const BlockRef<TIn, TOut>& cur, const BlockRef<TIn, TOut>& nxt, int skv, int W, char* lds, Seam<TIn>& S, int wv) {
    constexpr bool F32 = same_t<TIn, float>::v;
    const int wid = wv, lane = lane_now(), tid = wid * 64 + lane, r32 = lane & 31, hi = lane >> 5;
    const int j_lo = cur.JLO;
    int j_hi = (cur.P0 + QB - 1) / KVBLK + 1; if (j_hi > skv / KVBLK) j_hi = skv / KVBLK;
    const int NT = j_hi - j_lo;
    const int kbn = nxt.JLO * KVBLK;
    const int qlo = cur.P0 + wid * QBLK, qm = qlo + r32 - 4 * hi;
    char* V_lds = lds; char* K_lds = lds + 2 * SHM_V;
    float* ws = (float*)(lds + 2 * SHM_V + 2 * SHM_K) + wid * 64; float* li_l = ws, * al_l = ws + 32;
    float m_reg = -1e30f, l_reg = 0; f32x16 o[4] = {};
    const int sr = tid >> 4, sc = (tid & 15) * 8, vst0 = v_st(sr, sc)  , kws = KSWZ(sr, sc * 2);
    const int vb0 = (int)(uintptr_t)V_lds + v_rd_base(lane);
    const TIn* Kh = cur.K; const TIn* Vh = cur.V; const TIn* KAh = cur.KA;
#define RESC(a) do { if (__any((a) < 1.f)) { if (hi == 0) al_l[r32] = (a); asm volatile("s_waitcnt lgkmcnt(0)" ::: "memory");              \
                     for (int d_ = 0; d_ < 4; ++d_) for (int r = 0; r < 16; ++r) o[d_][r] *= al_l[crow(r, hi)]; } } while (0)
#define KBASE(t) ((j_lo + (t)) * KVBLK)
#define ACT(t) (KBASE(t) <= qlo + QBLK - 1 && KBASE(t) + KVBLK - 1 >= qlo - W + 1)
#define MASKT(P0_, P1_, t) do { const int kb_ = KBASE(t); if ((!SK || ACT(t)) && (kb_ + KVBLK - 1 > qlo || kb_ <= qlo + QBLK - 1 - W)) mask_tile(P0_, P1_, qm - kb_, (unsigned)W); } while (0)
    constexpr int NQL = F32 ? 16 : 8;
    constexpr bool SK = WSKIP && !F32;
#define SEAM_K0() do { VMWN(NQL); if constexpr (F32) { SWRITE_KF(0); SBAR(); SLOAD_F((const float*)nxt.V, kbn); } else { SWRITE_HK(0); } SBAR(); } while (0)
    f32x16 pA0, pA1, pB0, pB1; float mnA, mnB, alA, alB; bf16x8 pa0, pa1, pa2, pa3;
    if constexpr (F32) { VMW(); SWRITE_VF(0); SBAR(); } else { SWRITE_HV(0); SBAR(); }
    if (NT > 1) { if constexpr (F32) SLOAD_F((const float*)Kh, KBASE(1)); else SLOAD_H(Kh, Vh, KAh, KBASE(1), 1); }
    SBAR(); qkt<0, SK>(pA0, pA1, K_lds, r32, hi, S.qr, ACT(0));
    if constexpr (F32) { if (NT > 1) { VMW(); SWRITE_KF(1); SBAR(); SLOAD_F((const float*)Vh, KBASE(1)); } }
    MASKT(pA0, pA1, 0); partialSM(pA0, pA1, m_reg, mnA, alA);
    if (NT > 1) { VMW(); if constexpr (F32) { SWRITE_VF(1); SBAR(); if (NT > 2) SLOAD_F((const float*)Kh, KBASE(2)); } else SWRITE_H(1); }
    __syncthreads();
#define HALF_STEP(PX0, PX1, mnX, alX, PY0, PY1, alY, t, KB, VB, SB) do {                                                      \
        SBAR(); qkt<KB, SK>(PX0, PX1, K_lds, r32, hi, S.qr, ACT(t));                                             \
        finishSM(PY0, PY1, alY, l_reg, pa0, pa1, pa2, pa3); SBAR();                                                           \
        if ((t) + 1 < NT) { if constexpr (F32) { VMW(); SWRITE_KF(SB); SBAR(); SLOAD_F((const float*)Vh, KBASE((t) + 1)); }  \
                            else { SLOAD_H(Kh, Vh, KAh, KBASE((t) + 1), SB); } SBAR(); }                                               \
        pv_tile<VB, SK>(o, vb0, pa0, pa1, pa2, pa3, ACT((t) - 1)); MASKT(PX0, PX1, (t)); partialSM(PX0, PX1, m_reg, mnX, alX);                                        \
        __syncthreads();                                                                                                      \
        if ((t) + 1 < NT) { VMW(); if constexpr (F32) { SWRITE_VF(SB); SBAR(); if ((t) + 2 < NT) SLOAD_F((const float*)Kh, KBASE((t) + 2)); } \
                            else { SWRITE_H(SB); } }                                                                          \
        RESC(alX); __syncthreads(); } while (0)
    for (int t = 1; t + 1 < NT; t += 2) {
        HALF_STEP(pB0, pB1, mnB, alB, pA0, pA1, alA, t, 1, 0, 0);
        HALF_STEP(pA0, pA1, mnA, alA, pB0, pB1, alB, t + 1, 0, 1, 1);
    }
    const bool even = (NT & 1) == 0;
    if (even) { SBAR(); qkt<1, SK>(pB0, pB1, K_lds, r32, hi, S.qr, ACT(NT - 1)); SBAR(); }
#define QROW(e) (nxt.Q + (size_t)(wid * QBLK + r32) * D + ((e) >> 1) * 16 + hi * 8 + ((e) & 1) * 4)
    if constexpr (F32) { SLOAD_F((const float*)nxt.K, kbn); SBAR();
#pragma unroll
        for (int e = 0; e < 8; ++e) S.tq[e] = *(const f32x4*)QROW(e); }
    else { SLOAD_H(nxt.K, nxt.V, nxt.KA, kbn, 0); SBAR();
#pragma unroll
        for (int d0 = 0; d0 < 8; ++d0) S.qr[d0] = load8<TIn>(nxt.Q + (size_t)(wid * QBLK + r32) * D + d0 * 16 + hi * 8); }
    SBAR();
    finishSM(pA0, pA1, alA, l_reg, pa0, pa1, pa2, pa3); SBAR();
    if constexpr (F32) {
#pragma unroll
        for (int e = 8; e < 16; ++e) S.tq[e] = *(const f32x4*)QROW(e); SBAR(); }
#undef QROW
    pv_tile<0, SK>(o, vb0, pa0, pa1, pa2, pa3, ACT(even ? NT - 2 : NT - 1));
    if (even) { MASKT(pB0, pB1, NT - 1); partialSM(pB0, pB1, m_reg, mnB, alB); __syncthreads(); RESC(alB);
        finishSM(pB0, pB1, alB, l_reg, pa0, pa1, pa2, pa3); SBAR(); pv_tile<1, SK>(o, vb0, pa0, pa1, pa2, pa3, ACT(NT - 1)); }
    SBAR(); SEAM_K0();
    if (hi == 0) li_l[r32] = l_reg; asm volatile("s_waitcnt lgkmcnt(0)" ::: "memory");
    float rli[16];
#pragma unroll
    for (int r = 0; r < 16; ++r) rli[r] = __builtin_amdgcn_rcpf(li_l[crow(r, hi)]);
    TOut* Ow = cur.O + (size_t)(wid * QBLK) * OSTR;
#pragma unroll
    for (int r = 0; r < 16; ++r) { const int orow = crow(r, hi);
#pragma unroll
        for (int d0 = 0; d0 < 4; ++d0) { const float v = o[d0][r] * rli[r];
            if constexpr (same_t<TOut, float>::v) { Ow[(size_t)orow * OSTR + d0 * 32 + r32] = v; }
            else { const float vn = __builtin_bit_cast(float, __builtin_amdgcn_ds_bpermute((lane ^ 1) << 2, __builtin_bit_cast(int, v)));
                   if ((r32 & 1) == 0) *(unsigned*)(Ow + (size_t)orow * OSTR + d0 * 32 + r32) = cvtpk(v, vn); } } }
    if constexpr (F32) {
#pragma unroll
        for (int d0 = 0; d0 < 8; ++d0) S.qr[d0] = pack8(S.tq[2 * d0], S.tq[2 * d0 + 1]); }
    __syncthreads();
#undef RESC
#undef KBASE
#undef ACT
#undef MASKT
#undef SEAM_K0
#undef HALF_STEP
}
#undef ROW
#undef VMW
#undef VMWN
#undef SLOAD_H
#undef SWRITE_HK
#undef SWRITE_HV
#undef SWRITE_H
#undef SLOAD_F
#undef SWRITE_KF
#undef SWRITE_VF

typedef BlockRef<bf16, bf16> BR;
__device__ __forceinline__ float fox_gmax(const bf16* Q, const bf16* K, const float* F, const unsigned* nrm, int item, char* lds, int wv) {
    const int qb = 63 - (item >> 4), bh = item & 15; const size_t hb = (size_t)bh * 16384; const int P0 = qb * QB;
    const int lane = lane_now(), row = wv * 32 + (lane & 31), hi = lane >> 5;
    const bf16* qp = Q + (hb + P0 + row) * D + hi * 64; const bf16* kp = K + (hb + P0 + row) * D + hi * 64;
    float acc = 0.f, qq = 0.f;
#pragma unroll
    for (int c = 0; c < 8; ++c) { const u32x4 a = *(const u32x4*)(qp + 8 * c), b = *(const u32x4*)(kp + 8 * c);
#pragma unroll
        for (int q = 0; q < 4; ++q) { const unsigned x = q == 0 ? a.x : q == 1 ? a.y : q == 2 ? a.z : a.w, y = q == 0 ? b.x : q == 1 ? b.y : q == 2 ? b.z : b.w;
            const float xl = __builtin_bit_cast(float, x << 16), xh = __builtin_bit_cast(float, x & 0xffff0000u);
            acc += xl * __builtin_bit_cast(float, y << 16) + xh * __builtin_bit_cast(float, y & 0xffff0000u); qq += xl * xl + xh * xh; } }
    acc += __builtin_bit_cast(float, __builtin_amdgcn_ds_bpermute((lane ^ 32) << 2, __builtin_bit_cast(int, acc)));
    qq += __builtin_bit_cast(float, __builtin_amdgcn_ds_bpermute((lane ^ 32) << 2, __builtin_bit_cast(int, qq)));
    const float km = sqrtf(__builtin_bit_cast(float, nrm[bh]));
    float g = F[hb + P0 + row] + (1.001f * sqrtf(qq) * km - acc) * SCALE;
#pragma unroll
    for (int o = 1; o < 32; o <<= 1) g = fmaxf(g, __builtin_bit_cast(float, __builtin_amdgcn_ds_bpermute((lane ^ o) << 2, __builtin_bit_cast(int, g))));
    volatile float* gm = (volatile float*)(lds + KA_OFF + 2 * SHM_KA + 16);
    if (lane == 0) gm[wv] = g;
    __syncthreads();
    float r = gm[0];
#pragma unroll
    for (int w = 1; w < NW; ++w) r = fmaxf(r, gm[w]);
    __syncthreads();
    return r;
}
__device__ __forceinline__ BR fox_ref(const bf16* Q, const bf16* K, const bf16* V, const bf16* KA, bf16* O, const float* F, const unsigned* nrm, int item, int lane, float gmax) {
    const int qb = 63 - (item >> 4), bh = item & 15;
    BR r; const size_t hb = (size_t)bh * 16384;
    r.Q = Q + (hb + (size_t)qb * QB) * D; r.K = K + hb * D; r.V = V + hb * D; r.KA = KA + hb * 8;
    r.O = O + ((size_t)(bh >> 3) * 16384 + (size_t)qb * QB) * OSTR + (bh & 7) * D; r.P0 = qb * QB;
    const float* Fh = F + hb;
    const int jmax = 4 * qb; float fe[4];
#pragma unroll
    for (int i = 0; i < 4; ++i) { const int j = 4 * lane + i; fe[i] = Fh[(j < jmax ? j : jmax) * KVBLK + 63]; }
    const float thr = gmax + 88.05f;
    int first = 4;
#pragma unroll
    for (int i = 3; i >= 0; --i) if (4 * lane + i <= jmax && fe[i] <= thr) first = i;
    const unsigned long long bal = __ballot(first < 4); const int l1 = __builtin_amdgcn_readfirstlane((int)__builtin_ctzll(bal));
    r.JLO = 4 * l1 + __builtin_amdgcn_readlane(first, l1);
    return r;
}
__device__ __forceinline__ void fox_phase(const bf16* Q, const bf16* K, const bf16* V, const bf16* KA, bf16* O, const float* F, unsigned* ctlq  , char* lds, int wv) {
    constexpr int TOTAL = 1024, SKV = 16384, W = 16384;
    volatile int* slot = (volatile int*)(lds + KA_OFF + 2 * SHM_KA);
    const unsigned* nrm = ctlq + 16;
    int lane = lane_now();
    if (wv == 0 && lane == 0) { slot[0] = (int)atomicAdd(ctlq, 1u); slot[1] = (int)atomicAdd(ctlq, 1u); }
    __syncthreads();
    int icur = __builtin_amdgcn_readfirstlane(slot[0]), inxt = __builtin_amdgcn_readfirstlane(slot[1]);
    __syncthreads();
    if (icur >= TOTAL) return;
    BR cur = fox_ref(Q, K, V, KA, O, F, nrm, icur, lane, fox_gmax(Q, K, F, nrm, icur, lds, wv));
    BR nxt = cur; if (inxt < TOTAL) nxt = fox_ref(Q, K, V, KA, O, F, nrm, inxt, lane, fox_gmax(Q, K, F, nrm, inxt, lds, wv));
    Seam<bf16> S;
    causal_swa_prime<bf16, bf16>(cur, W, lds, S, wv);
    for (;;) {
        const bool last = inxt >= TOTAL;
        if (!last && wv == 0 && lane_now() == 0) slot[2] = (int)atomicAdd(ctlq, 1u);
        causal_swa_block<bf16, bf16>(cur, nxt, SKV, W, lds, S, wv);
        if (last) break;
        const int inn = __builtin_amdgcn_readfirstlane(slot[2]);
        cur = nxt; icur = inxt; inxt = inn; lane = lane_now();
        if (inxt < TOTAL) nxt = fox_ref(Q, K, V, KA, O, F, nrm, inxt, lane, fox_gmax(Q, K, F, nrm, inxt, lds, wv)); else nxt = cur;
        __syncthreads();
    }
}
template <bool MASK>
__device__ __forceinline__ float sb_half(f32x16& p, int kb, int trow, int hi, int pidx, float cin) {
    constexpr float C = SCALE * 1.4426950408889634f;
    float m[16];
#pragma unroll
    for (int r = 0; r < 16; ++r) { const int key = kb + crow(r, hi);
        const float e = __builtin_amdgcn_exp2f(fminf(p[r] * C, 115.f)); const float om = __builtin_amdgcn_rcpf(1.f + e); const bool v = !MASK || key < trow; m[r] = v ? om : 1.f; p[r] = v ? e * om : 0.f; }
    float later[4]; float sp = 1.f;
#pragma unroll
    for (int q = 3; q >= 0; --q) { const float gs = (m[4 * q] * m[4 * q + 1]) * (m[4 * q + 2] * m[4 * q + 3]);
        const float gp = __builtin_bit_cast(float, __builtin_amdgcn_ds_bpermute(pidx, __builtin_bit_cast(int, gs)));
        const float g_lo = hi ? gp : gs, g_hi = hi ? gs : gp;
        later[q] = hi ? sp : sp * g_hi; sp *= g_lo * g_hi; }
#pragma unroll
    for (int q = 0; q < 4; ++q) { float gx = cin * later[q];
#pragma unroll
        for (int i = 3; i >= 0; --i) { const int r = 4 * q + i; p[r] *= gx; gx *= m[r]; } }
    return sp;
}
template <bool MASK>
__device__ __forceinline__ void sb_weights(f32x16& p0, f32x16& p1, int kb, int trow, int hi, int pidx, float& carry) {
    const float s1 = sb_half<MASK>(p1, kb + 32, trow, hi, pidx, carry);
    const float c1 = carry * s1;
    const float s0 = sb_half<MASK>(p0, kb, trow, hi, pidx, c1);
    carry = c1 * s0;
}
__device__ __forceinline__ void sb_pack(const f32x16& p0, const f32x16& p1, bf16x8& pa0, bf16x8& pa1, bf16x8& pa2, bf16x8& pa3) {
#define PK4(P, B_, OUT) do { unsigned a0 = cvtpk(P[B_+0], P[B_+1]), a1 = cvtpk(P[B_+2], P[B_+3]);                          \
        unsigned b0 = cvtpk(P[B_+4], P[B_+5]), b1 = cvtpk(P[B_+6], P[B_+7]);                                             \
        auto r0 = __builtin_amdgcn_permlane32_swap(a0, b0, false, false); auto r1 = __builtin_amdgcn_permlane32_swap(a1, b1, false, false); \
        u32x4 w = {r0[0], r1[0], r0[1], r1[1]}; OUT = *reinterpret_cast<bf16x8*>(&w); } while (0)
    PK4(p0, 0, pa0); PK4(p0, 8, pa1); PK4(p1, 0, pa2); PK4(p1, 8, pa3);
#undef PK4
}
__device__ __forceinline__ void sb_phase(const bf16* Q, const bf16* K, const bf16* V, bf16* O, char* lds, int G, int c, int wv) {
    const int wid = wv;
    char* V_lds = lds; char* K_lds = lds + 2 * SHM_V;
    volatile int* flags = (volatile int*)(lds + 2 * SHM_V + 2 * SHM_K);
    for (int it = c; it < 1024; it += G) {
        const int lane = lane_now(), tid = wid * 64 + lane, r32 = lane & 31, hi = lane >> 5;
        const int sr = tid >> 4, sc = (tid & 15) * 8, vst0 = v_st(sr, sc), kws = KSWZ(sr, sc * 2);
        const int vb0 = (int)(uintptr_t)V_lds + v_rd_base(lane);
        const int bh = it >> 6, qb = it & 63; const size_t hb = (size_t)bh * 16384;
        const bf16* Kh = K + hb * D; const bf16* Vh = V + hb * D; const bf16* Qb = Q + (hb + (size_t)qb * QB) * D;
        const int P0 = qb * QB, qlo = P0 + wid * QBLK, trow = qlo + r32;
        bf16x8 qr[8];
#pragma unroll
        for (int d0 = 0; d0 < 8; ++d0) qr[d0] = *reinterpret_cast<const bf16x8*>(Qb + (size_t)(wid * QBLK + r32) * D + d0 * 16 + hi * 8);
        f32x16 o[4] = {}; float carry = 1.f; int wdone = 0;
        int j = P0 / KVBLK + 3;
        bf16x8 ak0, ak1, av0, av1, bk0, bk1, bv0, bv1;
#define SB_LOAD(K0_, K1_, V0_, V1_, jj) do { const int jc_ = (jj) > 0 ? (jj) : 0; const size_t k0_ = (size_t)jc_ * KVBLK; V0_ = *reinterpret_cast<const bf16x8*>(Vh + (k0_ + sr) * D + sc); V1_ = *reinterpret_cast<const bf16x8*>(Vh + (k0_ + 32 + sr) * D + sc); \
                         K0_ = *reinterpret_cast<const bf16x8*>(Kh + (k0_ + sr) * D + sc); K1_ = *reinterpret_cast<const bf16x8*>(Kh + (k0_ + 32 + sr) * D + sc); } while (0)
#define SB_STAGE(K0_, K1_, V0_, V1_) { \
            *(bf16x8*)(V_lds + vst0) = V0_; *(bf16x8*)(V_lds + vst0 + 8192) = V1_; *(bf16x8*)(K_lds + kws) = K0_; *(bf16x8*)(K_lds + kws + 32 * 256) = K1_; \
            __syncthreads(); \
            SB_LOAD(K0_, K1_, V0_, V1_, j - 2);                                  \
            const int kb = j * KVBLK; \
            if (!wdone && kb < qlo + QBLK - 1) { \
                f32x16 p0, p1; bf16x8 pa0, pa1, pa2, pa3; \
                qkt<0, false, false>(p0, p1, K_lds, r32, hi, qr, true); \
                if (kb + KVBLK - 1 >= qlo) sb_weights<true>(p0, p1, kb, trow, hi, (lane ^ 32) << 2, carry); \
                else sb_weights<false>(p0, p1, kb, trow, hi, (lane ^ 32) << 2, carry); \
                sb_pack(p0, p1, pa0, pa1, pa2, pa3); \
                pv_tile<0, false>(o, vb0, pa0, pa1, pa2, pa3, true); \
                wdone = __all(carry < 1.17549435e-38f) ? 1 : 0; \
            } \
            if (lane == 0) flags[wid] = wdone; \
            __syncthreads(); \
            int all = 1; \
            _Pragma("unroll") for (int w = 0; w < NW; ++w) all &= flags[w]; \
            if (all || j == 0) break; \
            --j; }
        SB_LOAD(ak0, ak1, av0, av1, j); SB_LOAD(bk0, bk1, bv0, bv1, j - 1);
        for (;;) {
            SB_STAGE(ak0, ak1, av0, av1)
            SB_STAGE(bk0, bk1, bv0, bv1)
        }
#undef SB_STAGE
#undef SB_LOAD
        bf16* Ow = O + ((size_t)(bh >> 3) * 16384 + (size_t)qb * QB + wid * QBLK) * OSTR + (bh & 7) * D;
        const int lz = lane_now(), hz = lz >> 5;
#pragma unroll
        for (int r = 0; r < 16; ++r) { const int orow = crow(r, hz);
#pragma unroll
            for (int d0 = 0; d0 < 4; ++d0) { const float v = o[d0][r];
                const float vn = __builtin_bit_cast(float, __builtin_amdgcn_ds_bpermute((lz ^ 1) << 2, __builtin_bit_cast(int, v)));
                if ((lz & 1) == 0) *(unsigned*)(Ow + (size_t)orow * OSTR + d0 * 32 + (lz & 31)) = cvtpk(v, vn); } }
        __syncthreads();
    }
}
}
struct Args { const float* in[21]; float* out; unsigned char* ws; int ph_lo, ph_hi; };
enum { I_X = 0, I_C, I_FOX_WIN, I_FOX_BF, I_FOX_WO, I_SB_WIN, I_SB_WO, I_ADA_W, I_ADA_B, I_LNA_G, I_LNA_B, I_RW, I_RB, I_EG, I_EU, I_ED, I_SG, I_SU, I_SD, I_LNF_G, I_LNF_B };

__device__ __forceinline__ void convert_attn_weights(const Args& A, LAS unsigned char* lds, int gw, int NGW, int wave, int lane) {
    asm volatile("" : "+v"(lane));
    LAS unsigned short* scr = (LAS unsigned short*)(lds + RING_OFF + wave * 16384);
    constexpr int nQ = 16 * 48, nO = 16 * 16, nR = 32, nZ = 128, PER = nQ + nO + nR + nZ;
    for (int it = gw; it < 2 * PER; it += NGW) {
        const int l = it / PER; int r = it % PER;
        bf16* WQKV = (bf16*)(A.ws + WS_WATT + (size_t)l * WATT_STRIDE); bf16* WO = (bf16*)(A.ws + WS_WATT + (size_t)l * WATT_STRIDE + WATT_O); bf16* WR = (bf16*)(A.ws + WS_WATT + (size_t)l * WATT_STRIDE + WATT_R);
        if (r < nQ) { const int kb = r / 48, nb = r % 48; transpose_item(l == 0 ? A.in[I_FOX_WIN] : A.in[I_SB_WIN], l == 0 ? 3080 : 3072, 64 * kb, 64 * nb, WQKV, 1024, 64 * nb, 0, scr, lane); continue; } r -= nQ;
        if (r < nO) { const int kb = r / 16, nb = r % 16; transpose_item(l == 0 ? A.in[I_FOX_WO] : A.in[I_SB_WO], 1024, 64 * kb, 64 * nb, WO, 1024, 64 * nb, 0, scr, lane); continue; } r -= nO;
        if (r < nR) { const int kb = r >> 1, lo = r & 1; transpose_item(A.in[I_RW] + (size_t)l * 1024 * 64, 64, 64 * kb, 0, WR, 1024, lo ? 128 : 0, lo, scr, lane); continue; } r -= nR;
        { const int row = r < 64 ? 64 + r : 192 + (r - 64); unsigned zz = 0u; asm volatile("" : "+v"(zz)); v4u z = {zz, zz, zz, zz}; v4u* p = (v4u*)(WR + (size_t)row * 1024) + lane; p[0] = z; p[64] = z; }
    }
}
constexpr int CONV_PER_LAYER = 65 * 128 + 65 * 64, CONV_TOTAL = 2 * CONV_PER_LAYER;
__device__ __forceinline__ void convert_moe_item(const float* eg, const float* eu, const float* ed, const float* sg, const float* su, const float* sd, unsigned char* ws, int item, LAS unsigned short* scr, int lane) {
    const int l = item / CONV_PER_LAYER; int r = item % CONV_PER_LAYER;
    bf16* WGU = (bf16*)(ws + (l == 0 ? WS_WMOE0 : WS_WMOE1)); bf16* WD = (bf16*)(ws + (l == 0 ? WS_WMOE0 : WS_WMOE1) + WMOE_D);
    if (r < 65 * 128) { const int e = r / 128, r2 = r % 128, which = r2 / 64, r3 = r2 % 64, kb = r3 / 4, nb = r3 % 4, n0 = 64 * nb;
        const float* src;
        if (e < 64) { src = which ? eu : eg; src += (size_t)(l * 64 + e) * 1024 * 256; } else { src = which ? su : sg; src += (size_t)l * 1024 * 256; }
        transpose_item(src, 256, 64 * kb, n0, WGU, 1024, e * 512 + (n0 >> 7) * 256 + which * 128 + (n0 & 127), 0, scr, lane); return; }
    r -= 65 * 128;
    { const int e = r / 64, r2 = r % 64, kb = r2 / 16, nb = r2 % 16;
      const float* src;
      if (e < 64) src = ed + (size_t)(l * 64 + e) * 256 * 1024; else src = sd + (size_t)l * 256 * 1024;
      transpose_item(src, 1024, 64 * kb, 64 * nb, WD, 256, e * 1024 + 64 * nb, 0, scr, lane); }
}
__device__ __forceinline__ void convert_moe_drain(const float* eg, const float* eu, const float* ed, const float* sg, const float* su, const float* sd, unsigned char* ws, LAS unsigned char* lds, int wave) {
    asm volatile("" : "+s"(eg), "+s"(eu), "+s"(ed), "+s"(sg), "+s"(su), "+s"(sd));
    unsigned* q = (unsigned*)(ws + WS_CTL) + CW_CONVQ;
    LAS unsigned short* scr = (LAS unsigned short*)(lds + RING_OFF + wave * 16384);
    for (;;) {
        const int lane = lane_now(); int base = 0;
        if (lane == 0) base = (int)atomicAdd(q, 2u);
        base = __builtin_amdgcn_readfirstlane(base);
        if (base >= CONV_TOTAL) break;
        for (int i = 0; i < 2; ++i) if (base + i < CONV_TOTAL) convert_moe_item(eg, eu, ed, sg, su, sd, ws, base + i, scr, lane);
    }
}

__device__ __forceinline__ void input_pass(const Args& A, LAS unsigned char* lds, int gw, int NGW, int tid, int lane) {
    asm volatile("" : "+v"(tid), "+v"(lane));
    LAS float* Wf = (LAS float*)lds;
    const float* win = A.in[I_FOX_WIN];
    for (int i = tid; i < 8192; i += 512) { const int k = i >> 3, q = i & 7; Wf[q * 1024 + k] = win[(size_t)k * 3080 + 3072 + q]; }
    __syncthreads();
    const float* x = A.in[I_X]; const float* MOD = (const float*)(A.ws + WS_MOD); bf16* H = (bf16*)(A.ws + WS_H); float* LOGF = (float*)(A.ws + WS_LOGF);
    const float bfv = A.in[I_FOX_BF][(lane >> 3) & 7];
    double* BSUM = (double*)(A.ws + WS_BSUM);
    for (int rb = gw; rb < NTOK / 16; rb += NGW) {
        const int b = (rb * 16) >> 14; const float* modb = MOD + (size_t)(0 * 2 + b) * 6144;
        float sc[16], sh[16];
        double bs = 0.0;
#pragma unroll
        for (int j = 0; j < 2; ++j) { float a[8], c[8]; ld8f(modb + 1024 + 512 * j + 8 * lane, a); ld8f(modb + 512 * j + 8 * lane, c);
#pragma unroll
            for (int e = 0; e < 8; ++e) { sc[8 * j + e] = 1.f + a[e]; sh[8 * j + e] = c[e]; } }
        f32x4 xc[4], xn[4];
#pragma unroll
        for (int q = 0; q < 4; ++q) xc[q] = *(const f32x4*)(x + (size_t)(rb * 16) * 1024 + 512 * (q >> 1) + 8 * lane + 4 * (q & 1));
        for (int r = 0; r < 16; ++r) {
            const int t = rb * 16 + r; float h[16];
            { const int tn = rb * 16 + (r < 15 ? r + 1 : r);
#pragma unroll
              for (int q = 0; q < 4; ++q) xn[q] = *(const f32x4*)(x + (size_t)tn * 1024 + 512 * (q >> 1) + 8 * lane + 4 * (q & 1)); }
            __builtin_amdgcn_sched_barrier(0);
#pragma unroll
            for (int j = 0; j < 2; ++j) { float a[8]; a[0] = xc[2 * j].x; a[1] = xc[2 * j].y; a[2] = xc[2 * j].z; a[3] = xc[2 * j].w; a[4] = xc[2 * j + 1].x; a[5] = xc[2 * j + 1].y; a[6] = xc[2 * j + 1].z; a[7] = xc[2 * j + 1].w; float o[8];
#pragma unroll
                for (int e = 0; e < 8; ++e) { h[8 * j + e] = a[e] * sc[8 * j + e] + sh[8 * j + e]; o[e] = h[8 * j + e]; }
                st8bf(H + (size_t)t * 1024 + 512 * j + 8 * lane, o); }
            float fl[8];
#pragma unroll
            for (int q = 0; q < 8; ++q) { float s = 0.f;
#pragma unroll
                for (int j = 0; j < 2; ++j) { const LAS float* wp = Wf + q * 1024 + 512 * j + 8 * lane; const f32x4 w0 = *(const LAS f32x4*)wp, w1 = *(const LAS f32x4*)(wp + 4);
                    s += h[8 * j + 0] * w0.x + h[8 * j + 1] * w0.y + h[8 * j + 2] * w0.z + h[8 * j + 3] * w0.w + h[8 * j + 4] * w1.x + h[8 * j + 5] * w1.y + h[8 * j + 6] * w1.z + h[8 * j + 7] * w1.w; }
                fl[q] = s; }
            float mine;
            { const bool b5 = (lane & 32) != 0, b4 = (lane & 16) != 0, b3 = (lane & 8) != 0; float t4[4], t2[2];
#pragma unroll
              for (int i = 0; i < 4; ++i) { const float keep = b5 ? fl[4 + i] : fl[i], give = b5 ? fl[i] : fl[4 + i]; t4[i] = keep + __builtin_bit_cast(float, __builtin_amdgcn_ds_bpermute((lane ^ 32) << 2, __builtin_bit_cast(int, give))); }
#pragma unroll
              for (int i = 0; i < 2; ++i) { const float keep = b4 ? t4[2 + i] : t4[i], give = b4 ? t4[i] : t4[2 + i]; t2[i] = keep + __builtin_bit_cast(float, __builtin_amdgcn_ds_bpermute((lane ^ 16) << 2, __builtin_bit_cast(int, give))); }
              { const float keep = b3 ? t2[1] : t2[0], give = b3 ? t2[0] : t2[1]; mine = keep + __builtin_bit_cast(float, __builtin_amdgcn_ds_bpermute((lane ^ 8) << 2, __builtin_bit_cast(int, give))); }
#pragma unroll
              for (int o = 4; o > 0; o >>= 1) mine += __builtin_bit_cast(float, __builtin_amdgcn_ds_bpermute((lane ^ o) << 2, __builtin_bit_cast(int, mine))); }
            { const float lf = logsig(mine + bfv); bs += (double)lf; if ((lane & 7) == 0) LOGF[(size_t)t * 8 + (lane >> 3)] = lf; }
#pragma unroll
            for (int q = 0; q < 4; ++q) xc[q] = xn[q];
        }
        if ((lane & 7) == 0) BSUM[(size_t)rb * 8 + (lane >> 3)] = bs;
    }
    __syncthreads();
}

__device__ __forceinline__ double shfl_d(double v, int idx4) { const unsigned long long u = __builtin_bit_cast(unsigned long long, v);
    const unsigned lo = (unsigned)__builtin_amdgcn_ds_bpermute(idx4, (int)(unsigned)u), hi = (unsigned)__builtin_amdgcn_ds_bpermute(idx4, (int)(unsigned)(u >> 32));
    return __builtin_bit_cast(double, ((unsigned long long)hi << 32) | lo); }
__device__ __forceinline__ void fox_scan_seg(const Args& A, LAS unsigned char* lds, int task, int tid, int lane, int wave) {
    asm volatile("" : "+v"(tid), "+v"(lane));
    const float* LOGF = (const float*)(A.ws + WS_LOGF); float* F = (float*)(A.ws + WS_F); bf16* KAUG = (bf16*)(A.ws + WS_KAUG); const double* BSUM = (const double*)(A.ws + WS_BSUM);
    LAS double* red = (LAS double*)lds;
    const int bh = task >> 4, seg = task & 15, b = bh >> 3, h = bh & 7;
    double p = 0.0;
    for (int blk = tid; blk < seg * 64; blk += 512) p += BSUM[((size_t)b * 1024 + blk) * 8 + h];
#pragma unroll
    for (int o = 1; o < 64; o <<= 1) p += shfl_d(p, (lane ^ o) << 2);
    const int s0 = seg * 1024 + 2 * tid;
    const float a0 = LOGF[((size_t)b * SEQ + s0) * 8 + h], a1 = LOGF[((size_t)b * SEQ + s0 + 1) * 8 + h];
    const double loc = (double)a0 + (double)a1; double inc = loc;
#pragma unroll
    for (int o = 1; o < 64; o <<= 1) { const double up = shfl_d(inc, ((lane - o) & 63) << 2); if (lane >= o) inc += up; }
    if (lane == 63) red[8 + wave] = inc;
    if (lane == 0) red[wave] = p;
    __syncthreads();
    double run = 0.0;
#pragma unroll
    for (int w = 0; w < 8; ++w) run += red[w];
    for (int w = 0; w < wave; ++w) run += red[8 + w];
    run += inc - loc;
#pragma unroll
    for (int i = 0; i < 2; ++i) { run += (double)(i == 0 ? a0 : a1); const int s = s0 + i;
        const float f = (float)run; F[(size_t)bh * SEQ + s] = f;
        const float xv = -f / ATTN_SCALE; const unsigned hi = f2bf(xv); const float r1 = xv - __builtin_bit_cast(float, hi << 16); const unsigned mid = f2bf(r1);
        const float r2 = r1 - __builtin_bit_cast(float, mid << 16); const unsigned lo = f2bf(r2);
        v4u w; w.x = hi | (mid << 16); w.y = lo; w.z = 0u; w.w = 0u; *(v4u*)(KAUG + ((size_t)bh * SEQ + s) * 8) = w; }
    __syncthreads();
}

__device__ __forceinline__ void f8x16(const v4u w, float (&y)[16]) {
#pragma unroll
    for (int q = 0; q < 4; ++q) { const int d = (int)(q == 0 ? w.x : q == 1 ? w.y : q == 2 ? w.z : w.w);
        const auto lo = __builtin_amdgcn_cvt_pk_f32_fp8(d, false), hi = __builtin_amdgcn_cvt_pk_f32_fp8(d, true);
        y[4 * q + 0] = lo[0]; y[4 * q + 1] = lo[1]; y[4 * q + 2] = hi[0]; y[4 * q + 3] = hi[1]; }
}
__device__ __forceinline__ v4u ldnt(const void* p) { return __builtin_nontemporal_load((const v4u*)p); }
__device__ __forceinline__ void ld16f_nt(const float* p, float (&v)[16]) {
#pragma unroll
    for (int q = 0; q < 4; ++q) { const f32x4 a = __builtin_nontemporal_load((const f32x4*)(p + 4 * q)); v[4 * q] = a.x; v[4 * q + 1] = a.y; v[4 * q + 2] = a.z; v[4 * q + 3] = a.w; }
}
__device__ __forceinline__ void ld16bf_nt(const bf16* p, float (&v)[16]) {
#pragma unroll
    for (int q = 0; q < 2; ++q) { const v4u w = ldnt(p + 8 * q); v[8 * q + 0] = bflo(w.x); v[8 * q + 1] = bfhi(w.x); v[8 * q + 2] = bflo(w.y); v[8 * q + 3] = bfhi(w.y); v[8 * q + 4] = bflo(w.z); v[8 * q + 5] = bfhi(w.z); v[8 * q + 6] = bflo(w.w); v[8 * q + 7] = bfhi(w.w); }
}
__device__ __forceinline__ void ld16f(const float* p, float (&v)[16]) {
#pragma unroll
    for (int q = 0; q < 4; ++q) { const f32x4 a = *(const f32x4*)(p + 4 * q); v[4 * q] = a.x; v[4 * q + 1] = a.y; v[4 * q + 2] = a.z; v[4 * q + 3] = a.w; }
}
__device__ __forceinline__ void ld16bf(const bf16* p, float (&v)[16]) { float a[8], b[8]; ld8bf(p, a); ld8bf(p + 8, b);
#pragma unroll
    for (int e = 0; e < 8; ++e) { v[e] = a[e]; v[8 + e] = b[e]; } }
__device__ __forceinline__ void st16bf(bf16* p, const float (&v)[16]) { float a[8], b[8];
#pragma unroll
    for (int e = 0; e < 8; ++e) { a[e] = v[e]; b[e] = v[8 + e]; }
    st8bf(p, a); st8bf(p + 8, b); }
__device__ __forceinline__ void st16bf_nt(bf16* p, const float (&v)[16]) {
#pragma unroll
    for (int q = 0; q < 2; ++q) { v4u w; w.x = pg8::cvt_pk_bf16(v[8 * q], v[8 * q + 1]); w.y = pg8::cvt_pk_bf16(v[8 * q + 2], v[8 * q + 3]); w.z = pg8::cvt_pk_bf16(v[8 * q + 4], v[8 * q + 5]); w.w = pg8::cvt_pk_bf16(v[8 * q + 6], v[8 * q + 7]);
        __builtin_nontemporal_store(w, (v4u*)(p + 8 * q)); } }
__device__ __forceinline__ void ln1_pass(const Args& A, int l, int gw, int NGW, int lane) {
    asm volatile("" : "+v"(lane));
    const float* xin = A.in[I_X]; bf16* XB = (bf16*)(A.ws + WS_XB);
    const unsigned char* Y = (const unsigned char*)(A.ws + WS_Y); bf16* H = (bf16*)(A.ws + WS_H); const float* MOD = (const float*)(A.ws + WS_MOD);
    const float* gam_p = A.in[I_LNA_G] + l * 1024; const float* bet_p = A.in[I_LNA_B] + l * 1024;
    const int c0 = 16 * lane;
    for (int rb = gw; rb < NTOK / 16; rb += NGW) {
        const int b = (rb * 16) >> 14; const float* modb = MOD + (size_t)(l * 2 + b) * 6144;
        float gA[16], gam[16], bet[16], scm[16], shm[16];
        ld16f(modb + 2048 + c0, gA); ld16f(gam_p + c0, gam); ld16f(bet_p + c0, bet); ld16f(modb + 4096 + c0, scm); ld16f(modb + 3072 + c0, shm);
#pragma unroll
        for (int e = 0; e < 16; ++e) { gA[e] = (1.f + gA[e]) * (1.f / 16.f); scm[e] += 1.f; }
#define LN1_ISSUE(X0, X1, X2, X3, R0, R1, RY, t_) do { if (l == 0) { X0 = *(const f32x4*)(xin + (t_) * 1024 + c0); X1 = *(const f32x4*)(xin + (t_) * 1024 + c0 + 4); X2 = *(const f32x4*)(xin + (t_) * 1024 + c0 + 8); X3 = *(const f32x4*)(xin + (t_) * 1024 + c0 + 12); } \
            else { R0 = ldnt(XB + (t_) * 1024 + c0); R1 = ldnt(XB + (t_) * 1024 + c0 + 8); } RY = ldnt(Y + (t_) * 1024 + c0); } while (0)
        f32x4 cx0, cx1, cx2, cx3, nx0, nx1, nx2, nx3; v4u c0r, c1r, cyr, n0r, n1r, nyr;
        { float zf = 0.f; unsigned zz = 0u; asm volatile("" : "+v"(zf), "+v"(zz)); cx0 = (f32x4){zf, zf, zf, zf}; cx1 = cx0; cx2 = cx0; cx3 = cx0; nx0 = cx0; nx1 = cx0; nx2 = cx0; nx3 = cx0; c0r = (v4u){zz, zz, zz, zz}; c1r = c0r; n0r = c0r; n1r = c0r; }
        LN1_ISSUE(cx0, cx1, cx2, cx3, c0r, c1r, cyr, (size_t)rb * 16);
        for (int r = 0; r < 16; ++r) {
            const size_t t = (size_t)rb * 16 + r; float v[16], y[16];
            { const size_t tn = (size_t)rb * 16 + (r < 15 ? r + 1 : r); LN1_ISSUE(nx0, nx1, nx2, nx3, n0r, n1r, nyr, tn); }
            __builtin_amdgcn_sched_barrier(0);
            if (l == 0) {
#define F4(R, q) v[4 * q] = R.x; v[4 * q + 1] = R.y; v[4 * q + 2] = R.z; v[4 * q + 3] = R.w
                F4(cx0, 0); F4(cx1, 1); F4(cx2, 2); F4(cx3, 3);
#undef F4
            } else {
#define B8(R, q) v[8 * q] = bflo(R.x); v[8 * q + 1] = bfhi(R.x); v[8 * q + 2] = bflo(R.y); v[8 * q + 3] = bfhi(R.y); v[8 * q + 4] = bflo(R.z); v[8 * q + 5] = bfhi(R.z); v[8 * q + 6] = bflo(R.w); v[8 * q + 7] = bfhi(R.w)
                B8(c0r, 0); B8(c1r, 1);
#undef B8
            }
            f8x16(cyr, y);
            cx0 = nx0; cx1 = nx1; cx2 = nx2; cx3 = nx3; c0r = n0r; c1r = n1r; cyr = nyr;
            float s = 0.f;
#pragma unroll
            for (int e = 0; e < 16; ++e) { v[e] = ALPHA * v[e] + gA[e] * y[e]; s += v[e]; }
            const float mean = wave_sum(s, lane) * (1.f / 1024.f); float s2 = 0.f;
#pragma unroll
            for (int e = 0; e < 16; ++e) { v[e] -= mean; s2 += v[e] * v[e]; }
            const float rstd = 1.f / sqrtf(wave_sum(s2, lane) * (1.f / 1024.f) + LN_EPS);
            float o[16], hh[16];
#pragma unroll
            for (int e = 0; e < 16; ++e) { o[e] = v[e] * rstd * gam[e] + bet[e]; hh[e] = o[e] * scm[e] + shm[e]; }
            st16bf(XB + t * 1024 + c0, o); st16bf(H + t * 1024 + c0, hh);
        }
#undef LN1_ISSUE
    }
}

__device__ __forceinline__ void ln2_pass(const Args& A, LAS unsigned char* lds, int l, int hf, int c, int G, int wave, int r, int WL4, int lane) {
    asm volatile("" : "+v"(lane));
    float* xout = A.out; bf16* XB = (bf16*)(A.ws + WS_XB); const unsigned char* YR = (const unsigned char*)(A.ws + WS_YR); bf16* H = (bf16*)(A.ws + WS_H); const float* MOD = (const float*)(A.ws + WS_MOD);
    const int* SLOTOF = (const int*)(A.ws + WS_SLOTOF); const float* GATE = (const float*)(A.ws + WS_GATE);
    const LAS int* BBL = (const LAS int*)(lds + BBL_OFF) + hf * 68;
    const int shbase = __builtin_amdgcn_readfirstlane(BBL[64]) * 256;
    const float* gam_p = A.in[I_LNF_G] + l * 1024; const float* bet_p = A.in[I_LNF_B] + l * 1024;
    const float* modb = MOD + (size_t)(l * 2 + hf) * 6144; const float* modn = MOD + (size_t)(1 * 2 + hf) * 6144;
    const int c0 = 16 * lane;
    float gM[16], gam[16], bet[16];
    ld16f(modb + 5120 + c0, gM); ld16f(gam_p + c0, gam); ld16f(bet_p + c0, bet);
#pragma unroll
    for (int e = 0; e < 16; ++e) gM[e] = (1.f + gM[e]) * (1.f / 16.f);
    int sln[8]; float gwn[8];
    const int tw = r * 4 + (G - r) * WL4, cum0 = c < r ? c * 4 : r * 4 + (c - r) * WL4, cum1 = cum0 + (c < r ? 4 : WL4);
    const int row0 = __builtin_amdgcn_readfirstlane((int)((unsigned)(HTOK * cum0) / (unsigned)tw)), row1 = __builtin_amdgcn_readfirstlane((int)((unsigned)(HTOK * cum1) / (unsigned)tw));
    { const size_t t0 = (size_t)hf * HTOK + (row0 + wave < HTOK ? row0 + wave : 0);
      const int sv_ = SLOTOF[t0 * 8 + (lane & 7)], ss_ = BBL[sv_ >> 16] * 256 + (sv_ & 0xffff);
#pragma unroll
      for (int k = 0; k < 8; ++k) { sln[k] = __builtin_amdgcn_readlane(ss_, k); gwn[k] = __builtin_bit_cast(float, __builtin_amdgcn_readfirstlane(__builtin_bit_cast(int, GATE[t0 * 8 + k]))); } }
    for (int tl = row0 + wave; tl < row1; tl += NWAVES) {
        const size_t t = (size_t)hf * HTOK + tl;
        int sl[8]; float gw8[8];
#pragma unroll
        for (int k = 0; k < 8; ++k) { sl[k] = sln[k]; gw8[k] = gwn[k]; }
        { const int tn = tl + NWAVES < row1 ? tl + NWAVES : tl; const size_t t1 = (size_t)hf * HTOK + tn;
          const int sv_ = SLOTOF[t1 * 8 + (lane & 7)], ss_ = BBL[sv_ >> 16] * 256 + (sv_ & 0xffff);
#pragma unroll
          for (int k = 0; k < 8; ++k) { sln[k] = __builtin_amdgcn_readlane(ss_, k); gwn[k] = __builtin_bit_cast(float, __builtin_amdgcn_readfirstlane(__builtin_bit_cast(int, GATE[t1 * 8 + k]))); } }
        float v[16], ys[16], y[16];
        ld16bf_nt(XB + t * 1024 + c0, v);
        f8x16(ldnt(YR + ((size_t)shbase + tl) * 1024 + c0), ys);
#pragma unroll
        for (int k = 0; k < 8; ++k) { f8x16(ldnt(YR + (size_t)sl[k] * 1024 + c0), y);
#pragma unroll
            for (int e = 0; e < 16; ++e) ys[e] += gw8[k] * y[e]; }
        float s = 0.f;
#pragma unroll
        for (int e = 0; e < 16; ++e) { v[e] = ALPHA * v[e] + gM[e] * ys[e]; s += v[e]; }
        const float mean = wave_sum(s, lane) * (1.f / 1024.f); float s2 = 0.f;
#pragma unroll
        for (int e = 0; e < 16; ++e) { v[e] -= mean; s2 += v[e] * v[e]; }
        const float rstd = 1.f / sqrtf(wave_sum(s2, lane) * (1.f / 1024.f) + LN_EPS);
        float o[16];
#pragma unroll
        for (int e = 0; e < 16; ++e) o[e] = v[e] * rstd * gam[e] + bet[e];
        if (l == 1) {
#pragma unroll
            for (int q = 0; q < 4; ++q) *(f32x4*)(xout + t * 1024 + c0 + 4 * q) = (f32x4){o[4 * q], o[4 * q + 1], o[4 * q + 2], o[4 * q + 3]}; }
        else st16bf(XB + t * 1024 + c0, o);
        if (l == 0) { float h0[8], h1[8], scn[16], shn[16];
            { const float* mq = modn; asm volatile("" : "+s"(mq)); ld16f(mq + 1024 + c0, scn); ld16f(mq + c0, shn); }
#pragma unroll
            for (int e = 0; e < 8; ++e) { h0[e] = o[e] * (1.f + scn[e]) + shn[e]; h1[e] = o[8 + e] * (1.f + scn[8 + e]) + shn[8 + e]; }
            st8bf(H + t * 1024 + c0, h0); st8bf(H + t * 1024 + c0 + 8, h1); }
    }
}

__device__ __forceinline__ void build_block_tables(const unsigned* cnt, LAS unsigned char* lds, int wave, int lane) {
    asm volatile("" : "+v"(lane));
    LAS int* BT = (LAS int*)(lds + BT_OFF); LAS int* BBL = (LAS int*)(lds + BBL_OFF);
    if (wave < 2) { const int h = wave;
        const int n = (int)__hip_atomic_load(cnt + h * 64 + lane, __ATOMIC_RELAXED, __HIP_MEMORY_SCOPE_AGENT), nb = (n + 255) >> 8;
        int inc = nb;
#pragma unroll
        for (int o = 1; o < 64; o <<= 1) { const int up = __builtin_amdgcn_ds_bpermute(((lane - o) & 63) << 2, inc); if (lane >= o) inc += up; }
        const int excl = inc - nb, tot = __builtin_amdgcn_readlane(inc, 63);
        BBL[h * 68 + lane] = excl; if (lane == 0) { BBL[h * 68 + 64] = tot; BBL[h * 68 + 65] = tot + 64; }
        for (int j = 0; j < nb; ++j) BT[h * MAXBLK + excl + j] = lane | (j << 8);
        BT[h * MAXBLK + tot + lane] = 64 | (lane << 8);
    }
    __syncthreads();
}
constexpr int PH_PER_LAYER = 12, PH_BASE = 3, NPH = PH_BASE + DEPTH * PH_PER_LAYER;
#ifndef MK_PER_PHASE
#define MK_PER_PHASE 0
#endif

typedef const __attribute__((address_space(4))) Args* KArgsPtr;
__device__ __forceinline__ Args load_args() {
#if defined(__HIP_DEVICE_COMPILE__)
    KArgsPtr p = (KArgsPtr)__builtin_amdgcn_kernarg_segment_ptr(); asm volatile("" : "+s"(p));
    Args a;
#pragma unroll
    for (int i = 0; i < 21; ++i) a.in[i] = p->in[i];
    a.out = p->out; a.ws = p->ws; a.ph_lo = p->ph_lo; a.ph_hi = p->ph_hi; return a;
#else
    return Args{};
#endif
}
__global__ void __launch_bounds__(NWAVES * 64, 2) mk_fwd(Args args) {
    extern __shared__ __attribute__((aligned(16))) unsigned char lds_raw[];
    LAS unsigned char* lds = (LAS unsigned char*)lds_raw;
    volatile LAS unsigned* MISC = (volatile LAS unsigned*)(lds + MISC_OFF);
    const int wave = __builtin_amdgcn_readfirstlane((int)threadIdx.x >> 6);
    const int G = gridDim.x, bx = blockIdx.x; const int vcu = (G % 8 == 0) ? (bx % 8) * (G / 8) + bx / 8 : bx;
    const int gw = vcu * NWAVES + wave, NGW = G * NWAVES;
    unsigned* ctl = (unsigned*)(args.ws + WS_CTL);
    for (int u = wave * 64 + lane_now(); u < (LDS_BYTES - LDSCTL_OFF) / 4; u += NWAVES * 64) ((LAS unsigned*)(lds + LDSCTL_OFF))[u] = 0u;
    __syncthreads();
    const int lo = args.ph_lo, hi = args.ph_hi;
    XcdBarrier bar; bar.bar = ctl + CW_BAR; bar.x = 0; bar.st = MISC + 8; bar.wave = wave;
    if (hi - lo > 1) bar = xcd_barrier_post(ctl + CW_BAR, MISC + 8, wave);
#ifndef LN2_WL4
#define LN2_WL4 8
#endif
#ifndef PHMASK
#define PHMASK 0xFFFF
#endif
#define KIND(i) ((PHMASK >> (i)) & 1)
#define PH(k) (lo <= (k) && (k) < hi)
#define SEAM(k) do { if (PH(k) && PH((k) + 1)) { XcdBarrier _b = bar; asm volatile("" : "+s"(_b.bar)); xcd_barrier(_b); } } while (0)

    if (PH(0) && KIND(0)) { const Args A = load_args(); const int lane = lane_now(), tid = wave * 64 + lane; (void)tid; (void)lane; unsigned char* const ws = A.ws; (void)ws;
        convert_attn_weights(A, lds, gw, NGW, wave, lane);
        {
            const float* adaw = A.in[I_ADA_W]; const float* cv = A.in[I_C]; const float* adab = A.in[I_ADA_B]; float* MOD = (float*)(ws + WS_MOD);
            LAS float* sl = (LAS float*)(lds + 65536); LAS float* part = sl + 2048;
            __syncthreads();
            for (int i = tid; i < 2048; i += 512) { const float c0 = cv[i]; sl[i] = c0 / (1.f + expf(-c0)); }
            __syncthreads();
            for (int pb2 = bx; pb2 < 12288 / 48; pb2 += G) {
                const int jq = tid % 12, ks = tid / 12;
                const int pair = pb2 * 48 + 4 * jq, l = pair / 6144, j = pair % 6144;
                if (ks < 32) { f32x4 a0 = {0.f, 0.f, 0.f, 0.f}, a1 = a0;
#pragma unroll 1
                    for (int k0 = ks * 32; k0 < ks * 32 + 32; k0 += 16) { f32x4 w[16];
#pragma unroll
                        for (int i = 0; i < 16; ++i) w[i] = *(const f32x4*)(adaw + ((size_t)l * 1024 + k0 + i) * 6144 + j);
#pragma unroll
                        for (int i = 0; i < 16; ++i) { a0 += sl[k0 + i] * w[i]; a1 += sl[1024 + k0 + i] * w[i]; } }
#pragma unroll
                    for (int q = 0; q < 4; ++q) { part[(ks * 48 + 4 * jq + q) * 2] = a0[q]; part[(ks * 48 + 4 * jq + q) * 2 + 1] = a1[q]; } }
                __syncthreads();
                if (tid < 96) { const int jj = tid >> 1, b = tid & 1; const int pr = pb2 * 48 + jj, l2 = pr / 6144, j2 = pr % 6144; float s = adab[l2 * 6144 + j2];
                    for (int q = 0; q < 32; ++q) s += part[(q * 48 + jj) * 2 + b];
                    MOD[(size_t)(l2 * 2 + b) * 6144 + j2] = s; }
                __syncthreads();
            }
        }
    }
    SEAM(0);
    if (PH(2) && KIND(2)) { const Args A = load_args(); const int lane = lane_now(), tid = wave * 64 + lane; (void)tid; (void)lane; input_pass(A, lds, gw, NGW, tid, lane); }
    SEAM(2);

    for (int l = 0; l < DEPTH; ++l) {
        const int pb = PH_BASE + l * PH_PER_LAYER;
        if (PH(pb + 0) && KIND(3)) { const Args A = load_args(); const int lane = lane_now(), tid = wave * 64 + lane; (void)tid; (void)lane; unsigned char* const ws = A.ws; (void)ws;
            if (l == 0) { for (int task = bx; task < 256; task += G) fox_scan_seg(A, lds, task, tid, lane, wave); }
            pg8::Gemm g{(const bf16*)(ws + WS_H), (const bf16*)(ws + WS_WATT + (size_t)l * WATT_STRIDE), NTOK, 3 * DM, DM}; pg8::StaticOrder<NTOK / 256, 12> S; S.init(G, bx);
            pg8::EpiQKV E{(bf16*)(ws + WS_Q), (size_t)(WS_K - WS_Q) / 2, l == 0 ? ctl + CW_FOXQ + 16 : nullptr, (LAS float*)(lds + LDSCTL_OFF + 4096)};
            pg8::gemm_phase<pg8::EpiQKV, pg8::StaticOrder<NTOK / 256, 12>, true, false>(lds + RING_OFF, g, S, E, nullptr, wave);
        }
        SEAM(pb + 0);
        if (PH(pb + 1) && KIND(4)) { const Args A = load_args(); const int lane = lane_now(), tid = wave * 64 + lane; (void)tid; (void)lane; unsigned char* const ws = A.ws; (void)ws;
            if (l == 0) {
                const bool conv_first = ((bx >> 3) & 7) == 0;
                if (conv_first) { convert_moe_drain(A.in[I_EG], A.in[I_EU], A.in[I_ED], A.in[I_SG], A.in[I_SU], A.in[I_SD], ws, lds, wave); __syncthreads(); }
                fox::fox_phase((const bf16*)(ws + WS_Q), (const bf16*)(ws + WS_K), (const bf16*)(ws + WS_V), (const bf16*)(ws + WS_KAUG), (bf16*)(ws + WS_O), (const float*)(ws + WS_F), ctl + CW_FOXQ, (char*)lds_raw, wave); __syncthreads();
                convert_moe_drain(A.in[I_EG], A.in[I_EU], A.in[I_ED], A.in[I_SG], A.in[I_SU], A.in[I_SD], ws, lds, wave); __syncthreads(); }
            else { fox::sb_phase((const bf16*)(ws + WS_Q), (const bf16*)(ws + WS_K), (const bf16*)(ws + WS_V), (bf16*)(ws + WS_O), (char*)lds_raw, G, vcu, wave); __syncthreads(); }
        }
        SEAM(pb + 1);
        if (PH(pb + 2) && KIND(5)) { const Args A = load_args(); const int lane = lane_now(), tid = wave * 64 + lane; (void)tid; (void)lane; unsigned char* const ws = A.ws; (void)ws;
            pg8::Gemm g{(const bf16*)(ws + WS_O), (const bf16*)(ws + WS_WATT + (size_t)l * WATT_STRIDE + WATT_O), NTOK, DM, DM}; pg8::StaticOrder<NTOK / 256, 4> S; S.init(G, bx);
            pg8::EpiF8 E{(unsigned char*)(ws + WS_Y), DM, 0xffff};
            pg8::gemm_phase<pg8::EpiF8, pg8::StaticOrder<NTOK / 256, 4>, true, false>(lds + RING_OFF, g, S, E, nullptr, wave);
        }
        SEAM(pb + 2);
        if (PH(pb + 3) && KIND(6)) { const Args A = load_args(); const int lane = lane_now(), tid = wave * 64 + lane; (void)tid; (void)lane; ln1_pass(A, l, gw, NGW, lane); }
        SEAM(pb + 3);
        if (PH(pb + 4) && KIND(7)) { const Args A = load_args(); const int lane = lane_now(), tid = wave * 64 + lane; (void)tid; (void)lane; unsigned char* const ws = A.ws; (void)ws;
            pg8::Gemm g{(const bf16*)(ws + WS_H), (const bf16*)(ws + WS_WATT + (size_t)l * WATT_STRIDE + WATT_R), NTOK, 256, DM}; pg8::StaticOrder<NTOK / 256, 1> S; S.init(G, bx);
            pg8::EpiRouter E{A.in[I_RB] + l * 64, (float*)(ws + WS_GATE), ctl + CW_CNT + l * 128, (int*)(ws + WS_SLOTOF), (unsigned short*)(ws + WS_ROWTOK2)};
            pg8::gemm_phase<pg8::EpiRouter, pg8::StaticOrder<NTOK / 256, 1>, false, false>(lds + RING_OFF, g, S, E, nullptr, wave);
            __syncthreads();
        }
        SEAM(pb + 4);
        for (int hf = 0; hf < 2; ++hf) {
            const int ph = pb + 6 + 3 * hf;
            if (PH(ph) && KIND(9)) { const Args A = load_args(); const int lane = lane_now(), tid = wave * 64 + lane; (void)tid; (void)lane; unsigned char* const ws = A.ws; (void)ws;
                if (hf == 0) build_block_tables(ctl + CW_CNT + l * 128, lds, wave, lane);
                const int nblk = __builtin_amdgcn_readfirstlane(((const LAS int*)(lds + BBL_OFF))[hf * 68 + 65]);
                pg8::Gemm g{(const bf16*)(ws + WS_H) + (size_t)hf * HTOK * DM, (const bf16*)(ws + (l == 0 ? WS_WMOE0 : WS_WMOE1)), 0, 512, DM};
                pg8::MoeOrder S{nblk * 2, 1, G, vcu, (const LAS int*)(lds + BT_OFF) + hf * MAXBLK};
                pg8::EpiSwiglu E{(bf16*)(ws + WS_ACT)};
                pg8::gemm_phase<pg8::EpiSwiglu, pg8::MoeOrder, true, true>(lds + RING_OFF, g, S, E, (const unsigned short*)(ws + WS_ROWTOK2) + (size_t)hf * 65 * 16384, wave);
            }
            SEAM(ph);
            if (PH(ph + 1) && KIND(10)) { const Args A = load_args(); const int lane = lane_now(), tid = wave * 64 + lane; (void)tid; (void)lane; unsigned char* const ws = A.ws; (void)ws;
                const int nblk = __builtin_amdgcn_readfirstlane(((const LAS int*)(lds + BBL_OFF))[hf * 68 + 65]);
                pg8::Gemm g{(const bf16*)(ws + WS_ACT), (const bf16*)(ws + (l == 0 ? WS_WMOE0 : WS_WMOE1) + WMOE_D), 0, 1024, FE};
                pg8::MoeOrder S{nblk * 4, 2, G, vcu, (const LAS int*)(lds + BT_OFF) + hf * MAXBLK};
                pg8::EpiF8 E{(unsigned char*)(ws + WS_YR), DM, 3};
                pg8::gemm_phase<pg8::EpiF8, pg8::MoeOrder, true, false>(lds + RING_OFF, g, S, E, nullptr, wave);
            }
            SEAM(ph + 1);
            if (PH(ph + 2) && KIND(11)) { const Args A = load_args(); const int lane = lane_now(), tid = wave * 64 + lane; (void)tid; (void)lane; unsigned char* const ws = A.ws; (void)ws;
                int r = G, wl4 = 4;
                if (hf == 0) { const int nun = __builtin_amdgcn_readfirstlane(((const LAS int*)(lds + BBL_OFF))[1 * 68 + 65]) * 2; r = nun % G; wl4 = LN2_WL4; }
                ln2_pass(A, lds, l, hf, vcu, G, wave, r, wl4, lane);
            }
            if (hf == 1) SEAM(ph + 2);
        }
    }
#undef PH
#undef SEAM
}

extern "C" void kernel_launch(void* const* d_in, const int* in_sizes, int n_in, void* d_out, int out_size, void* d_ws, size_t ws_size, hipStream_t stream) {
    static int grid = 0;
    if (grid == 0) {
        if (n_in != 21 || in_sizes[0] != NTOK * DM || out_size != NTOK * DM || ws_size < WS_END) {
            fprintf(stderr, "kernel_launch: unexpected shapes (n_in %d, in0 %d, out %d, ws %zu < %zu); nothing launched\n", n_in, n_in > 0 ? in_sizes[0] : -1, out_size, ws_size, (size_t)WS_END); grid = -1; return; }
        int dev = 0, cus = 0;
        if (hipGetDevice(&dev) != hipSuccess || hipDeviceGetAttribute(&cus, hipDeviceAttributeMultiprocessorCount, dev) != hipSuccess) { grid = -1; return; }
        if (hipFuncSetAttribute((const void*)mk_fwd, hipFuncAttributeMaxDynamicSharedMemorySize, LDS_BYTES) != hipSuccess) { fprintf(stderr, "kernel_launch: hipFuncSetAttribute failed\n"); grid = -1; return; }
        int per_cu = 0;
        if (hipOccupancyMaxActiveBlocksPerMultiprocessor(&per_cu, (const void*)mk_fwd, NWAVES * 64, LDS_BYTES) != hipSuccess || per_cu < 1) { fprintf(stderr, "kernel_launch: occupancy query reports %d\n", per_cu); }
        (void)hipGetLastError();
        grid = cus;
        if (grid < 128) { fprintf(stderr, "kernel_launch: needs >= 128 CUs\n"); grid = -1; return; }
    }
    if (grid < 0) return;
    if (hipMemsetAsync((char*)d_ws + WS_CTL, 0, CTL_ZERO_BYTES, stream) != hipSuccess) return;
    Args a{};
    for (int i = 0; i < 21; ++i) a.in[i] = (const float*)d_in[i];
    a.out = (float*)d_out; a.ws = (unsigned char*)d_ws;
#if MK_PER_PHASE
    for (int p = 0; p < NPH; ++p) { a.ph_lo = p; a.ph_hi = p + 1; hipLaunchKernelGGL(mk_fwd, dim3(grid), dim3(NWAVES * 64), LDS_BYTES, stream, a); }
#else
    a.ph_lo = 0; a.ph_hi = NPH;
    hipLaunchKernelGGL(mk_fwd, dim3(grid), dim3(NWAVES * 64), LDS_BYTES, stream, a);
#endif
}
```
